# Optimizing an MI355X kernel written in HIP

```python
import jax, jax.numpy as jnp
from jax import lax
import numpy as np

D_MODEL = 1024
BATCH = 8
SEQ = 4096
DEPTH = 4

RET_HEADS = 4
RET_DK = 64
RET_DV = 64
RET_CHUNK = 128
DIL_HEADS = 6
DIL_DH = 64
DIL_PATTERNS = ((128, 1), (512, 4), (2048, 16))
MLA_HEADS = 6
MLA_Q_RANK = 384
MLA_KV_RANK = 256
MLA_NOPE = 64
MLA_ROPE = 32
MLA_V = 64
Q_BLOCK = 128
RET_IN = RET_HEADS * (2 * RET_DK + 2 * RET_DV)
DIL_IN = 3 * DIL_HEADS * DIL_DH
MLA_IN = MLA_Q_RANK + MLA_KV_RANK + MLA_ROPE
D_IN = RET_IN + DIL_IN + MLA_IN
MIX_OUT = RET_HEADS * RET_DV + DIL_HEADS * DIL_DH + MLA_HEADS * MLA_V
D_FF = 2816
N_EXPERTS = 8
TOP_K = 2
D_FF_EXPERT = 3584
ROPE_THETA = 10000.0
LN_EPS = 1e-5
RMS_EPS = 1e-6
DEEPNORM_ALPHA = (2.0 * DEPTH) ** 0.25
DEEPNORM_BETA = (8.0 * DEPTH) ** -0.25
N_DENSE = (DEPTH + 1) // 2
N_MOE = DEPTH // 2

kernel_name = 'hybrid_ret_dilated_mla_moe_deepnorm'


def layer_norm(x, g, b):
    xf = x.astype(jnp.float32)
    mu = jnp.mean(xf, -1, keepdims=True)
    var = jnp.mean(jnp.square(xf - mu), -1, keepdims=True)
    return ((xf - mu) * lax.rsqrt(var + LN_EPS) * g + b).astype(x.dtype)


def rms_norm(x, g):
    xf = x.astype(jnp.float32)
    return (xf * lax.rsqrt(jnp.mean(jnp.square(xf), -1, keepdims=True) + RMS_EPS) * g).astype(x.dtype)


def rope_tables(positions, dim):
    inv = ROPE_THETA ** (-jnp.arange(0, dim, 2, dtype=jnp.float32) / dim)
    ang = positions.astype(jnp.float32)[..., None] * inv
    return jnp.cos(ang), jnp.sin(ang)


def apply_rope(x, cos, sin):
    c = cos[:, :, None, :].astype(x.dtype)
    s = sin[:, :, None, :].astype(x.dtype)
    x1, x2 = jnp.split(x, 2, axis=-1)
    return jnp.concatenate([x1 * c - x2 * s, x2 * c + x1 * s], axis=-1)


def retention(q, k, v, g, gn_g):
    B, S, H, dk = q.shape
    dv = v.shape[-1]
    C = RET_CHUNK
    N = S // C
    dt = q.dtype
    log_g = jnp.log(1.0 - 2.0 ** (-5.0 - jnp.arange(H, dtype=jnp.float32)))
    idx = jnp.arange(C, dtype=jnp.float32)
    diff = idx[:, None] - idx[None, :]
    intra = jnp.where(diff >= 0, jnp.exp(jnp.maximum(diff, 0.0) * log_g[:, None, None]), 0.0).astype(dt)
    xi = jnp.exp((idx[:, None] + 1.0) * log_g[None, :]).astype(dt)
    zeta = jnp.exp((C - 1.0 - idx[:, None]) * log_g[None, :]).astype(dt)
    chunk_decay = jnp.exp(C * log_g).astype(dt)[None, :, None, None]
    qc = q.reshape(B, N, C, H, dk)
    kc = k.reshape(B, N, C, H, dk) * (dk ** -0.5)
    vc = v.reshape(B, N, C, H, dv)
    s = jnp.einsum('bnihd,bnjhd->bnhij', qc, kc) * intra
    inner = jnp.einsum('bnhij,bnjhe->bnihe', s, vc)
    kv = jnp.einsum('bnjhd,bnjhe->nbhde', kc * zeta[:, :, None], vc)

    def step(state, kv_n):
        return state * chunk_decay + kv_n, state

    _, prev = lax.scan(step, jnp.zeros((B, H, dk, dv), dt), kv)
    cross = jnp.einsum('bnihd,nbhde->bnihe', qc, prev) * xi[:, :, None]
    o = (inner + cross).reshape(B, S, H, dv).astype(jnp.float32)
    mu = jnp.mean(o, -1, keepdims=True)
    var = jnp.mean(jnp.square(o - mu), -1, keepdims=True)
    o = ((o - mu) * lax.rsqrt(var + LN_EPS)).reshape(B, S, H * dv) * gn_g
    return jax.nn.silu(g) * o.astype(dt)


def dilated_branch(q, k, v, window, dilation):
    B, S, H, dh = q.shape
    L = S // dilation
    W = window // dilation
    nb = -(-L // W)
    Lp = nb * W
    R = B * dilation

    def to_sub(x):
        x = x.reshape(B, L, dilation, H, dh).transpose(0, 2, 1, 3, 4).reshape(R, L, H, dh)
        return jnp.pad(x, ((0, 0), (0, Lp - L), (0, 0), (0, 0)))

    def banded(x):
        cur = x.reshape(R, nb, W, H, dh)
        prev = jnp.pad(cur, ((0, 0), (1, 0), (0, 0), (0, 0), (0, 0)))[:, :nb]
        return jnp.concatenate([prev, cur], axis=2)

    qb = to_sub(q).reshape(R, nb, W, H, dh)
    kb = banded(to_sub(k))
    vb = banded(to_sub(v))
    s = jnp.einsum('rnqhd,rnkhd->rnhqk', qb, kb).astype(jnp.float32) * (dh ** -0.5)
    qi = jnp.arange(W)[:, None]
    kj = jnp.arange(2 * W)[None, :]
    dist = W + qi - kj
    band = (dist >= 0) & (dist <= W)
    first = jnp.arange(nb)[:, None, None] > 0
    valid = band[None] & (first | (kj >= W)[None])
    s = jnp.where(valid[None, :, None], s, -jnp.inf)
    m = jnp.max(s, -1, keepdims=True)
    p = jnp.exp(s - m)
    l = jnp.sum(p, -1, keepdims=True)
    o = jnp.einsum('rnhqk,rnkhd->rnqhd', (p / l).astype(v.dtype), vb)
    lse = (m + jnp.log(l))[..., 0]
    o = o.reshape(R, Lp, H, dh)[:, :L]
    o = o.reshape(B, dilation, L, H, dh).transpose(0, 2, 1, 3, 4).reshape(B, S, H, dh)
    lse = jnp.moveaxis(lse, 2, 3).reshape(R, Lp, H)[:, :L]
    lse = lse.reshape(B, dilation, L, H).transpose(0, 2, 1, 3).reshape(B, S, H)
    return o, lse


def dilated_attention(q, k, v):
    outs, lses = [], []
    for window, dilation in DIL_PATTERNS:
        o, lse = dilated_branch(q, k, v, window, dilation)
        outs.append(o)
        lses.append(lse)
    wts = jax.nn.softmax(jnp.stack(lses, 0), axis=0).astype(q.dtype)
    return jnp.einsum('pbsh,pbshd->bshd', wts, jnp.stack(outs, 0))


def mla_attention(qn, qr, kn, kr, v):
    B, S, H, _ = qn.shape
    nb = S // Q_BLOCK
    scale = (MLA_NOPE + MLA_ROPE) ** -0.5
    kpos = jnp.arange(S)

    def blocks(x):
        return jnp.moveaxis(x.reshape(B, nb, Q_BLOCK, *x.shape[2:]), 1, 0)

    def one(args):
        qn_b, qr_b, start = args
        s = jnp.einsum('bqhd,bkhd->bhqk', qn_b, kn) + jnp.einsum('bqhd,bkd->bhqk', qr_b, kr)
        s = s.astype(jnp.float32) * scale
        qpos = start + jnp.arange(Q_BLOCK)
        s = jnp.where(kpos[None, :] <= qpos[:, None], s, -jnp.inf)
        p = jax.nn.softmax(s, axis=-1).astype(v.dtype)
        return jnp.einsum('bhqk,bkhd->bqhd', p, v)

    starts = jnp.arange(nb, dtype=jnp.int32) * Q_BLOCK
    out = lax.map(one, (blocks(qn), blocks(qr), starts))
    return jnp.moveaxis(out, 0, 1).reshape(B, S, H, v.shape[-1])


def hybrid_mixer(h, w_in, ret_gn_g, mla_qn_g, mla_kvn_g, w_uq, w_ukv, w_out, rope_ret, rope_dil, rope_mla):
    B, S, _ = h.shape
    z = h @ w_in
    za, zb, zc = jnp.split(z, [RET_IN, RET_IN + DIL_IN], axis=-1)
    nq = RET_HEADS * RET_DK
    nv = RET_HEADS * RET_DV
    rq, rk, rv, rg = jnp.split(za, [nq, 2 * nq, 2 * nq + nv], axis=-1)
    rq = apply_rope(rq.reshape(B, S, RET_HEADS, RET_DK), *rope_ret)
    rk = apply_rope(rk.reshape(B, S, RET_HEADS, RET_DK), *rope_ret)
    ya = retention(rq, rk, rv.reshape(B, S, RET_HEADS, RET_DV), rg, ret_gn_g)
    dq, dk, dv = [t.reshape(B, S, DIL_HEADS, DIL_DH) for t in jnp.split(zb, 3, axis=-1)]
    dq = apply_rope(dq, *rope_dil)
    dk = apply_rope(dk, *rope_dil)
    yb = dilated_attention(dq, dk, dv).reshape(B, S, DIL_HEADS * DIL_DH)
    cq, ckv, kr = jnp.split(zc, [MLA_Q_RANK, MLA_Q_RANK + MLA_KV_RANK], axis=-1)
    q = (rms_norm(cq, mla_qn_g) @ w_uq).reshape(B, S, MLA_HEADS, MLA_NOPE + MLA_ROPE)
    qn, qr = jnp.split(q, [MLA_NOPE], axis=-1)
    qr = apply_rope(qr, *rope_mla)
    kv = (rms_norm(ckv, mla_kvn_g) @ w_ukv).reshape(B, S, MLA_HEADS, MLA_NOPE + MLA_V)
    kn, mv = jnp.split(kv, [MLA_NOPE], axis=-1)
    kr = apply_rope(kr[:, :, None, :], *rope_mla)[:, :, 0]
    yc = mla_attention(qn, qr, kn, kr, mv).reshape(B, S, MLA_HEADS * MLA_V)
    return jnp.concatenate([ya, yb, yc], axis=-1) @ w_out


def swiglu(h, w1, w3, w2):
    return (jax.nn.silu(h @ w1) * (h @ w3)) @ w2


def moe_swiglu(h, w_router, w1, w3, w2):
    B, S, D = h.shape
    t = h.reshape(B * S, D)
    logits = (t @ w_router).astype(jnp.float32)
    top_v, top_i = lax.top_k(logits, TOP_K)
    gates = jax.nn.softmax(top_v, axis=-1)
    combine = jnp.sum(jax.nn.one_hot(top_i, N_EXPERTS, dtype=jnp.float32) * gates[..., None], axis=1).astype(t.dtype)
    out = jnp.zeros_like(t)
    for e in range(N_EXPERTS):
        out = out + combine[:, e:e + 1] * swiglu(t, w1[e], w3[e], w2[e])
    return out.reshape(B, S, D)


def setup_inputs(seed: int = 0) -> dict:
    key = jax.random.key(seed)
    ks = jax.random.split(key, 23)
    f32 = jnp.float32

    def nrm(k, shape, scale):
        return jax.random.normal(k, shape, f32) * scale

    def gain(k, shape):
        return 1.0 + 0.02 * jax.random.normal(k, shape, f32)

    L = DEPTH
    D = D_MODEL
    return {
        'x': nrm(ks[0], (BATCH, SEQ, D), 1.0),
        'c': nrm(ks[1], (BATCH, D), 1.0),
        'positions': jnp.tile(jnp.arange(SEQ, dtype=jnp.int32)[None, :], (BATCH, 1)),
        'w_in': nrm(ks[2], (L, D, D_IN), D ** -0.5),
        'ret_gn_g': gain(ks[3], (L, RET_HEADS * RET_DV)),
        'mla_qn_g': gain(ks[4], (L, MLA_Q_RANK)),
        'mla_kvn_g': gain(ks[5], (L, MLA_KV_RANK)),
        'w_uq': nrm(ks[6], (L, MLA_Q_RANK, MLA_HEADS * (MLA_NOPE + MLA_ROPE)), MLA_Q_RANK ** -0.5),
        'w_ukv': nrm(ks[7], (L, MLA_KV_RANK, MLA_HEADS * (MLA_NOPE + MLA_V)), MLA_KV_RANK ** -0.5),
        'w_out': nrm(ks[8], (L, MIX_OUT, D), DEEPNORM_BETA * MIX_OUT ** -0.5),
        'w_ada': nrm(ks[9], (L, D, 6 * D), 0.1 * D ** -0.5),
        'b_ada': nrm(ks[10], (L, 6 * D), 0.01),
        'ln1_g': gain(ks[11], (L, D)),
        'ln1_b': nrm(ks[12], (L, D), 0.01),
        'ln2_g': gain(ks[13], (L, D)),
        'ln2_b': nrm(ks[14], (L, D), 0.01),
        'w1_dense': nrm(ks[15], (N_DENSE, D, D_FF), D ** -0.5),
        'w3_dense': nrm(ks[16], (N_DENSE, D, D_FF), D ** -0.5),
        'w2_dense': nrm(ks[17], (N_DENSE, D_FF, D), DEEPNORM_BETA * D_FF ** -0.5),
        'w_router': nrm(ks[18], (N_MOE, D, N_EXPERTS), D ** -0.5),
        'w1_moe': nrm(ks[19], (N_MOE, N_EXPERTS, D, D_FF_EXPERT), D ** -0.5),
        'w3_moe': nrm(ks[20], (N_MOE, N_EXPERTS, D, D_FF_EXPERT), D ** -0.5),
        'w2_moe': nrm(ks[21], (N_MOE, N_EXPERTS, D_FF_EXPERT, D), DEEPNORM_BETA * D_FF_EXPERT ** -0.5),
    }


def reference(x, c, positions, w_in, ret_gn_g, mla_qn_g, mla_kvn_g, w_uq, w_ukv, w_out,
              w_ada, b_ada, ln1_g, ln1_b, ln2_g, ln2_b, w1_dense, w3_dense, w2_dense,
              w_router, w1_moe, w3_moe, w2_moe):
    rope_ret = rope_tables(positions, RET_DK)
    rope_dil = rope_tables(positions, DIL_DH)
    rope_mla = rope_tables(positions, MLA_ROPE)
    cond = jax.nn.silu(c)
    for l in range(DEPTH):
        mod = (cond @ w_ada[l] + b_ada[l])[:, None, :]
        sh1, sc1, g1, sh2, sc2, g2 = jnp.split(mod, 6, axis=-1)
        h = x * (1.0 + sc1) + sh1
        y = hybrid_mixer(h, w_in[l], ret_gn_g[l], mla_qn_g[l], mla_kvn_g[l], w_uq[l], w_ukv[l], w_out[l],
                         rope_ret, rope_dil, rope_mla)
        x = layer_norm(DEEPNORM_ALPHA * x + (1.0 + g1) * y, ln1_g[l], ln1_b[l])
        h = x * (1.0 + sc2) + sh2
        if l % 2 == 0:
            y = swiglu(h, w1_dense[l // 2], w3_dense[l // 2], w2_dense[l // 2])
        else:
            y = moe_swiglu(h, w_router[l // 2], w1_moe[l // 2], w3_moe[l // 2], w2_moe[l // 2])
        x = layer_norm(DEEPNORM_ALPHA * x + (1.0 + g2) * y, ln2_g[l], ln2_b[l])
    return x
```

```cpp
#ifndef HOST_EMU
#include <hip/hip_runtime.h>
#define HD __device__ __forceinline__
#else
#include <cmath>
#include <cstdio>
#include <cstdlib>
#include <cstring>
#include <vector>
#include <string>
#define HD inline
#endif
#include <cstdint>
#include <cstddef>

constexpr int D = 1024, NEXP = 8;
constexpr int RET_H = 4, DIL_H = 6, MLA_H = 6;
constexpr int RET_IN = 1024, DIL_IN = 1152, MLA_IN = 672, D_IN = 2848;
constexpr int ZO_RQ = 0, ZO_RK = 256, ZO_RV = 512, ZO_RG = 768;
constexpr int ZO_DQ = 1024, ZO_DK = 1408, ZO_DV = 1792;
constexpr int ZO_CQ = 2176, ZO_CKV = 2560, ZO_KR = 2816;
constexpr int QRANK = 384, KVRANK = 256;
constexpr int YO_RET = 0, YO_DIL = 256, YO_MLA = 640;
constexpr float LN_EPS = 1e-5f, RMS_EPS = 1e-6f;

struct Dims { int B, S, T, L, DFF, DFFE; float alpha; int pad; };

#ifdef HOST_EMU
static const double INVT[48] = {
#else
__constant__ double INVT[48] = {
#endif
0.15915494309189535, 0.11934937021124886, 0.089499401608891013, 0.067115083005227255, 0.050329212104487035, 0.037741584717419771, 0.028302195830623399, 0.02122365276477766, 0.015915494309189534, 0.011934937021124886, 0.0089499401608891024, 0.0067115083005227253, 0.0050329212104487037, 0.0037741584717419772, 0.0028302195830623399, 0.0021223652764777662, 0.0015915494309189536, 0.0011934937021124885, 0.00089499401608891024, 0.0006711508300522726, 0.00050329212104487033, 0.00037741584717419774, 0.00028302195830623395, 0.00021223652764777661, 0.00015915494309189535, 0.00011934937021124886, 8.9499401608891018e-05, 6.7115083005227254e-05, 5.0329212104487035e-05, 3.7741584717419777e-05, 2.8302195830623396e-05, 2.1223652764777659e-05, 0.15915494309189535, 0.089499401608891013, 0.050329212104487035, 0.028302195830623399, 0.015915494309189534, 0.0089499401608891024, 0.0050329212104487037, 0.0028302195830623399, 0.0015915494309189536, 0.00089499401608891024, 0.00050329212104487033, 0.00028302195830623395, 0.00015915494309189535, 8.9499401608891018e-05, 5.0329212104487035e-05, 2.8302195830623396e-05};

HD float f_exp(float x) { return expf(x); }
HD float f_silu(float x) { return x / (1.0f + expf(-x)); }
HD float f_rsqrt(float x) { return 1.0f / sqrtf(x); }
HD void sincos_turns(float fr, float& s, float& c) {
#ifdef HOST_EMU
    s = (float)std::sin(6.283185307179586 * (double)fr); c = (float)std::cos(6.283185307179586 * (double)fr);
#else
    s = __builtin_amdgcn_sinf(fr); c = __builtin_amdgcn_cosf(fr);
#endif
}

struct KMod { const float* c; const float* w_ada; const float* b_ada; float* mod; int B, L;
    HD void operator()(long ix, long) const { const int j = (int)(ix % (6 * D)); const int b = (int)((ix / (6 * D)) % B); const int l = (int)(ix / ((long)6 * D * B));
        const float* w = w_ada + (size_t)l * D * 6 * D + j; float acc = b_ada[(size_t)l * 6 * D + j];
        for (int k = 0; k < D; ++k) acc += f_silu(c[b * D + k]) * w[(size_t)k * 6 * D];
        mod[ix] = acc; } };
struct KTab { const int* pos; float* tab;
    HD void operator()(long ix, long) const { const long t = ix / 48; const int i = (int)(ix % 48); const double x = (double)pos[t] * INVT[i]; const float fr = (float)(x - floor(x)); float s, c; sincos_turns(fr, s, c);
        float* r = tab + t * 96; if (i < 32) { r[i] = c; r[32 + i] = s; } else { r[64 + (i - 32)] = c; r[80 + (i - 32)] = s; } } };
struct KModulate { const float* x; const float* mod_lb;   int sh_off, sc_off; float* h; int S; int pad;
    HD void operator()(long ix, long) const { const long t = ix / D; const int d = (int)(ix % D); const int b = (int)(t / S); const float* m = mod_lb + (size_t)b * 6 * D;
        h[ix] = x[ix] * (1.0f + m[sc_off + d]) + m[sh_off + d]; } };
struct KGemm { const float* A; const float* W; float* C; int lda, ldw, ldc, M, N, K;
    HD void operator()(long ix, long iy) const { const int n = (int)ix; if (n >= N) return; const int m0 = (int)iy * 8; float acc[8];
#pragma unroll
        for (int i = 0; i < 8; ++i) acc[i] = 0.f;
        for (int k = 0; k < K; ++k) { const float w = W[(size_t)k * ldw + n];
#pragma unroll
            for (int i = 0; i < 8; ++i) acc[i] += A[(size_t)(m0 + i) * lda + k] * w; }
#pragma unroll
        for (int i = 0; i < 8; ++i) if (m0 + i < M) C[(size_t)(m0 + i) * ldc + n] = acc[i]; } };
struct KRopeZ { float* z; const float* tab;
    HD void operator()(long ix, long) const { const long t = ix / 656; const int u = (int)(ix % 656); float* zr = z + t * D_IN; const float* tb = tab + t * 96;
        int base, i, half; float c, s;
        if (u < 640) { int hh; if (u < 128) { hh = u / 32; base = ZO_RQ + hh * 64; } else if (u < 256) { hh = (u - 128) / 32; base = ZO_RK + hh * 64; } else if (u < 448) { hh = (u - 256) / 32; base = ZO_DQ + hh * 64; } else { hh = (u - 448) / 32; base = ZO_DK + hh * 64; }
            i = u % 32; half = 32; c = tb[i]; s = tb[32 + i]; }
        else { i = u - 640; base = ZO_KR; half = 16; c = tb[64 + i]; s = tb[80 + i]; }
        const float x1 = zr[base + i], x2 = zr[base + half + i]; zr[base + i] = x1 * c - x2 * s; zr[base + half + i] = x2 * c + x1 * s; } };
struct KRet { const float* z; const float* gn_g; float* ycat; int S; int pad;
    HD void operator()(long ix, long) const { const int t = (int)(ix % S); const int h = (int)((ix / S) % RET_H); const int b = (int)(ix / ((long)S * RET_H));
        const float lg2 = log2f(1.0f - exp2f(-5.0f - (float)h));
        const float* zb = z + (size_t)b * S * D_IN; const float* qp = zb + (size_t)t * D_IN + ZO_RQ + h * 64; float q[64], o[64];
#pragma unroll
        for (int d = 0; d < 64; ++d) { q[d] = qp[d] * 0.125f; o[d] = 0.f; }
        for (int j = 0; j <= t; ++j) { const float* kp = zb + (size_t)j * D_IN + ZO_RK + h * 64; const float* vp = zb + (size_t)j * D_IN + ZO_RV + h * 64; float s = 0.f;
#pragma unroll
            for (int d = 0; d < 64; ++d) s += q[d] * kp[d];
            s *= exp2f((float)(t - j) * lg2);
#pragma unroll
            for (int d = 0; d < 64; ++d) o[d] += s * vp[d]; }
        float mu = 0.f;
#pragma unroll
        for (int d = 0; d < 64; ++d) mu += o[d];
        mu *= (1.0f / 64.0f); float var = 0.f;
#pragma unroll
        for (int d = 0; d < 64; ++d) { const float dd = o[d] - mu; var += dd * dd; }
        const float rs = f_rsqrt(var * (1.0f / 64.0f) + LN_EPS);
        const float* gp = zb + (size_t)t * D_IN + ZO_RG + h * 64; float* yp = ycat + ((size_t)b * S + t) * D + YO_RET + h * 64;
#pragma unroll
        for (int d = 0; d < 64; ++d) yp[d] = f_silu(gp[d]) * ((o[d] - mu) * rs * gn_g[h * 64 + d]); } };
struct KDil { const float* z; float* ycat; int S; int pad;
    HD void operator()(long ix, long) const { const int t = (int)(ix % S); const int h = (int)((ix / S) % DIL_H); const int b = (int)(ix / ((long)S * DIL_H));
        const float* zb = z + (size_t)b * S * D_IN; const float* qp = zb + (size_t)t * D_IN + ZO_DQ + h * 64; float q[64], o[64];
#pragma unroll
        for (int d = 0; d < 64; ++d) { q[d] = qp[d] * 0.125f; o[d] = 0.f; }
        float m = -INFINITY, l = 0.f;
        for (int p = 0; p < 3; ++p) { const int r = (p == 0) ? 1 : (p == 1) ? 4 : 16;
            for (int j = 0; j <= 128; ++j) { const int kpos = t - j * r; if (kpos < 0) break;
                const float* kp = zb + (size_t)kpos * D_IN + ZO_DK + h * 64; const float* vp = zb + (size_t)kpos * D_IN + ZO_DV + h * 64; float s = 0.f;
#pragma unroll
                for (int d = 0; d < 64; ++d) s += q[d] * kp[d];
                const float mn = fmaxf(m, s), corr = f_exp(m - mn), pe = f_exp(s - mn); l = l * corr + pe; m = mn;
#pragma unroll
                for (int d = 0; d < 64; ++d) o[d] = o[d] * corr + pe * vp[d]; } }
        const float il = 1.0f / l; float* yp = ycat + ((size_t)b * S + t) * D + YO_DIL + h * 64;
#pragma unroll
        for (int d = 0; d < 64; ++d) yp[d] = o[d] * il; } };
struct KMlaNorm { const float* z; const float* qn_g; const float* kvn_g; float* cqn; float* ckvn;
    HD void operator()(long t, long) const { const float* zr = z + (size_t)t * D_IN; float s = 0.f;
        for (int i = 0; i < QRANK; ++i) s += zr[ZO_CQ + i] * zr[ZO_CQ + i];
        const float rq = f_rsqrt(s * (1.0f / QRANK) + RMS_EPS);
        for (int i = 0; i < QRANK; ++i) cqn[(size_t)t * QRANK + i] = zr[ZO_CQ + i] * rq * qn_g[i];
        s = 0.f; for (int i = 0; i < KVRANK; ++i) s += zr[ZO_CKV + i] * zr[ZO_CKV + i];
        const float rk = f_rsqrt(s * (1.0f / KVRANK) + RMS_EPS);
        for (int i = 0; i < KVRANK; ++i) ckvn[(size_t)t * KVRANK + i] = zr[ZO_CKV + i] * rk * kvn_g[i]; } };
struct KRopeQ { float* qm; const float* tab;
    HD void operator()(long ix, long) const { const long t = ix / 96; const int u = (int)(ix % 96); const int h = u / 16, i = u % 16; float* p = qm + t * 576 + h * 96 + 64; const float c = tab[t * 96 + 64 + i], s = tab[t * 96 + 80 + i];
        const float x1 = p[i], x2 = p[16 + i]; p[i] = x1 * c - x2 * s; p[16 + i] = x2 * c + x1 * s; } };
struct KMla { const float* qm; const float* kvm; const float* z; float* ycat; int S; int pad;
    HD void operator()(long ix, long) const { const int t = (int)(ix % S); const int h = (int)((ix / S) % MLA_H); const int b = (int)(ix / ((long)S * MLA_H));
        const size_t r0 = (size_t)b * S; const float sc = 0.10206207261596577f;
        const float* qp = qm + (r0 + t) * 576 + h * 96; float q[96], o[64];
#pragma unroll
        for (int d = 0; d < 96; ++d) q[d] = qp[d] * sc;
#pragma unroll
        for (int d = 0; d < 64; ++d) o[d] = 0.f;
        float m = -INFINITY, l = 0.f;
        for (int j = 0; j <= t; ++j) { const float* kn = kvm + (r0 + j) * 768 + h * 128; const float* kr = z + (r0 + j) * D_IN + ZO_KR; const float* vp = kn + 64; float s = 0.f;
#pragma unroll
            for (int d = 0; d < 64; ++d) s += q[d] * kn[d];
#pragma unroll
            for (int d = 0; d < 32; ++d) s += q[64 + d] * kr[d];
            const float mn = fmaxf(m, s), corr = f_exp(m - mn), pe = f_exp(s - mn); l = l * corr + pe; m = mn;
#pragma unroll
            for (int d = 0; d < 64; ++d) o[d] = o[d] * corr + pe * vp[d]; }
        const float il = 1.0f / l; float* yp = ycat + (r0 + t) * D + YO_MLA + h * 64;
#pragma unroll
        for (int d = 0; d < 64; ++d) yp[d] = o[d] * il; } };
struct KLn { const float* xin; float* xout; const float* Y; const int* tslot; const float* tgate; const float* gmod;
    const float* lng; const float* lnb; const float* hmod;   int sh_off, sc_off; float* h; int S; float alpha;
    HD float yv(long t, int d) const { if (tslot) return tgate[t * 2] * Y[(size_t)tslot[t * 2] * D + d] + tgate[t * 2 + 1] * Y[(size_t)tslot[t * 2 + 1] * D + d]; return Y[(size_t)t * D + d]; }
    HD void operator()(long t, long) const { const int b = (int)(t / S); const float* g = gmod + (size_t)b * 6 * D; float mu = 0.f;
        for (int d = 0; d < D; ++d) mu += alpha * xin[(size_t)t * D + d] + (1.0f + g[d]) * yv(t, d);
        mu *= (1.0f / D); float var = 0.f;
        for (int d = 0; d < D; ++d) { const float v = alpha * xin[(size_t)t * D + d] + (1.0f + g[d]) * yv(t, d) - mu; var += v * v; }
        const float rs = f_rsqrt(var * (1.0f / D) + LN_EPS); const float* hm = hmod ? hmod + (size_t)b * 6 * D : nullptr;
        for (int d = 0; d < D; ++d) { const float v = alpha * xin[(size_t)t * D + d] + (1.0f + g[d]) * yv(t, d); const float xn = (v - mu) * rs * lng[d] + lnb[d]; xout[(size_t)t * D + d] = xn;
            if (hm) h[(size_t)t * D + d] = xn * (1.0f + hm[sc_off + d]) + hm[sh_off + d]; } } };
struct KRouter { const float* h; const float* wr; int* topi; float* gate; int* counts;
    HD void operator()(long t, long) const { float lg[NEXP];
#pragma unroll
        for (int e = 0; e < NEXP; ++e) lg[e] = 0.f;
        for (int d = 0; d < D; ++d) { const float hv = h[(size_t)t * D + d];
#pragma unroll
            for (int e = 0; e < NEXP; ++e) lg[e] += hv * wr[d * NEXP + e]; }
        int i0 = 0; float v0 = lg[0];
#pragma unroll
        for (int e = 1; e < NEXP; ++e) if (lg[e] > v0) { v0 = lg[e]; i0 = e; }
        int i1 = -1; float v1 = -INFINITY;
#pragma unroll
        for (int e = 0; e < NEXP; ++e) if (e != i0 && lg[e] > v1) { v1 = lg[e]; i1 = e; }
        const float g0 = 1.0f / (1.0f + f_exp(v1 - v0)); topi[t * 2] = i0; topi[t * 2 + 1] = i1; gate[t * 2] = g0; gate[t * 2 + 1] = 1.0f - g0;
#ifdef HOST_EMU
        counts[i0]++; counts[i1]++;
#else
        atomicAdd(&counts[i0], 1); atomicAdd(&counts[i1], 1);
#endif
    } };
struct KScan { int* counts; int* rt; int padm; int pad;
    HD void operator()(long, long) const { int acc = 0; for (int e = 0; e < NEXP; ++e) { rt[e] = acc; acc += (counts[e] + padm - 1) / padm * padm; rt[16 + e] = 0; } rt[8] = acc; rt[9] = acc; } };
struct KFillI { int* p; int v; int pad; HD void operator()(long ix, long) const { p[ix] = v; } };
struct KFill { const int* topi; int* rt; int* slot_tok; int* tslot;
    HD void operator()(long t, long) const {
        for (int k = 0; k < 2; ++k) { const int e = topi[t * 2 + k];
#ifdef HOST_EMU
            const int pos = rt[16 + e]++;
#else
            const int pos = atomicAdd(&rt[16 + e], 1);
#endif
            const int slot = rt[e] + pos; slot_tok[slot] = (int)t; tslot[t * 2 + k] = slot; } } };
struct KFfn1 { const float* h; const float* W1; const float* W3; float* FF; const int* slot_tok; const int* rt;   int F, s_base, s_end, pad;
    HD void operator()(long ix, long iy) const { const int f = (int)ix; if (f >= F) return; const int s0 = s_base + (int)iy * 8; if (s0 >= s_end) return;
        int e = 0; if (rt) { for (int k = 1; k < NEXP; ++k) if (s0 >= rt[k]) e = k; if (s0 >= rt[8]) return; }
        const float* w1 = W1 + (size_t)e * D * F + f; const float* w3 = W3 + (size_t)e * D * F + f; const float* hp[8]; float a1[8], a3[8];
#pragma unroll
        for (int i = 0; i < 8; ++i) { const int tok = slot_tok ? slot_tok[s0 + i] : (s0 + i); hp[i] = tok >= 0 ? h + (size_t)tok * D : nullptr; a1[i] = 0.f; a3[i] = 0.f; }
        for (int d = 0; d < D; ++d) { const float x1 = w1[(size_t)d * F], x3 = w3[(size_t)d * F];
#pragma unroll
            for (int i = 0; i < 8; ++i) { const float hv = hp[i] ? hp[i][d] : 0.f; a1[i] += hv * x1; a3[i] += hv * x3; } }
#pragma unroll
        for (int i = 0; i < 8; ++i) FF[(size_t)(s0 - s_base + i) * F + f] = f_silu(a1[i]) * a3[i]; } };
struct KFfn2 { const float* FF; const float* W2; float* Y; const int* rt; int F, s_base, s_end, pad;
    HD void operator()(long ix, long iy) const { const int n = (int)ix; if (n >= D) return; const int s0 = s_base + (int)iy * 8; if (s0 >= s_end) return;
        int e = 0; if (rt) { for (int k = 1; k < NEXP; ++k) if (s0 >= rt[k]) e = k; if (s0 >= rt[8]) return; }
        const float* w2 = W2 + (size_t)e * F * D + n; float acc[8];
#pragma unroll
        for (int i = 0; i < 8; ++i) acc[i] = 0.f;
        for (int f = 0; f < F; ++f) { const float w = w2[(size_t)f * D];
#pragma unroll
            for (int i = 0; i < 8; ++i) acc[i] += FF[(size_t)(s0 - s_base + i) * F + f] * w; }
#pragma unroll
        for (int i = 0; i < 8; ++i) Y[(size_t)(s0 + i) * D + n] = acc[i]; } };

static_assert(sizeof(KMod) == 40 && sizeof(KTab) == 16 && sizeof(KModulate) == 40 && sizeof(KGemm) == 48 && sizeof(KRopeZ) == 16 && sizeof(KRet) == 32 && sizeof(KDil) == 24 && sizeof(KMlaNorm) == 40 && sizeof(KRopeQ) == 16 && sizeof(KMla) == 40, "no padding");
static_assert(sizeof(KLn) == 96 && sizeof(KRouter) == 40 && sizeof(KScan) == 24 && sizeof(KFillI) == 16 && sizeof(KFill) == 32 && sizeof(KFfn1) == 64 && sizeof(KFfn2) == 48, "no padding");
#ifdef HOST_EMU
template <class F> void run(F f, long nx, long ny, bool serial = false) {
    if (serial) { for (long y = 0; y < ny; ++y) for (long x = 0; x < nx; ++x) f(x, y); return; }
    const long n = nx * ny;
#pragma omp parallel for schedule(dynamic, 64)
    for (long i = 0; i < n; ++i) f(i % nx, i / nx);
}
#define RUN(f, nx, ny) run(f, nx, ny)
#define RUN_SERIAL(f, nx, ny) run(f, nx, ny, true)
#else
template <class F> __global__ void __launch_bounds__(256) kern(F f, long nx) { const long ix = (long)blockIdx.x * 256 + threadIdx.x; if (ix < nx) f(ix, (long)blockIdx.y); }
static hipStream_t g_stream;
template <class F> void run(F f, long nx, long ny) { dim3 grid((unsigned)((nx + 255) / 256), (unsigned)ny); hipLaunchKernelGGL(kern<F>, grid, dim3(256), 0, g_stream, f, nx); }
#define RUN(f, nx, ny) run(f, nx, ny)
#define RUN_SERIAL(f, nx, ny) run(f, nx, ny)
#endif

static void forward(const void* const* in, float* out, unsigned char* ws, Dims dm) {
    const int B = dm.B, S = dm.S, T = dm.T, L = dm.L, DFF = dm.DFF, DFFE = dm.DFFE;
    const float* x_in = (const float*)in[0]; const float* c = (const float*)in[1]; const int* pos = (const int*)in[2];
    const float* w_in = (const float*)in[3]; const float* ret_gn = (const float*)in[4]; const float* qn_g = (const float*)in[5]; const float* kvn_g = (const float*)in[6];
    const float* w_uq = (const float*)in[7]; const float* w_ukv = (const float*)in[8]; const float* w_out = (const float*)in[9]; const float* w_ada = (const float*)in[10]; const float* b_ada = (const float*)in[11];
    const float* ln1_g = (const float*)in[12]; const float* ln1_b = (const float*)in[13]; const float* ln2_g = (const float*)in[14]; const float* ln2_b = (const float*)in[15];
    const float* w1d = (const float*)in[16]; const float* w3d = (const float*)in[17]; const float* w2d = (const float*)in[18]; const float* w_router = (const float*)in[19];
    const float* w1m = (const float*)in[20]; const float* w3m = (const float*)in[21]; const float* w2m = (const float*)in[22];
    size_t off = 0; auto take = [&](size_t bytes) { size_t o = off; off += (bytes + 255) & ~(size_t)255; return ws + o; };
    float* MOD = (float*)take((size_t)L * B * 6 * D * 4); float* TAB = (float*)take((size_t)T * 96 * 4);
    int* RT = (int*)take(256); int* COUNTS = (int*)take(256); int* TOPI = (int*)take((size_t)T * 2 * 4); float* GATE = (float*)take((size_t)T * 2 * 4); int* TSLOT = (int*)take((size_t)T * 2 * 4);
    const int MAXSLOT = 2 * T + NEXP * 8; int* SLOTTOK = (int*)take((size_t)MAXSLOT * 4);
    float* H = (float*)take((size_t)T * D * 4); float* YCAT = (float*)take((size_t)T * D * 4);
    size_t r1 = (size_t)T * D_IN * 4; if ((size_t)T * DFF * 4 > r1) r1 = (size_t)T * DFF * 4; float* R1 = (float*)take(r1);
    size_t r2 = (size_t)T * (QRANK + KVRANK + 576 + 768) * 4; if ((size_t)MAXSLOT * D * 4 > r2) r2 = (size_t)MAXSLOT * D * 4; float* R2 = (float*)take(r2);
    float* Z = R1; float* FF = R1; float* CQN = R2; float* CKVN = CQN + (size_t)T * QRANK; float* QM = CKVN + (size_t)T * KVRANK; float* KVM = QM + (size_t)T * 576; float* Y = R2;
    float* X = out;
    RUN((KMod{c, w_ada, b_ada, MOD, B, L}), (long)L * B * 6 * D, 1);
    RUN((KTab{pos, TAB}), (long)T * 48, 1);
    for (int l = 0; l < L; ++l) {
        const float* modl = MOD + (size_t)l * B * 6 * D;
        if (l == 0) RUN((KModulate{x_in, modl, 0, D, H, S, 0}), (long)T * D, 1);
        RUN((KGemm{H, w_in + (size_t)l * D * D_IN, Z, D, D_IN, D_IN, T, D_IN, D}), D_IN, T / 8);
        RUN((KRopeZ{Z, TAB}), (long)T * 656, 1);
        RUN((KRet{Z, ret_gn + l * 256, YCAT, S, 0}), (long)B * RET_H * S, 1);
        RUN((KDil{Z, YCAT, S, 0}), (long)B * DIL_H * S, 1);
        RUN((KMlaNorm{Z, qn_g + l * QRANK, kvn_g + l * KVRANK, CQN, CKVN}), T, 1);
        RUN((KGemm{CQN, w_uq + (size_t)l * QRANK * 576, QM, QRANK, 576, 576, T, 576, QRANK}), 576, T / 8);
        RUN((KGemm{CKVN, w_ukv + (size_t)l * KVRANK * 768, KVM, KVRANK, 768, 768, T, 768, KVRANK}), 768, T / 8);
        RUN((KRopeQ{QM, TAB}), (long)T * 96, 1);
        RUN((KMla{QM, KVM, Z, YCAT, S, 0}), (long)B * MLA_H * S, 1);
        RUN((KGemm{YCAT, w_out + (size_t)l * D * D, Y, D, D, D, T, D, D}), D, T / 8);
        RUN((KLn{l == 0 ? x_in : X, X, Y, nullptr, nullptr, modl + 2 * D, ln1_g + l * D, ln1_b + l * D, modl, 3 * D, 4 * D, H, S, dm.alpha}), T, 1);
        const float* hmod_next = (l + 1 < L) ? MOD + (size_t)(l + 1) * B * 6 * D : nullptr;
        if (l % 2 == 0) {
            const int li = l / 2;
            RUN((KFfn1{H, w1d + (size_t)li * D * DFF, w3d + (size_t)li * D * DFF, FF, nullptr, nullptr, DFF, 0, T, 0}), DFF, T / 8);
            RUN((KFfn2{FF, w2d + (size_t)li * DFF * D, Y, nullptr, DFF, 0, T, 0}), D, T / 8);
            RUN((KLn{X, X, Y, nullptr, nullptr, modl + 5 * D, ln2_g + l * D, ln2_b + l * D, hmod_next, 0, D, H, S, dm.alpha}), T, 1);
        } else {
            const int li = l / 2;
            RUN((KFillI{COUNTS, 0, 0}), 16, 1);
            RUN((KFillI{SLOTTOK, -1, 0}), MAXSLOT, 1);
            RUN_SERIAL((KRouter{H, w_router + (size_t)li * D * NEXP, TOPI, GATE, COUNTS}), T, 1);
            RUN((KScan{COUNTS, RT, 8, 0}), 1, 1);
            RUN_SERIAL((KFill{TOPI, RT, SLOTTOK, TSLOT}), T, 1);
            const int CH = 8192;
            for (int s0 = 0; s0 < MAXSLOT; s0 += CH) { const int s1 = (s0 + CH < MAXSLOT) ? s0 + CH : MAXSLOT;
                RUN((KFfn1{H, w1m + (size_t)li * NEXP * D * DFFE, w3m + (size_t)li * NEXP * D * DFFE, FF, SLOTTOK, RT, DFFE, s0, s1, 0}), DFFE, (s1 - s0) / 8);
                RUN((KFfn2{FF, w2m + (size_t)li * NEXP * DFFE * D, Y, RT, DFFE, s0, s1, 0}), D, (s1 - s0) / 8); }
            RUN((KLn{X, X, Y, TSLOT, GATE, modl + 5 * D, ln2_g + l * D, ln2_b + l * D, hmod_next, 0, D, H, S, dm.alpha}), T, 1);
        }
    }
}

#ifndef HOST_EMU
extern "C" void kernel_launch(void* const* d_in, const int* in_sizes, int n_in, void* d_out, int out_size, void* d_ws, size_t ws_size, hipStream_t stream) {
    g_stream = stream;
    Dims dm{}; dm.B = 8; dm.S = 4096; dm.T = 32768; dm.L = 4; dm.DFF = 2816; dm.DFFE = 3584; dm.alpha = 1.6817928305074290f; dm.pad = 0;
    forward((const void* const*)d_in, (float*)d_out, (unsigned char*)d_ws, dm);
}
#else
static std::vector<char> readf(const std::string& p) { FILE* f = fopen(p.c_str(), "rb"); if (!f) { printf("cannot open %s\n", p.c_str()); exit(1); } fseek(f, 0, SEEK_END); long n = ftell(f); fseek(f, 0, SEEK_SET); std::vector<char> v(n); if (fread(v.data(), 1, n, f) != (size_t)n) exit(1); fclose(f); return v; }
int main() {
    FILE* mf = fopen("data/manifest.txt", "r"); Dims dm{}; if (fscanf(mf, "%d %d %d %d %d", &dm.B, &dm.S, &dm.L, &dm.DFF, &dm.DFFE) != 5) return 1; fclose(mf);
    dm.T = dm.B * dm.S; dm.alpha = powf(2.0f * dm.L, 0.25f);
    std::vector<std::vector<char>> ins(23); const void* inp[23];
    for (int i = 0; i < 23; ++i) { char nm[64]; snprintf(nm, 64, "data/in%02d.bin", i); ins[i] = readf(nm); inp[i] = ins[i].data(); }
    std::vector<char> exp = readf("data/expected.bin"); const size_t n = (size_t)dm.T * D;
    std::vector<float> out(n); std::vector<unsigned char> ws((size_t)1 << 31, 0xAA);
    forward(inp, out.data(), ws.data(), dm);
    const float* e = (const float*)exp.data(); double num = 0, den = 0, mx = 0; for (size_t i = 0; i < n; ++i) { const double d = (double)out[i] - e[i]; num += d * d; den += (double)e[i] * e[i]; if (fabs(d) > mx) mx = fabs(d); }
    printf("rvr = %.3e  maxabs = %.3e\n", num / den, mx);
    return 0;
}
#endif
```

```cpp
#include <hip/hip_runtime.h>
#include <cstdio>
#include <cstdint>

namespace pg8 {
#define PG8_LAS __attribute__((address_space(3)))
typedef unsigned short bf16_t;
typedef short bf16x8 __attribute__((ext_vector_type(8)));
typedef float f32x4 __attribute__((ext_vector_type(4)));
typedef unsigned u32x4 __attribute__((ext_vector_type(4)));
typedef unsigned u32x2 __attribute__((ext_vector_type(2)));
constexpr int BM = 256, BK = 64, HALF = 128, HTB = HALF * BK * 2, STAGE_BYTES = 8 * HTB, NXCD = 8, WGM = 8;

__host__ __device__ __forceinline__ int lds_byte(int r, int c) { const int st = (r >> 4) * 2 + (c >> 5), rr = r & 15, cc = c & 31, ob = rr * 64 + cc * 2; return st * 1024 + (ob ^ (((ob >> 9) & 1) << 5)); }
__host__ __device__ __forceinline__ void stage_rc(int b, int& R, int& C) { const int st = b / 1024, sb = b % 1024, swz = sb ^ (((sb >> 9) & 1) << 5); R = (st >> 1) * 16 + swz / 64; C = (st & 1) * 32 + (swz % 64) / 2; }
__host__ __device__ __forceinline__ int perm32(int rho) { const int n = rho >> 4, i = rho & 15; return 8 * (i >> 2) + 4 * n + (i & 3); }

struct Unit { int pm, pn, g; };
struct Gemm { const bf16_t* A; const bf16_t* Bt; int lda, ldb, K; int pad; long gstride; };

struct StaticOrder {
    int nM, nN, nwg, G, c;
    __device__ void init(int M, int N, int G_, int c_) { nM = M / BM; nN = N / BM; nwg = nM * nN; G = G_; c = c_; }
    __device__ bool next(int i, Unit& u) const {
        const long L = (long)i * G + c; if (L >= nwg) return false;
        int wgid = (int)L; { const int q = nwg / NXCD, r = nwg % NXCD, xcd = wgid % NXCD, off = wgid / NXCD; wgid = (xcd < r ? xcd * (q + 1) : r * (q + 1) + (xcd - r) * q) + off; }
        const int nig = WGM * nN, gid = wgid / nig, fm = gid * WGM, gsz = (nM - fm) < WGM ? (nM - fm) : WGM;
        u.pm = fm + ((wgid % nig) % gsz); u.pn = (wgid % nig) / gsz; u.g = 0; return true;
    }
};
struct GroupedOrder {
    int tp[9]; int nN, nwg, G, c;
    __device__ void init(const int* seg, int nN_, int G_, int c_) {
#pragma unroll
        for (int k = 0; k < 9; ++k) tp[k] = __builtin_amdgcn_readfirstlane(seg[k]) / BM;
        nN = nN_; nwg = tp[8] * nN; G = G_; c = c_; }
    __device__ bool next(int i, Unit& u) const {
        const long L = (long)i * G + c; if (L >= nwg) return false;
        const int wgid = (int)L, nM = tp[8];
        const int nig = WGM * nN, gid = wgid / nig, fm = gid * WGM, gsz = (nM - fm) < WGM ? (nM - fm) : WGM;
        u.pm = fm + ((wgid % nig) % gsz); u.pn = (wgid % nig) / gsz; int e = 0;
#pragma unroll
        for (int k = 1; k < 8; ++k) e += (u.pm >= tp[k]) ? 1 : 0;
        u.g = e; return true;
    }
};

__device__ __forceinline__ unsigned cvt_pk_bf16(float lo, float hi) { unsigned r; asm volatile("v_cvt_pk_bf16_f32 %0, %1, %2" : "=v"(r) : "v"(lo), "v"(hi)); return r; }

struct EpiBf16 {
    static constexpr bool PERM = true;
    bf16_t* O; int ldc; int ncols;
    __device__ __forceinline__ void operator()(const f32x4 (&acc)[2][2][4][2], const Unit& u, int wr, int wc, int fr, int fq) const {
        const int row0 = u.pm * BM + wr * 64 + fr; const int col0 = u.pn * BM + wc * 32 + 8 * fq;
#pragma unroll
        for (int ai = 0; ai < 2; ++ai)
#pragma unroll
            for (int m = 0; m < 4; ++m) { bf16_t* rowp = O + (size_t)(row0 + ai * HALF + m * 16) * ldc + col0;
#pragma unroll
                for (int bj = 0; bj < 2; ++bj) { if (col0 + bj * HALF >= ncols) continue; const f32x4 v0 = acc[ai][bj][m][0], v1 = acc[ai][bj][m][1];
                    u32x4 w; w.x = cvt_pk_bf16(v0[0], v0[1]); w.y = cvt_pk_bf16(v0[2], v0[3]); w.z = cvt_pk_bf16(v1[0], v1[1]); w.w = cvt_pk_bf16(v1[2], v1[3]);
                    *(u32x4*)(rowp + bj * HALF) = w; } }
    }
};
struct EpiSwiglu {
    static constexpr bool PERM = false;
    bf16_t* O; int ldc;
    __device__ __forceinline__ void operator()(const f32x4 (&acc)[2][2][4][2], const Unit& u, int wr, int wc, int fr, int fq) const {
        const int row0 = u.pm * BM + wr * 64 + fr; const int col0 = u.pn * 128 + wc * 16 + 4 * fq;
#pragma unroll
        for (int ai = 0; ai < 2; ++ai)
#pragma unroll
            for (int m = 0; m < 4; ++m) { bf16_t* rowp = O + (size_t)(row0 + ai * HALF + m * 16) * ldc + col0;
#pragma unroll
                for (int bj = 0; bj < 2; ++bj) { const f32x4 a1 = acc[ai][bj][m][0], a3 = acc[ai][bj][m][1]; float o[4];
#pragma unroll
                    for (int j = 0; j < 4; ++j) o[j] = a1[j] * __builtin_amdgcn_rcpf(1.0f + __builtin_amdgcn_exp2f(-1.4426950408889634f * a1[j])) * a3[j];
                    u32x2 w; w.x = cvt_pk_bf16(o[0], o[1]); w.y = cvt_pk_bf16(o[2], o[3]); *(u32x2*)(rowp + bj * 64) = w; } }
    }
};
struct EpiMlaQ {
    static constexpr bool PERM = false;
    bf16_t* Q; const float* rs; const float* tab; float qscale; int pad;
    __device__ __forceinline__ void operator()(const f32x4 (&acc)[2][2][4][2], const Unit& u, int wr, int wc, int fr, int fq) const {
        const int row0 = u.pm * BM + wr * 64 + fr;
#pragma unroll
        for (int bj = 0; bj < 2; ++bj) { const int c0 = u.pn * BM + bj * HALF + wc * 32; if (c0 >= 576) continue; const bool rope = (c0 % 96) == 64;
#pragma unroll
            for (int ai = 0; ai < 2; ++ai)
#pragma unroll
                for (int m = 0; m < 4; ++m) { const int t = row0 + ai * HALF + m * 16; const float sc = rs[t * 2] * qscale; f32x4 v0 = acc[ai][bj][m][0] * sc, v1 = acc[ai][bj][m][1] * sc;
                    if (rope) { const f32x4 cs = *(const f32x4*)(tab + (size_t)t * 96 + 64 + 4 * fq), sn = *(const f32x4*)(tab + (size_t)t * 96 + 80 + 4 * fq); const f32x4 o0 = v0 * cs - v1 * sn, o1 = v1 * cs + v0 * sn; v0 = o0; v1 = o1; }
                    bf16_t* p = Q + (size_t)t * 576 + c0 + 4 * fq; u32x2 w; w.x = cvt_pk_bf16(v0[0], v0[1]); w.y = cvt_pk_bf16(v0[2], v0[3]); *(u32x2*)p = w; w.x = cvt_pk_bf16(v1[0], v1[1]); w.y = cvt_pk_bf16(v1[2], v1[3]); *(u32x2*)(p + 16) = w; } }
    }
};
struct EpiMlaKV {
    static constexpr bool PERM = true;
    bf16_t* Km; bf16_t* Vm; const float* rs;
    __device__ __forceinline__ void operator()(const f32x4 (&acc)[2][2][4][2], const Unit& u, int wr, int wc, int fr, int fq) const {
        const int row0 = u.pm * BM + wr * 64 + fr;
#pragma unroll
        for (int bj = 0; bj < 2; ++bj) { const int c8 = u.pn * BM + bj * HALF + wc * 32 + 8 * fq; const int head = c8 >> 7, off = c8 & 127;
#pragma unroll
            for (int ai = 0; ai < 2; ++ai)
#pragma unroll
                for (int m = 0; m < 4; ++m) { const int t = row0 + ai * HALF + m * 16; const float sc = rs[t * 2 + 1]; const f32x4 v0 = acc[ai][bj][m][0] * sc, v1 = acc[ai][bj][m][1] * sc;
                    bf16_t* p = (off < 64) ? Km + (size_t)t * 576 + head * 96 + off : Vm + (size_t)t * 384 + head * 64 + (off - 64);
                    u32x4 w; w.x = cvt_pk_bf16(v0[0], v0[1]); w.y = cvt_pk_bf16(v0[2], v0[3]); w.z = cvt_pk_bf16(v1[0], v1[1]); w.w = cvt_pk_bf16(v1[2], v1[3]); *(u32x4*)p = w; } }
    }
};

template <class Epi, class Sched, bool ALIGN_EPI>
__device__ __forceinline__ void gemm_phase(PG8_LAS unsigned char* lds, const Gemm g, const Sched& S, const Epi& E, const int tid) {
    const int wid = __builtin_amdgcn_readfirstlane(tid >> 6), lane = tid & 63, wr = wid >> 2, wc = wid & 3, fr = lane & 15, fq = lane >> 4;
    const int K = g.K, nt = K / BK;
    unsigned voffA[2], voffB[2];
#pragma unroll
    for (int i = 0; i < 2; ++i) { int R, C; stage_rc(tid * 16 + i * 8192, R, C); const int Rb = Epi::PERM ? ((R & ~31) + perm32(R & 31)) : R;
        voffA[i] = (unsigned)(R * g.lda + C) * 2u; voffB[i] = (unsigned)(Rb * g.ldb + C) * 2u; }
    const size_t kstep = (size_t)(BK * 2);
    const size_t hstepA = (size_t)HALF * g.lda * 2, hstepB = (size_t)HALF * g.ldb * 2;
    const size_t tstepA = 2 * hstepA, tstepB = 2 * hstepB;
    const unsigned ldsw = (unsigned)wid * 1024u;
    const int aoff = lds_byte(wr * 64 + fr, fq * 8), boff = lds_byte(wc * 32 + fr, fq * 8);
#define PG8_SA(b, h) (((b) * 2 + (h)) * HTB)
#define PG8_SB(b, h) ((4 + (b) * 2 + (h)) * HTB)
#define PG8_STAGE(bufoff, gbase, voff) do { _Pragma("unroll") for (int _i = 0; _i < 2; ++_i) \
        __builtin_amdgcn_global_load_lds((const unsigned*)((const char*)(gbase) + (voff)[_i]), (PG8_LAS unsigned*)(lds + (bufoff) + ldsw + _i * 8192), 16, 0, 0); } while (0)
#define PG8_LDA(dst, b, h) do { _Pragma("unroll") for (int m = 0; m < 4; ++m) _Pragma("unroll") for (int k = 0; k < 2; ++k) dst[m][k] = *(const PG8_LAS bf16x8*)(lds + PG8_SA(b, h) + aoff + m * 2048 + k * 1024); } while (0)
#define PG8_LDB(dst, b, h) do { _Pragma("unroll") for (int n = 0; n < 2; ++n) _Pragma("unroll") for (int k = 0; k < 2; ++k) dst[n][k] = *(const PG8_LAS bf16x8*)(lds + PG8_SB(b, h) + boff + n * 2048 + k * 1024); } while (0)
#define PG8_MMA(ai, bj, At, Bt) do { __builtin_amdgcn_s_setprio(1); _Pragma("unroll") for (int m = 0; m < 4; ++m) _Pragma("unroll") for (int n = 0; n < 2; ++n) _Pragma("unroll") for (int k = 0; k < 2; ++k) \
        acc[ai][bj][m][n] = __builtin_amdgcn_mfma_f32_16x16x32_bf16(Bt[n][k], At[m][k], acc[ai][bj][m][n], 0, 0, 0); __builtin_amdgcn_s_setprio(0); } while (0)
#define PG8_WAIT_V(n) asm volatile("s_waitcnt vmcnt(" #n ")" ::: "memory")
#define PG8_WAIT_L(n) asm volatile("s_waitcnt lgkmcnt(" #n ")" ::: "memory")
#define PG8_BAR __builtin_amdgcn_s_barrier()
#define PG8_SCHED __builtin_amdgcn_sched_barrier(0)
    Unit cur, nxt; int ui = 0;
    if (!S.next(0, cur)) return;
    f32x4 acc[2][2][4][2];
#pragma unroll
    for (int a = 0; a < 2; ++a)
#pragma unroll
        for (int b = 0; b < 2; ++b)
#pragma unroll
            for (int m = 0; m < 4; ++m)
#pragma unroll
                for (int n = 0; n < 2; ++n) acc[a][b][m][n] = (f32x4){0.f, 0.f, 0.f, 0.f};
    bf16x8 At[4][2], B0[2][2], B1[2][2];
    const char* cA = (const char*)g.A + (size_t)cur.pm * tstepA; const char* cB = (const char*)(g.Bt + (size_t)cur.g * g.gstride) + (size_t)cur.pn * tstepB;
    PG8_STAGE(PG8_SB(0, 0), cB, voffB); PG8_STAGE(PG8_SB(0, 1), cB + hstepB, voffB); PG8_STAGE(PG8_SA(0, 0), cA, voffA); PG8_STAGE(PG8_SA(0, 1), cA + hstepA, voffA);
    if (wr == 1) PG8_BAR;
    PG8_WAIT_V(2); PG8_BAR;
    PG8_STAGE(PG8_SB(1, 0), cB + kstep, voffB); PG8_STAGE(PG8_SA(1, 0), cA + kstep, voffA); PG8_STAGE(PG8_SB(1, 1), cB + hstepB + kstep, voffB);
    PG8_WAIT_V(6); PG8_BAR;
    for (;;) {
        const bool has_next = S.next(ui + 1, nxt);
        const char* nA = has_next ? (const char*)g.A + (size_t)nxt.pm * tstepA : cA; const char* nB = has_next ? (const char*)(g.Bt + (size_t)nxt.g * g.gstride) + (size_t)nxt.pn * tstepB : cB;
#pragma nounroll
        for (int t = 0; t < nt; t += 2) {
            const bool last = (t == nt - 2);
            const char* a1 = cA + (size_t)(t + 1) * kstep;
            const char* a2 = last ? nA : cA + (size_t)(t + 2) * kstep; const char* b2 = last ? nB : cB + (size_t)(t + 2) * kstep;
            const char* a3 = a2 + kstep; const char* b3 = b2 + kstep;
            PG8_LDB(B0, 0, 0); PG8_LDB(B1, 0, 1); PG8_SCHED; PG8_LDA(At, 0, 0); PG8_STAGE(PG8_SA(1, 1), a1 + hstepA, voffA);
            PG8_WAIT_V(8); PG8_WAIT_L(0); PG8_BAR; PG8_MMA(0, 0, At, B0); PG8_MMA(0, 1, At, B1); PG8_BAR; PG8_SCHED;
            PG8_LDA(At, 0, 1); PG8_STAGE(PG8_SB(0, 0), b2, voffB); PG8_STAGE(PG8_SB(0, 1), b2 + hstepB, voffB); PG8_STAGE(PG8_SA(0, 0), a2, voffA);
            PG8_WAIT_V(8); PG8_WAIT_L(0); PG8_BAR; PG8_MMA(1, 0, At, B0); PG8_MMA(1, 1, At, B1); PG8_BAR; PG8_SCHED;
            PG8_LDB(B0, 1, 0); PG8_LDB(B1, 1, 1); PG8_SCHED; PG8_LDA(At, 1, 0); PG8_STAGE(PG8_SA(0, 1), a2 + hstepA, voffA);
            PG8_WAIT_V(8); PG8_WAIT_L(0); PG8_BAR; PG8_MMA(0, 0, At, B0); PG8_MMA(0, 1, At, B1); PG8_BAR; PG8_SCHED;
            PG8_LDA(At, 1, 1); PG8_STAGE(PG8_SB(1, 0), b3, voffB); PG8_STAGE(PG8_SB(1, 1), b3 + hstepB, voffB); PG8_STAGE(PG8_SA(1, 0), a3, voffA);
            PG8_WAIT_V(8); PG8_WAIT_L(0); PG8_BAR; PG8_MMA(1, 0, At, B0); PG8_MMA(1, 1, At, B1); PG8_BAR; PG8_SCHED;
        }
        if constexpr (ALIGN_EPI) { if (wr == 0) PG8_BAR; }
        E(acc, cur, wr, wc, fr, fq);
        if (!has_next) break;
#pragma unroll
        for (int a = 0; a < 2; ++a)
#pragma unroll
            for (int b = 0; b < 2; ++b)
#pragma unroll
                for (int m = 0; m < 4; ++m)
#pragma unroll
                    for (int n = 0; n < 2; ++n) acc[a][b][m][n] = (f32x4){0.f, 0.f, 0.f, 0.f};
        cur = nxt; cA = nA; cB = nB; ++ui;
        if constexpr (ALIGN_EPI) { if (wr == 1) PG8_BAR; }
    }
    PG8_WAIT_V(0);
    if constexpr (!ALIGN_EPI) { if (wr == 0) PG8_BAR; }
    PG8_BAR;
#undef PG8_SA
#undef PG8_SB
#undef PG8_STAGE
#undef PG8_LDA
#undef PG8_LDB
#undef PG8_MMA
#undef PG8_WAIT_V
#undef PG8_WAIT_L
#undef PG8_BAR
#undef PG8_SCHED
}
}
constexpr int NWAVES = 8, NTHREADS = 512;
constexpr int NB = 8, SEQ = 4096, T = NB * SEQ, NL = 4, D = 1024, NEXP = 8;
constexpr int D_IN = 2848, ZLD = 3072;
constexpr int ZO_RQ = 0, ZO_RK = 256, ZO_RV = 512, ZO_RG = 768, ZO_DQ = 1024, ZO_DK = 1408, ZO_DV = 1792, ZO_CQ = 2176, ZO_CKV = 2560, ZO_KR = 2816;
constexpr int QRANK = 384, KVRANK = 256, QLD = 576, KLD = 576, VLD = 384;
constexpr int YO_RET = 0, YO_DIL = 256, YO_MLA = 640;
constexpr int DFF = 2816, DFFE = 3584;
constexpr float LN_EPS = 1e-5f, RMS_EPS = 1e-6f, DN_ALPHA = 1.6817928305074290f;
constexpr float LOG2E = 1.4426950408889634f;
constexpr float MLA_QSCALE = 0.10206207261596577f * LOG2E;
constexpr int MAXSLOT = 2 * T + NEXP * 256;

constexpr size_t MiB = 1u << 20;
constexpr size_t WS_CTL = 0, CTL_ZERO_BYTES = 1 * MiB;
constexpr size_t WS_MOD = 1 * MiB;
constexpr size_t WS_RS = 2 * MiB, WS_TOPI = WS_RS + 256 * 1024, WS_GATE = WS_TOPI + 256 * 1024, WS_TSLOT = WS_GATE + 256 * 1024, WS_SEG = WS_TSLOT + 256 * 1024;
constexpr size_t WS_TAB = 4 * MiB;
constexpr size_t WS_WIN = 16 * MiB, WS_WUQ = 22 * MiB, WS_WUKV = 23 * MiB, WS_WOUT = 24 * MiB, WS_WFF = 26 * MiB;
constexpr size_t WFF_W2_OFF_DENSE = (size_t)2 * DFF * D * 2, WFF_W2_OFF_MOE = (size_t)NEXP * 2 * DFFE * D * 2;
constexpr size_t WS_H = 194 * MiB;
constexpr size_t WS_A = 258 * MiB;
constexpr size_t WS_Z = WS_A, WS_QM = WS_A + 192 * MiB, WS_KM = WS_A + 228 * MiB, WS_VM = WS_A + 264 * MiB, WS_KVS = WS_A + 288 * MiB, WS_DILO = WS_A + 304 * MiB, WS_DILL = WS_A + 376 * MiB, WS_YCAT = WS_A + 380 * MiB;
constexpr size_t WS_FF = WS_A;
constexpr size_t WS_Y = 720 * MiB;
constexpr size_t WS_END = 852 * MiB;
static_assert((size_t)MAXSLOT * DFFE * 2 <= 462 * MiB && (size_t)MAXSLOT * D * 2 <= 132 * MiB && (size_t)T * ZLD * 2 == 192 * MiB, "ws map");
constexpr int CW_TMO = 0, CW_CODE = 1, CW_BAR = 4096, CW_CNT = 8192  , CW_CUR = 8448  , CW_Q = 8704  ;

constexpr int RING_OFF = 0, RING_BYTES = 131072;
constexpr int LDSCTL_OFF = RING_BYTES, MISC_OFF = LDSCTL_OFF + 320;
constexpr int LDS_BYTES = 147456;
constexpr int PTAB_OFF = LDSCTL_OFF + 512;

#define GAS __attribute__((address_space(1)))
#define LAS __attribute__((address_space(3)))
typedef unsigned short bf16;
typedef unsigned v4u __attribute__((ext_vector_type(4)));
typedef unsigned v2u __attribute__((ext_vector_type(2)));
typedef float f32x4 __attribute__((ext_vector_type(4)));
typedef GAS unsigned gu32;
#define RLX_AGENT __ATOMIC_RELAXED, __HIP_MEMORY_SCOPE_AGENT
#define LDS_WAIT() asm volatile("s_waitcnt lgkmcnt(0)" ::: "memory")
#define VM_WAIT() asm volatile("s_waitcnt vmcnt(0)" ::: "memory")
__device__ __forceinline__ unsigned f2bf(float f) { unsigned u = __builtin_bit_cast(unsigned, f); return (u + 0x7fffu + ((u >> 16) & 1u)) >> 16; }
__device__ __forceinline__ unsigned pk2(float lo, float hi) { return f2bf(lo) | (f2bf(hi) << 16); }
__device__ __forceinline__ float bf2f(unsigned short b) { return __builtin_bit_cast(float, (unsigned)b << 16); }
__device__ __forceinline__ float bflo(unsigned w) { return __builtin_bit_cast(float, w << 16); }
__device__ __forceinline__ float bfhi(unsigned w) { return __builtin_bit_cast(float, w & 0xffff0000u); }
__device__ __forceinline__ void ld8(const bf16* p, float* o) { const v4u w = *(const v4u*)p; o[0] = bflo(w.x); o[1] = bfhi(w.x); o[2] = bflo(w.y); o[3] = bfhi(w.y); o[4] = bflo(w.z); o[5] = bfhi(w.z); o[6] = bflo(w.w); o[7] = bfhi(w.w); }
__device__ __forceinline__ float fsilu(float x) { return x * __builtin_amdgcn_rcpf(1.0f + __builtin_amdgcn_exp2f(-LOG2E * x)); }

#define XB_TMO      128
#define XB_XCNT(j)  (256  + 64 * (j))
#define XB_XSUB(j)  (1280 + 64 * (j))
#define XB_XGEN(j)  (2304 + 64 * (j))
#define XB_TOP      3328
#define XB_TOPGEN   3392
#define XCD_BAR_WORDS 3456
#define XB_SPIN_CAP (1u << 18)
__device__ __forceinline__ unsigned xb_ld(unsigned* p)              { return __hip_atomic_load(p, __ATOMIC_RELAXED, __HIP_MEMORY_SCOPE_AGENT); }
__device__ __forceinline__ unsigned xb_add(unsigned* p, unsigned v) { return __hip_atomic_fetch_add(p, v, __ATOMIC_RELAXED, __HIP_MEMORY_SCOPE_AGENT); }
__device__ __forceinline__ unsigned xb_xcc_id() { return (unsigned)__builtin_amdgcn_s_getreg((3 << 11) | 20) & 0xFu; }
#define XB_SPIN(cond, bar) do { unsigned _sp = 0; while (cond) { __builtin_amdgcn_s_sleep(1); \
    if ((++_sp & 255u) == 0u) { if (xb_ld(&(bar)[XB_TMO])) break; if (_sp > XB_SPIN_CAP) { atomicAdd(&(bar)[XB_TMO], 1u); break; } } } } while (0)
struct XcdBarrier { unsigned* bar; unsigned x; volatile LAS unsigned* st; };
__device__ __forceinline__ XcdBarrier xcd_barrier_post(unsigned* bar, volatile LAS unsigned* st) {
    XcdBarrier b; b.bar = bar; b.x = xb_xcc_id(); b.st = st;
    if (threadIdx.x == 0) (void)xb_add(&bar[XB_XCNT(b.x)], 1u);
    return b;
}
__device__ __forceinline__ void xcd_barrier_complete(unsigned* bar, unsigned x, unsigned& nloc, unsigned& nx) {
    const unsigned G = gridDim.x * gridDim.y * gridDim.z;
    unsigned sum, cnt, mine, sp = 0u;
    for (;;) {
        sum = 0u; cnt = 0u; mine = 0u;
#pragma unroll
        for (unsigned j = 0; j < 16; ++j) { const unsigned c = xb_ld(&bar[XB_XCNT(j)]); sum += c; cnt += (c > 0u) ? 1u : 0u; mine = (j == x) ? c : mine; }
        if (sum == G) break;
        __builtin_amdgcn_s_sleep(1);
        if ((++sp & 255u) == 0u) { if (xb_ld(&bar[XB_TMO])) break; if (sp > XB_SPIN_CAP) { atomicAdd(&bar[XB_TMO], 1u); break; } }
    }
    nloc = mine > 0u ? mine : 1u; nx = cnt > 0u ? cnt : 1u;
}
__device__ __forceinline__ void xcd_barrier(const XcdBarrier& b) {
    asm volatile("s_waitcnt vmcnt(0)" ::: "memory");
    __syncthreads();
    if (threadIdx.x == 0) {
        unsigned* bar = b.bar;
        __builtin_amdgcn_s_waitcnt(0);
        unsigned nloc = b.st[0], nx = b.st[1];
        if (nloc == 0u) { xcd_barrier_complete(bar, b.x, nloc, nx); b.st[0] = nloc; b.st[1] = nx; }
        const unsigned old = xb_add(&bar[XB_XSUB(b.x)], 1u);
        const unsigned gen = old / nloc;
        if (old + 1u == (gen + 1u) * nloc) {
            __builtin_amdgcn_fence(__ATOMIC_RELEASE, "agent");
            asm volatile("s_waitcnt vmcnt(0)" ::: "memory");
            const unsigned og = xb_add(&bar[XB_TOP], 1u);
            const unsigned tg = og / nx;
            if (og + 1u == (tg + 1u) * nx) xb_add(&bar[XB_TOPGEN], 1u);
            else XB_SPIN(xb_ld(&bar[XB_TOPGEN]) == tg, bar);
            __builtin_amdgcn_fence(__ATOMIC_ACQUIRE, "agent");
            xb_add(&bar[XB_XGEN(b.x)], 1u);
            asm volatile("s_waitcnt vmcnt(0)" ::: "memory");
        } else {
            XB_SPIN(xb_ld(&bar[XB_XGEN(b.x)]) == gen, bar);
            __builtin_amdgcn_fence(__ATOMIC_ACQUIRE, "agent");
            asm volatile("s_waitcnt vmcnt(0)" ::: "memory");
        }
    }
    __syncthreads();
}

struct Frame {
    LAS unsigned char* lds; volatile LAS unsigned* MISC; gu32* ctl;
    int tid, lane, wave, vcu, G;
    __device__ __forceinline__ unsigned long long ptab(int i) const { const volatile LAS unsigned* p = (const volatile LAS unsigned*)(lds + PTAB_OFF) + 2 * i; const unsigned lo = p[0], hi = p[1];
        return ((unsigned long long)(unsigned)__builtin_amdgcn_readfirstlane((int)hi) << 32) | (unsigned)__builtin_amdgcn_readfirstlane((int)lo); }
    int wave_s;
    __device__ __forceinline__ void refresh() { int w = wave_s; asm volatile("" : "+s"(w)); int ln = (int)__builtin_amdgcn_mbcnt_hi(~0u, __builtin_amdgcn_mbcnt_lo(~0u, 0u)); asm volatile("" : "+v"(ln)); wave = w; lane = ln; tid = w * 64 + ln;
        unsigned long long c = ptab(24); ctl = (gu32*)c; }
    __device__ __forceinline__ const float* in(int i) const { return (const float*)ptab(i); }
    __device__ __forceinline__ float* outp() const { return (float*)ptab(23); }
    __device__ __forceinline__ unsigned char* wsp() const { return (unsigned char*)ptab(24); }
};
__constant__ double INVT[48] = {
0.15915494309189535, 0.11934937021124886, 0.089499401608891013, 0.067115083005227255, 0.050329212104487035, 0.037741584717419771, 0.028302195830623399, 0.02122365276477766, 0.015915494309189534, 0.011934937021124886, 0.0089499401608891024, 0.0067115083005227253, 0.0050329212104487037, 0.0037741584717419772, 0.0028302195830623399, 0.0021223652764777662, 0.0015915494309189536, 0.0011934937021124885, 0.00089499401608891024, 0.0006711508300522726, 0.00050329212104487033, 0.00037741584717419774, 0.00028302195830623395, 0.00021223652764777661, 0.00015915494309189535, 0.00011934937021124886, 8.9499401608891018e-05, 6.7115083005227254e-05, 5.0329212104487035e-05, 3.7741584717419777e-05, 2.8302195830623396e-05, 2.1223652764777659e-05, 0.15915494309189535, 0.089499401608891013, 0.050329212104487035, 0.028302195830623399, 0.015915494309189534, 0.0089499401608891024, 0.0050329212104487037, 0.0028302195830623399, 0.0015915494309189536, 0.00089499401608891024, 0.00050329212104487033, 0.00028302195830623395, 0.00015915494309189535, 8.9499401608891018e-05, 5.0329212104487035e-05, 2.8302195830623396e-05};

__device__ __forceinline__ float wave_sum(float v) {
#pragma unroll
    for (int o = 1; o < 64; o <<= 1) v += __shfl_xor(v, o);
    return v;
}
__device__ __forceinline__ void transpose_item(const float* W, int K, int N, bf16* WT, int mode, const float* kscale, LAS float* scr, int item, int lane) {
    const int nblk = N / 32, kb = item / nblk, nb = item % nblk, k0 = 64 * kb, n0 = 32 * nb;
#pragma unroll 8
    for (int i = 0; i < 32; ++i) { const int kk = 2 * i + (lane >> 5); float v = W[(size_t)(k0 + kk) * N + n0 + (lane & 31)]; if (kscale) v *= kscale[k0 + kk]; scr[kk * 33 + (lane & 31)] = v; }
    LDS_WAIT(); asm volatile("" ::: "memory");
    const int c = lane & 7;
#pragma unroll
    for (int j = 0; j < 4; ++j) { const int n = (lane >> 3) + 8 * j; const LAS float* s = scr + (8 * c) * 33 + n;
        v4u o; o.x = pk2(s[0 * 33], s[1 * 33]); o.y = pk2(s[2 * 33], s[3 * 33]); o.z = pk2(s[4 * 33], s[5 * 33]); o.w = pk2(s[6 * 33], s[7 * 33]);
        const int nn = n0 + n; const int row = (mode == 0) ? nn : (32 * (nn >> 4) + (nn & 15) + (mode == 2 ? 16 : 0));
        *(GAS v4u*)(WT + (size_t)row * K + k0 + 8 * c) = o; }
    LDS_WAIT(); asm volatile("" ::: "memory");
}
__device__ __forceinline__ void phase_convert(Frame& F, int l) {
    LAS float* scr = (LAS float*)(F.lds + RING_OFF + F.wave * 16384);
    const int gw = F.vcu * NWAVES + F.wave, NGW = F.G * NWAVES;
    bf16* WIN = (bf16*)(F.wsp() + WS_WIN); bf16* WUQ = (bf16*)(F.wsp() + WS_WUQ); bf16* WUKV = (bf16*)(F.wsp() + WS_WUKV); bf16* WOUT = (bf16*)(F.wsp() + WS_WOUT); bf16* WFF = (bf16*)(F.wsp() + WS_WFF);
    constexpr int I_IN = 16 * 89, I_UQ = 6 * 18, I_UKV = 4 * 24, I_OUT = 16 * 32, I_D1 = 16 * 88, I_D2 = 44 * 32, I_M1 = 16 * 112, I_M2 = 56 * 32;
    const bool moe = (l & 1) != 0; const int li = l >> 1;
    const int nff = moe ? NEXP * (2 * I_M1 + I_M2) : (2 * I_D1 + I_D2);
    const int nitems = I_IN + I_UQ + I_UKV + I_OUT + nff;
    for (int it = gw; it < nitems; it += NGW) {
        int r = it;
        if (r < I_IN) { transpose_item(F.in(3) + (size_t)l * D * D_IN, D, D_IN, WIN, 0, nullptr, scr, r, F.lane); continue; } r -= I_IN;
        if (r < I_UQ) { transpose_item(F.in(7) + (size_t)l * QRANK * 576, QRANK, 576, WUQ, 0, F.in(5) + l * QRANK, scr, r, F.lane); continue; } r -= I_UQ;
        if (r < I_UKV) { transpose_item(F.in(8) + (size_t)l * KVRANK * 768, KVRANK, 768, WUKV, 0, F.in(6) + l * KVRANK, scr, r, F.lane); continue; } r -= I_UKV;
        if (r < I_OUT) { transpose_item(F.in(9) + (size_t)l * D * D, D, D, WOUT, 0, nullptr, scr, r, F.lane); continue; } r -= I_OUT;
        if (!moe) {
            if (r < I_D1) { transpose_item(F.in(16) + (size_t)li * D * DFF, D, DFF, WFF, 1, nullptr, scr, r, F.lane); continue; } r -= I_D1;
            if (r < I_D1) { transpose_item(F.in(17) + (size_t)li * D * DFF, D, DFF, WFF, 2, nullptr, scr, r, F.lane); continue; } r -= I_D1;
            transpose_item(F.in(18) + (size_t)li * DFF * D, DFF, D, (bf16*)((unsigned char*)WFF + WFF_W2_OFF_DENSE), 0, nullptr, scr, r, F.lane);
        } else {
            const int per = 2 * I_M1 + I_M2; const int e = r / per; r -= e * per;
            bf16* w13 = WFF + (size_t)e * 2 * DFFE * D; bf16* w2 = (bf16*)((unsigned char*)WFF + WFF_W2_OFF_MOE) + (size_t)e * D * DFFE;
            if (r < I_M1) { transpose_item(F.in(20) + ((size_t)li * NEXP + e) * D * DFFE, D, DFFE, w13, 1, nullptr, scr, r, F.lane); continue; } r -= I_M1;
            if (r < I_M1) { transpose_item(F.in(21) + ((size_t)li * NEXP + e) * D * DFFE, D, DFFE, w13, 2, nullptr, scr, r, F.lane); continue; } r -= I_M1;
            transpose_item(F.in(22) + ((size_t)li * NEXP + e) * DFFE * D, DFFE, D, w2, 0, nullptr, scr, r, F.lane);
        }
    }
    const int gt = F.vcu * NTHREADS + F.tid, NT = F.G * NTHREADS;
    { GAS v4u* p = (GAS v4u*)(WIN + (size_t)D_IN * D); const int n = (ZLD - D_IN) * D / 8; unsigned zz = 0u; asm volatile("" : "+v"(zz)); for (int i = gt; i < n; i += NT) p[i] = (v4u){zz, zz, zz, zz}; }
    { GAS v4u* p = (GAS v4u*)(WUQ + (size_t)576 * QRANK); const int n = (768 - 576) * QRANK / 8; unsigned zz = 0u; asm volatile("" : "+v"(zz)); for (int i = gt; i < n; i += NT) p[i] = (v4u){zz, zz, zz, zz}; }
}
__device__ __forceinline__ void phase_mod_tab(Frame& F) {
    const int gt = F.vcu * NTHREADS + F.tid, NT = F.G * NTHREADS;
    float* MOD = (float*)(F.wsp() + WS_MOD); float* TAB = (float*)(F.wsp() + WS_TAB);
    const float* c = F.in(1); const float* w_ada = F.in(10); const float* b_ada = F.in(11); const int* pos = (const int*)F.in(2);
    for (int ix = gt; ix < NL * NB * 6 * D; ix += NT) { const int j = ix % (6 * D), b = (ix / (6 * D)) % NB, l = ix / (6 * D * NB);
        const float* w = w_ada + (size_t)l * D * 6 * D + j; float acc = b_ada[(size_t)l * 6 * D + j];
        for (int k = 0; k < D; ++k) acc += fsilu(c[b * D + k]) * w[(size_t)k * 6 * D];
        MOD[ix] = acc; }
    for (int ix = gt; ix < T * 48; ix += NT) { const int t = ix / 48, i = ix % 48; const double x = (double)pos[t] * INVT[i]; const float fr = (float)(x - floor(x));
        const float s = __builtin_amdgcn_sinf(fr), cc = __builtin_amdgcn_cosf(fr); float* r = TAB + (size_t)t * 96;
        if (i < 32) { r[i] = cc; r[32 + i] = s; } else { r[64 + (i - 32)] = cc; r[80 + (i - 32)] = s; } }
}
__device__ __forceinline__ void phase_modulate0(Frame& F) {
    const int gt = F.vcu * NTHREADS + F.tid, NT = F.G * NTHREADS; const float* MOD = (const float*)(F.wsp() + WS_MOD); bf16* H = (bf16*)(F.wsp() + WS_H); const float* x = F.in(0);
    for (int ix = gt; ix < T * D / 4; ix += NT) { const int t = ix / (D / 4), d = (ix % (D / 4)) * 4, b = t / SEQ; const float* m = MOD + (size_t)b * 6 * D;
        const f32x4 xv = *(const f32x4*)(x + (size_t)ix * 4), sh = *(const f32x4*)(m + d), sc = *(const f32x4*)(m + D + d); const f32x4 h = xv * (1.0f + sc) + sh;
        v2u w; w.x = pk2(h.x, h.y); w.y = pk2(h.z, h.w); *(v2u*)(H + (size_t)ix * 4) = w; }
}
__device__ __forceinline__ void phase_rope_stats(Frame& F) {
    const int gw = F.vcu * NWAVES + F.wave, NGW = F.G * NWAVES, lane = F.lane;
    bf16* Z = (bf16*)(F.wsp() + WS_Z); bf16* KM = (bf16*)(F.wsp() + WS_KM); const float* TAB = (const float*)(F.wsp() + WS_TAB); float* RS = (float*)(F.wsp() + WS_RS);
    for (int t = gw; t < T; t += NGW) { bf16* zr = Z + (size_t)t * ZLD; const float* tb = TAB + (size_t)t * 96;
#pragma unroll
        for (int k = 0; k < 10; ++k) { const int u = lane + 64 * k; int base;
            if (u < 128) base = ZO_RQ + (u >> 5) * 64; else if (u < 256) base = ZO_RK + ((u - 128) >> 5) * 64; else if (u < 448) base = ZO_DQ + ((u - 256) >> 5) * 64; else base = ZO_DK + ((u - 448) >> 5) * 64;
            const int i = u & 31; const float x1 = bf2f(zr[base + i]), x2 = bf2f(zr[base + 32 + i]), c = tb[i], s = tb[32 + i];
            zr[base + i] = (bf16)f2bf(x1 * c - x2 * s); zr[base + 32 + i] = (bf16)f2bf(x2 * c + x1 * s); }
        if (lane < 16) { const float x1 = bf2f(zr[ZO_KR + lane]), x2 = bf2f(zr[ZO_KR + 16 + lane]), c = tb[64 + lane], s = tb[80 + lane]; const bf16 o1 = (bf16)f2bf(x1 * c - x2 * s), o2 = (bf16)f2bf(x2 * c + x1 * s);
#pragma unroll
            for (int h = 0; h < 6; ++h) { KM[(size_t)t * KLD + h * 96 + 64 + lane] = o1; KM[(size_t)t * KLD + h * 96 + 80 + lane] = o2; } }
        float s1 = 0.f, s2 = 0.f;
#pragma unroll
        for (int k = 0; k < 6; ++k) { const float v = bf2f(zr[ZO_CQ + lane + 64 * k]); s1 += v * v; }
#pragma unroll
        for (int k = 0; k < 4; ++k) { const float v = bf2f(zr[ZO_CKV + lane + 64 * k]); s2 += v * v; }
        s1 = wave_sum(s1); s2 = wave_sum(s2);
        if (lane == 0) { RS[t * 2] = 1.0f / sqrtf(s1 * (1.0f / QRANK) + RMS_EPS); RS[t * 2 + 1] = 1.0f / sqrtf(s2 * (1.0f / KVRANK) + RMS_EPS); } }
}
__device__ __forceinline__ void phase_ret_simple(Frame& F, int l) {
    const int gt = F.vcu * NTHREADS + F.tid, NT = F.G * NTHREADS; const bf16* Z = (const bf16*)(F.wsp() + WS_Z); bf16* YC = (bf16*)(F.wsp() + WS_YCAT); const float* gn = F.in(4) + l * 256;
    for (int ix = gt; ix < NB * 4 * SEQ; ix += NT) { const int t = ix % SEQ, h = (ix / SEQ) % 4, b = ix / (SEQ * 4);
        const float lg2 = __builtin_amdgcn_logf(1.0f - __builtin_amdgcn_exp2f(-5.0f - (float)h));
        const bf16* zb = Z + (size_t)b * SEQ * ZLD; float q[64], o[64];
#pragma unroll
        for (int d = 0; d < 64; d += 8) ld8(zb + (size_t)t * ZLD + ZO_RQ + h * 64 + d, q + d);
#pragma unroll
        for (int d = 0; d < 64; ++d) { q[d] *= 0.125f; o[d] = 0.f; }
        for (int j = 0; j <= t; ++j) { const bf16* kp = zb + (size_t)j * ZLD + ZO_RK + h * 64; const bf16* vp = zb + (size_t)j * ZLD + ZO_RV + h * 64; float s = 0.f;
#pragma unroll
            for (int d = 0; d < 64; d += 8) { float kk[8]; ld8(kp + d, kk);
#pragma unroll
                for (int e = 0; e < 8; ++e) s += q[d + e] * kk[e]; }
            s *= __builtin_amdgcn_exp2f((float)(t - j) * lg2);
#pragma unroll
            for (int d = 0; d < 64; d += 8) { float vv[8]; ld8(vp + d, vv);
#pragma unroll
                for (int e = 0; e < 8; ++e) o[d + e] += s * vv[e]; } }
        float mu = 0.f;
#pragma unroll
        for (int d = 0; d < 64; ++d) mu += o[d];
        mu *= (1.0f / 64.0f); float var = 0.f;
#pragma unroll
        for (int d = 0; d < 64; ++d) { const float dd = o[d] - mu; var += dd * dd; }
        const float rs = 1.0f / sqrtf(var * (1.0f / 64.0f) + LN_EPS);
        const bf16* gp = zb + (size_t)t * ZLD + ZO_RG + h * 64; bf16* yp = YC + ((size_t)b * SEQ + t) * D + YO_RET + h * 64;
#pragma unroll
        for (int d = 0; d < 64; d += 8) { float gg[8]; ld8(gp + d, gg); v4u w; float r[8];
#pragma unroll
            for (int e = 0; e < 8; ++e) r[e] = fsilu(gg[e]) * ((o[d + e] - mu) * rs * gn[h * 64 + d + e]);
            w.x = pk2(r[0], r[1]); w.y = pk2(r[2], r[3]); w.z = pk2(r[4], r[5]); w.w = pk2(r[6], r[7]); *(v4u*)(yp + d) = w; } }
}
__device__ __forceinline__ void phase_dil_simple(Frame& F) {
    const int gt = F.vcu * NTHREADS + F.tid, NT = F.G * NTHREADS; const bf16* Z = (const bf16*)(F.wsp() + WS_Z); bf16* YC = (bf16*)(F.wsp() + WS_YCAT);
    for (int ix = gt; ix < NB * 6 * SEQ; ix += NT) { const int t = ix % SEQ, h = (ix / SEQ) % 6, b = ix / (SEQ * 6);
        const bf16* zb = Z + (size_t)b * SEQ * ZLD; float q[64], o[64];
#pragma unroll
        for (int d = 0; d < 64; d += 8) ld8(zb + (size_t)t * ZLD + ZO_DQ + h * 64 + d, q + d);
#pragma unroll
        for (int d = 0; d < 64; ++d) { q[d] *= 0.125f * LOG2E; o[d] = 0.f; }
        float m = -INFINITY, lsum = 0.f;
        for (int p = 0; p < 3; ++p) { const int r = (p == 0) ? 1 : (p == 1) ? 4 : 16;
            for (int j = 0; j <= 128; ++j) { const int kpos = t - j * r; if (kpos < 0) break;
                const bf16* kp = zb + (size_t)kpos * ZLD + ZO_DK + h * 64; const bf16* vp = zb + (size_t)kpos * ZLD + ZO_DV + h * 64; float s = 0.f;
#pragma unroll
                for (int d = 0; d < 64; d += 8) { float kk[8]; ld8(kp + d, kk);
#pragma unroll
                    for (int e = 0; e < 8; ++e) s += q[d + e] * kk[e]; }
                const float mn = fmaxf(m, s), corr = __builtin_amdgcn_exp2f(m - mn), pe = __builtin_amdgcn_exp2f(s - mn); lsum = lsum * corr + pe; m = mn;
#pragma unroll
                for (int d = 0; d < 64; d += 8) { float vv[8]; ld8(vp + d, vv);
#pragma unroll
                    for (int e = 0; e < 8; ++e) o[d + e] = o[d + e] * corr + pe * vv[e]; } } }
        const float il = 1.0f / lsum; bf16* yp = YC + ((size_t)b * SEQ + t) * D + YO_DIL + h * 64;
#pragma unroll
        for (int d = 0; d < 64; d += 8) { v4u w; w.x = pk2(o[d] * il, o[d + 1] * il); w.y = pk2(o[d + 2] * il, o[d + 3] * il); w.z = pk2(o[d + 4] * il, o[d + 5] * il); w.w = pk2(o[d + 6] * il, o[d + 7] * il); *(v4u*)(yp + d) = w; } }
}
__device__ __forceinline__ void phase_mla_simple(Frame& F) {
    const int gt = F.vcu * NTHREADS + F.tid, NT = F.G * NTHREADS; const bf16* QM = (const bf16*)(F.wsp() + WS_QM); const bf16* KM = (const bf16*)(F.wsp() + WS_KM); const bf16* VM = (const bf16*)(F.wsp() + WS_VM); bf16* YC = (bf16*)(F.wsp() + WS_YCAT);
    for (int ix = gt; ix < NB * 6 * SEQ; ix += NT) { const int t = ix % SEQ, h = (ix / SEQ) % 6, b = ix / (SEQ * 6); const size_t r0 = (size_t)b * SEQ;
        float q[96], o[64];
#pragma unroll
        for (int d = 0; d < 96; d += 8) ld8(QM + (r0 + t) * QLD + h * 96 + d, q + d);
#pragma unroll
        for (int d = 0; d < 64; ++d) o[d] = 0.f;
        float m = -INFINITY, lsum = 0.f;
        for (int j = 0; j <= t; ++j) { const bf16* kp = KM + (r0 + j) * KLD + h * 96; const bf16* vp = VM + (r0 + j) * VLD + h * 64; float s = 0.f;
#pragma unroll
            for (int d = 0; d < 96; d += 8) { float kk[8]; ld8(kp + d, kk);
#pragma unroll
                for (int e = 0; e < 8; ++e) s += q[d + e] * kk[e]; }
            const float mn = fmaxf(m, s), corr = __builtin_amdgcn_exp2f(m - mn), pe = __builtin_amdgcn_exp2f(s - mn); lsum = lsum * corr + pe; m = mn;
#pragma unroll
            for (int d = 0; d < 64; d += 8) { float vv[8]; ld8(vp + d, vv);
#pragma unroll
                for (int e = 0; e < 8; ++e) o[d + e] = o[d + e] * corr + pe * vv[e]; } }
        const float il = 1.0f / lsum; bf16* yp = YC + (r0 + t) * D + YO_MLA + h * 64;
#pragma unroll
        for (int d = 0; d < 64; d += 8) { v4u w; w.x = pk2(o[d] * il, o[d + 1] * il); w.y = pk2(o[d + 2] * il, o[d + 3] * il); w.z = pk2(o[d + 4] * il, o[d + 5] * il); w.w = pk2(o[d + 6] * il, o[d + 7] * il); *(v4u*)(yp + d) = w; } }
}
template <bool MOE_Y>
__device__ __forceinline__ void phase_ln(Frame& F, const float* xin, float* xout, const float* gmod  , const float* lng, const float* lnb,
                                         const float* hm  , int sh_off, int sc_off, const float* wr  , int li) {
    const int gw = F.vcu * NWAVES + F.wave, NGW = F.G * NWAVES, lane = F.lane;
    const bf16* Y = (const bf16*)(F.wsp() + WS_Y); bf16* H = (bf16*)(F.wsp() + WS_H); int* TOPI = (int*)(F.wsp() + WS_TOPI); float* GATE = (float*)(F.wsp() + WS_GATE); const int* TSLOT = (const int*)(F.wsp() + WS_TSLOT);
    volatile LAS unsigned* lcnt = F.MISC + 16;
    if (wr) { if (F.tid < 8) lcnt[F.tid] = 0u; __syncthreads(); }
    for (int t = gw; t < T; t += NGW) { const int b = t / SEQ; const float* g = gmod + (size_t)b * 6 * D; f32x4 v[4]; float s = 0.f;
        float g0 = 0.f, g1 = 0.f; const bf16 *y0, *y1 = nullptr;
        if (MOE_Y) { g0 = GATE[t * 2]; g1 = GATE[t * 2 + 1]; y0 = Y + (size_t)TSLOT[t * 2] * D; y1 = Y + (size_t)TSLOT[t * 2 + 1] * D; } else y0 = Y + (size_t)t * D;
#pragma unroll
        for (int j = 0; j < 4; ++j) { const int d = 4 * lane + 256 * j; const f32x4 xv = *(const f32x4*)(xin + (size_t)t * D + d), gv = *(const f32x4*)(g + d);
            const v2u w0 = *(const v2u*)(y0 + d); f32x4 yv = (f32x4){bflo(w0.x), bfhi(w0.x), bflo(w0.y), bfhi(w0.y)};
            if (MOE_Y) { const v2u w1 = *(const v2u*)(y1 + d); yv = yv * g0 + (f32x4){bflo(w1.x), bfhi(w1.x), bflo(w1.y), bfhi(w1.y)} * g1; }
            v[j] = xv * DN_ALPHA + (1.0f + gv) * yv; s += (v[j].x + v[j].y) + (v[j].z + v[j].w); }
        const float mean = wave_sum(s) * (1.f / D); float s2 = 0.f;
#pragma unroll
        for (int j = 0; j < 4; ++j) { v[j] = v[j] - mean; s2 += (v[j].x * v[j].x + v[j].y * v[j].y) + (v[j].z * v[j].z + v[j].w * v[j].w); }
        const float rstd = 1.f / sqrtf(wave_sum(s2) * (1.f / D) + LN_EPS);
        float lg[8];
#pragma unroll
        for (int e = 0; e < 8; ++e) lg[e] = 0.f;
#pragma unroll
        for (int j = 0; j < 4; ++j) { const int d = 4 * lane + 256 * j; const f32x4 xn = v[j] * rstd * *(const f32x4*)(lng + d) + *(const f32x4*)(lnb + d);
            *(f32x4*)(xout + (size_t)t * D + d) = xn;
            if (hm) { const float* m = hm + (size_t)b * 6 * D; const f32x4 hv = xn * (1.0f + *(const f32x4*)(m + sc_off + d)) + *(const f32x4*)(m + sh_off + d);
                v2u w; w.x = pk2(hv.x, hv.y); w.y = pk2(hv.z, hv.w); *(v2u*)(H + (size_t)t * D + d) = w;
                if (wr) {
#pragma unroll
                    for (int i = 0; i < 4; ++i) { const f32x4 wa = *(const f32x4*)(wr + (size_t)(d + i) * 8), wb = *(const f32x4*)(wr + (size_t)(d + i) * 8 + 4); const float hh = hv[i];
                        lg[0] += hh * wa.x; lg[1] += hh * wa.y; lg[2] += hh * wa.z; lg[3] += hh * wa.w; lg[4] += hh * wb.x; lg[5] += hh * wb.y; lg[6] += hh * wb.z; lg[7] += hh * wb.w; } } } }
        if (wr) {
#pragma unroll
            for (int e = 0; e < 8; ++e) lg[e] = wave_sum(lg[e]);
            if (lane == 0) { int i0 = 0; float v0 = lg[0];
#pragma unroll
                for (int e = 1; e < 8; ++e) if (lg[e] > v0) { v0 = lg[e]; i0 = e; }
                int i1 = 0; float v1 = -INFINITY;
#pragma unroll
                for (int e = 0; e < 8; ++e) if (e != i0 && lg[e] > v1) { v1 = lg[e]; i1 = e; }
                const float ga = 1.0f / (1.0f + __expf(v1 - v0)); TOPI[t * 2] = i0; TOPI[t * 2 + 1] = i1; GATE[t * 2] = ga; GATE[t * 2 + 1] = 1.0f - ga;
                __hip_atomic_fetch_add((LAS unsigned*)(lcnt + i0), 1u, __ATOMIC_RELAXED, __HIP_MEMORY_SCOPE_WORKGROUP); __hip_atomic_fetch_add((LAS unsigned*)(lcnt + i1), 1u, __ATOMIC_RELAXED, __HIP_MEMORY_SCOPE_WORKGROUP); } } }
    if (wr) { __syncthreads(); if (F.tid < 8) __hip_atomic_fetch_add(F.ctl + CW_CNT + 64 * li + F.tid, lcnt[F.tid], RLX_AGENT); }
}
__device__ __forceinline__ void phase_moe_assign(Frame& F, int li) {
    const int gw = F.vcu * NWAVES + F.wave, NGW = F.G * NWAVES, lane = F.lane;
    const int* TOPI = (const int*)(F.wsp() + WS_TOPI); int* TSLOT = (int*)(F.wsp() + WS_TSLOT); int* SEG = (int*)(F.wsp() + WS_SEG); const bf16* H = (const bf16*)(F.wsp() + WS_H); bf16* HS = (bf16*)(F.wsp() + WS_Y);
    int seg[9]; { int acc = 0;
#pragma unroll
        for (int e = 0; e < 8; ++e) { seg[e] = acc; const int c = (int)__hip_atomic_load(F.ctl + CW_CNT + 64 * li + e, RLX_AGENT); acc += (c + 255) & ~255; } seg[8] = acc; }
    if (gw == 0 && lane < 9) { int v = seg[0];
#pragma unroll
        for (int k = 1; k < 9; ++k) v = (lane == k) ? seg[k] : v;
        SEG[lane] = v; }
    for (int blk = gw; blk < T / 64; blk += NGW) { const int t = blk * 64 + lane; const int e0 = TOPI[t * 2], e1 = TOPI[t * 2 + 1]; int s0 = 0, s1 = 0;
        const unsigned long long lt = (1ull << lane) - 1ull;
#pragma unroll
        for (int e = 0; e < 8; ++e) { const unsigned long long m0 = __ballot(e0 == e), m1 = __ballot(e1 == e); const int c0 = __popcll(m0), c1 = __popcll(m1);
            int base = 0; if (lane == 0 && (c0 + c1) > 0) base = (int)__hip_atomic_fetch_add(F.ctl + CW_CUR + 64 * li + e, (unsigned)(c0 + c1), RLX_AGENT);
            base = __builtin_amdgcn_readfirstlane(base) + seg[e];
            if (e0 == e) s0 = base + __popcll(m0 & lt); if (e1 == e) s1 = base + c0 + __popcll(m1 & lt); }
        TSLOT[t * 2] = s0; TSLOT[t * 2 + 1] = s1;
        for (int i = 0; i < 64; ++i) { const int sa = __shfl(s0, i), sb = __shfl(s1, i); const bf16* src = H + (size_t)(blk * 64 + i) * D;
#pragma unroll
            for (int k = 0; k < 2; ++k) { const v4u w = *(const v4u*)(src + k * 512 + lane * 8); *(v4u*)(HS + (size_t)sa * D + k * 512 + lane * 8) = w; *(v4u*)(HS + (size_t)sb * D + k * 512 + lane * 8) = w; } } }
}
#ifndef MK_PER_PHASE
#define MK_PER_PHASE 0
#endif
constexpr int NPHASES = 43;
struct Args { const float* in[23]; float* out; unsigned char* ws; int ph_lo, ph_hi; };
static_assert(sizeof(Args) == 23 * 8 + 8 + 8 + 8, "no padding");

__global__ void __launch_bounds__(NTHREADS, 2) mk_fwd(Args args) {
    extern __shared__ __attribute__((aligned(16))) unsigned char lds[];
    Frame F;
    F.lds = (LAS unsigned char*)lds; F.MISC = (volatile LAS unsigned*)(F.lds + MISC_OFF);
    F.tid = threadIdx.x; F.lane = F.tid & 63; F.wave = __builtin_amdgcn_readfirstlane(F.tid >> 6); F.wave_s = F.wave;
    F.G = gridDim.x; { const int bx = blockIdx.x; F.vcu = (F.G % 8 == 0) ? (bx % 8) * (F.G / 8) + bx / 8 : bx; }
    F.ctl = (gu32*)(args.ws + WS_CTL);
    for (int u = F.tid; u < (LDS_BYTES - LDSCTL_OFF) / 4; u += NTHREADS) ((LAS unsigned*)(F.lds + LDSCTL_OFF))[u] = 0u;
    __syncthreads();
    if (F.tid == 0) { LAS unsigned long long* pt = (LAS unsigned long long*)(F.lds + PTAB_OFF);
#pragma unroll
        for (int i = 0; i < 23; ++i) pt[i] = (unsigned long long)args.in[i];
        pt[23] = (unsigned long long)args.out; pt[24] = (unsigned long long)args.ws; }
    __syncthreads();
    XcdBarrier bar = xcd_barrier_post((unsigned*)(F.ctl + CW_BAR), F.MISC + 8);
    int pc = 0;
#define PH_ON() (args.ph_lo <= pc && pc < args.ph_hi && (F.refresh(), true))
#define PH_END() do { if (args.ph_lo <= pc && pc + 1 < args.ph_hi) xcd_barrier(bar); ++pc; } while (0)
#define WSB(T_, off) ((T_*)(F.wsp() + (off)))
    if (PH_ON()) { phase_mod_tab(F); phase_convert(F, 0); } PH_END();
    if (PH_ON()) { phase_modulate0(F); } PH_END();
    for (int l = 0; l < NL; ++l) {
        const bool moe = (l & 1) != 0; const int li = l >> 1;
        if (l > 0) { if (PH_ON()) { phase_convert(F, l); } PH_END(); }
        if (PH_ON()) { pg8::Gemm g{WSB(bf16, WS_H), WSB(bf16, WS_WIN), D, D, D, 0, 0}; pg8::StaticOrder S; S.init(T, ZLD, F.G, (int)blockIdx.x); pg8::EpiBf16 E{WSB(bf16, WS_Z), ZLD, D_IN};
            pg8::gemm_phase<pg8::EpiBf16, pg8::StaticOrder, true>(F.lds + RING_OFF, g, S, E, F.tid); } PH_END();
        if (PH_ON()) { phase_rope_stats(F); } PH_END();
        if (PH_ON()) {
            { pg8::Gemm g{WSB(bf16, WS_Z) + ZO_CQ, WSB(bf16, WS_WUQ), ZLD, QRANK, QRANK, 0, 0}; pg8::StaticOrder S; S.init(T, 768, F.G, (int)blockIdx.x); pg8::EpiMlaQ E{WSB(bf16, WS_QM), WSB(const float, WS_RS), WSB(const float, WS_TAB), MLA_QSCALE, 0};
              pg8::gemm_phase<pg8::EpiMlaQ, pg8::StaticOrder, true>(F.lds + RING_OFF, g, S, E, F.tid); }
            { pg8::Gemm g{WSB(bf16, WS_Z) + ZO_CKV, WSB(bf16, WS_WUKV), ZLD, KVRANK, KVRANK, 0, 0}; pg8::StaticOrder S; S.init(T, 768, F.G, (int)blockIdx.x); pg8::EpiMlaKV E{WSB(bf16, WS_KM), WSB(bf16, WS_VM), WSB(const float, WS_RS)};
              pg8::gemm_phase<pg8::EpiMlaKV, pg8::StaticOrder, true>(F.lds + RING_OFF, g, S, E, F.tid); }
        } PH_END();
        if (PH_ON()) { phase_ret_simple(F, l); phase_dil_simple(F); phase_mla_simple(F); } PH_END();
        if (PH_ON()) { pg8::Gemm g{WSB(bf16, WS_YCAT), WSB(bf16, WS_WOUT), D, D, D, 0, 0}; pg8::StaticOrder S; S.init(T, D, F.G, (int)blockIdx.x); pg8::EpiBf16 E{WSB(bf16, WS_Y), D, D};
            pg8::gemm_phase<pg8::EpiBf16, pg8::StaticOrder, true>(F.lds + RING_OFF, g, S, E, F.tid); } PH_END();
        if (PH_ON()) { phase_ln<false>(F, l == 0 ? F.in(0) : F.outp(), F.outp(), WSB(const float, WS_MOD) + (size_t)l * NB * 6 * D + 2 * D, F.in(12) + l * D, F.in(13) + l * D, WSB(const float, WS_MOD) + (size_t)l * NB * 6 * D, 3 * D, 4 * D, moe ? F.in(19) + (size_t)li * D * NEXP : nullptr, li); } PH_END();

        if (!moe) {
            if (PH_ON()) { pg8::Gemm g{WSB(bf16, WS_H), WSB(bf16, WS_WFF), D, D, D, 0, 0}; pg8::StaticOrder S; S.init(T, 2 * DFF, F.G, (int)blockIdx.x); pg8::EpiSwiglu E{WSB(bf16, WS_FF), DFF};
                pg8::gemm_phase<pg8::EpiSwiglu, pg8::StaticOrder, true>(F.lds + RING_OFF, g, S, E, F.tid); } PH_END();
            if (PH_ON()) { pg8::Gemm g{WSB(bf16, WS_FF), WSB(const bf16, WS_WFF + WFF_W2_OFF_DENSE), DFF, DFF, DFF, 0, 0}; pg8::StaticOrder S; S.init(T, D, F.G, (int)blockIdx.x); pg8::EpiBf16 E{WSB(bf16, WS_Y), D, D};
                pg8::gemm_phase<pg8::EpiBf16, pg8::StaticOrder, true>(F.lds + RING_OFF, g, S, E, F.tid); } PH_END();
            if (PH_ON()) { phase_ln<false>(F, F.outp(), F.outp(), WSB(const float, WS_MOD) + (size_t)l * NB * 6 * D + 5 * D, F.in(14) + l * D, F.in(15) + l * D, (l + 1 < NL) ? WSB(const float, WS_MOD) + (size_t)(l + 1) * NB * 6 * D : nullptr, 0, D, nullptr, 0); } PH_END();
        } else {
            if (PH_ON()) { phase_moe_assign(F, li); } PH_END();
            if (PH_ON()) { pg8::Gemm g{WSB(bf16, WS_Y), WSB(bf16, WS_WFF), D, D, D, 0, (long)2 * DFFE * D}; pg8::GroupedOrder S; S.init(WSB(const int, WS_SEG), 2 * DFFE / 256, F.G, (int)blockIdx.x); pg8::EpiSwiglu E{WSB(bf16, WS_FF), DFFE};
                pg8::gemm_phase<pg8::EpiSwiglu, pg8::GroupedOrder, true>(F.lds + RING_OFF, g, S, E, F.tid); } PH_END();
            if (PH_ON()) { pg8::Gemm g{WSB(bf16, WS_FF), WSB(const bf16, WS_WFF + WFF_W2_OFF_MOE), DFFE, DFFE, DFFE, 0, (long)D * DFFE}; pg8::GroupedOrder S; S.init(WSB(const int, WS_SEG), D / 256, F.G, (int)blockIdx.x); pg8::EpiBf16 E{WSB(bf16, WS_Y), D, D};
                pg8::gemm_phase<pg8::EpiBf16, pg8::GroupedOrder, true>(F.lds + RING_OFF, g, S, E, F.tid); } PH_END();
            if (PH_ON()) { phase_ln<true>(F, F.outp(), F.outp(), WSB(const float, WS_MOD) + (size_t)l * NB * 6 * D + 5 * D, F.in(14) + l * D, F.in(15) + l * D, (l + 1 < NL) ? WSB(const float, WS_MOD) + (size_t)(l + 1) * NB * 6 * D : nullptr, 0, D, nullptr, 0); } PH_END();
        }
    }
#undef PH_ON
#undef PH_END
}

extern "C" void kernel_launch(void* const* d_in, const int* in_sizes, int n_in, void* d_out, int out_size, void* d_ws, size_t ws_size, hipStream_t stream) {
    static int grid = 0;
    if (grid == 0) {
        if (n_in != 23 || out_size != T * D || ws_size < WS_END) { fprintf(stderr, "kernel_launch: unexpected shapes (n_in %d out %d ws %zu)\n", n_in, out_size, ws_size); grid = -1; return; }
        int dev = 0, cus = 0, per_cu = 0;
        if (hipGetDevice(&dev) != hipSuccess || hipDeviceGetAttribute(&cus, hipDeviceAttributeMultiprocessorCount, dev) != hipSuccess) { grid = -1; return; }
        if (hipFuncSetAttribute((const void*)mk_fwd, hipFuncAttributeMaxDynamicSharedMemorySize, LDS_BYTES) != hipSuccess) { fprintf(stderr, "kernel_launch: hipFuncSetAttribute failed\n"); grid = -1; return; }
        if (hipOccupancyMaxActiveBlocksPerMultiprocessor(&per_cu, (const void*)mk_fwd, NTHREADS, LDS_BYTES) != hipSuccess || per_cu < 1) fprintf(stderr, "kernel_launch: occupancy query reports %d\n", per_cu);
        (void)hipGetLastError();
        grid = cus;
    }
    if (grid < 0) return;
    if (hipMemsetAsync((char*)d_ws + WS_CTL, 0, CTL_ZERO_BYTES, stream) != hipSuccess) return;
    Args a{};
    for (int i = 0; i < 23; ++i) a.in[i] = (const float*)d_in[i];
    a.out = (float*)d_out; a.ws = (unsigned char*)d_ws;
#if MK_PER_PHASE
    for (int p = 0; p < NPHASES; ++p) { a.ph_lo = p; a.ph_hi = p + 1; hipLaunchKernelGGL(mk_fwd, dim3(grid), dim3(NTHREADS), LDS_BYTES, stream, a); }
#else
    a.ph_lo = 0; a.ph_hi = NPHASES; hipLaunchKernelGGL(mk_fwd, dim3(grid), dim3(NTHREADS), LDS_BYTES, stream, a);
#endif
}
```

```cpp
#include <hip/hip_runtime.h>
#include <cstdio>
#include <cstdint>

namespace pg8 {
#define PG8_LAS __attribute__((address_space(3)))
typedef unsigned short bf16_t;
typedef short bf16x8 __attribute__((ext_vector_type(8)));
typedef float f32x4 __attribute__((ext_vector_type(4)));
typedef unsigned u32x4 __attribute__((ext_vector_type(4)));
typedef unsigned u32x2 __attribute__((ext_vector_type(2)));
constexpr int BM = 256, BK = 64, HALF = 128, HTB = HALF * BK * 2, STAGE_BYTES = 8 * HTB, NXCD = 8, WGM = 8;

__host__ __device__ __forceinline__ int lds_byte(int r, int c) { const int st = (r >> 4) * 2 + (c >> 5), rr = r & 15, cc = c & 31, ob = rr * 64 + cc * 2; return st * 1024 + (ob ^ (((ob >> 9) & 1) << 5)); }
__host__ __device__ __forceinline__ void stage_rc(int b, int& R, int& C) { const int st = b / 1024, sb = b % 1024, swz = sb ^ (((sb >> 9) & 1) << 5); R = (st >> 1) * 16 + swz / 64; C = (st & 1) * 32 + (swz % 64) / 2; }
__host__ __device__ __forceinline__ int perm32(int rho) { const int n = rho >> 4, i = rho & 15; return 8 * (i >> 2) + 4 * n + (i & 3); }

struct Unit { int pm, pn, g; };
struct Gemm { const bf16_t* A; const bf16_t* Bt; int lda, ldb, K; int pad; long gstride; };

struct StaticOrder {
    int nM, nN, nwg, G, c;
    __device__ void init(int M, int N, int G_, int c_) { nM = M / BM; nN = N / BM; nwg = nM * nN; G = G_; c = c_; }
    __device__ bool next(int i, Unit& u) const {
        const long L = (long)i * G + c; if (L >= nwg) return false;
        int wgid = (int)L; { const int q = nwg / NXCD, r = nwg % NXCD, xcd = wgid % NXCD, off = wgid / NXCD; wgid = (xcd < r ? xcd * (q + 1) : r * (q + 1) + (xcd - r) * q) + off; }
        const int nig = WGM * nN, gid = wgid / nig, fm = gid * WGM, gsz = (nM - fm) < WGM ? (nM - fm) : WGM;
        u.pm = fm + ((wgid % nig) % gsz); u.pn = (wgid % nig) / gsz; u.g = 0; return true;
    }
};
struct GroupedOrder {
    int tp[9]; int nN, nwg, G, c;
    __device__ void init(const int* seg, int nN_, int G_, int c_) {
#pragma unroll
        for (int k = 0; k < 9; ++k) tp[k] = __builtin_amdgcn_readfirstlane(seg[k]) / BM;
        nN = nN_; nwg = tp[8] * nN; G = G_; c = c_; }
    __device__ bool next(int i, Unit& u) const {
        const long L = (long)i * G + c; if (L >= nwg) return false;
        const int wgid = (int)L, nM = tp[8];
        const int nig = WGM * nN, gid = wgid / nig, fm = gid * WGM, gsz = (nM - fm) < WGM ? (nM - fm) : WGM;
        u.pm = fm + ((wgid % nig) % gsz); u.pn = (wgid % nig) / gsz; int e = 0;
#pragma unroll
        for (int k = 1; k < 8; ++k) e += (u.pm >= tp[k]) ? 1 : 0;
        u.g = e; return true;
    }
};

__device__ __forceinline__ unsigned cvt_pk_bf16(float lo, float hi) { unsigned r; asm volatile("v_cvt_pk_bf16_f32 %0, %1, %2" : "=v"(r) : "v"(lo), "v"(hi)); return r; }

struct EpiBf16 {
    static constexpr bool PERM = true;
    bf16_t* O; int ldc; int ncols;
    __device__ __forceinline__ void operator()(const f32x4 (&acc)[2][2][4][2], const Unit& u, int wr, int wc, int fr, int fq) const {
        const int row0 = u.pm * BM + wr * 64 + fr; const int col0 = u.pn * BM + wc * 32 + 8 * fq;
#pragma unroll
        for (int ai = 0; ai < 2; ++ai)
#pragma unroll
            for (int m = 0; m < 4; ++m) { bf16_t* rowp = O + (size_t)(row0 + ai * HALF + m * 16) * ldc + col0;
#pragma unroll
                for (int bj = 0; bj < 2; ++bj) { if (col0 + bj * HALF >= ncols) continue; const f32x4 v0 = acc[ai][bj][m][0], v1 = acc[ai][bj][m][1];
                    u32x4 w; w.x = cvt_pk_bf16(v0[0], v0[1]); w.y = cvt_pk_bf16(v0[2], v0[3]); w.z = cvt_pk_bf16(v1[0], v1[1]); w.w = cvt_pk_bf16(v1[2], v1[3]);
                    *(u32x4*)(rowp + bj * HALF) = w; } }
    }
};
struct EpiSwiglu {
    static constexpr bool PERM = false;
    bf16_t* O; int ldc;
    __device__ __forceinline__ void operator()(const f32x4 (&acc)[2][2][4][2], const Unit& u, int wr, int wc, int fr, int fq) const {
        const int row0 = u.pm * BM + wr * 64 + fr; const int col0 = u.pn * 128 + wc * 16 + 4 * fq;
#pragma unroll
        for (int ai = 0; ai < 2; ++ai)
#pragma unroll
            for (int m = 0; m < 4; ++m) { bf16_t* rowp = O + (size_t)(row0 + ai * HALF + m * 16) * ldc + col0;
#pragma unroll
                for (int bj = 0; bj < 2; ++bj) { const f32x4 a1 = acc[ai][bj][m][0], a3 = acc[ai][bj][m][1]; float o[4];
#pragma unroll
                    for (int j = 0; j < 4; ++j) o[j] = a1[j] * __builtin_amdgcn_rcpf(1.0f + __builtin_amdgcn_exp2f(-1.4426950408889634f * a1[j])) * a3[j];
                    u32x2 w; w.x = cvt_pk_bf16(o[0], o[1]); w.y = cvt_pk_bf16(o[2], o[3]); *(u32x2*)(rowp + bj * 64) = w; } }
    }
};
struct EpiMlaQ {
    static constexpr bool PERM = false;
    bf16_t* Q; const float* rs; const float* tab; float qscale; int pad;
    __device__ __forceinline__ void operator()(const f32x4 (&acc)[2][2][4][2], const Unit& u, int wr, int wc, int fr, int fq) const {
        const int row0 = u.pm * BM + wr * 64 + fr;
#pragma unroll
        for (int bj = 0; bj < 2; ++bj) { const int c0 = u.pn * BM + bj * HALF + wc * 32; if (c0 >= 576) continue; const bool rope = (c0 % 96) == 64;
#pragma unroll
            for (int ai = 0; ai < 2; ++ai)
#pragma unroll
                for (int m = 0; m < 4; ++m) { const int t = row0 + ai * HALF + m * 16; const float sc = rs[t * 2] * qscale; f32x4 v0 = acc[ai][bj][m][0] * sc, v1 = acc[ai][bj][m][1] * sc;
                    if (rope) { const f32x4 cs = *(const f32x4*)(tab + (size_t)t * 96 + 64 + 4 * fq), sn = *(const f32x4*)(tab + (size_t)t * 96 + 80 + 4 * fq); const f32x4 o0 = v0 * cs - v1 * sn, o1 = v1 * cs + v0 * sn; v0 = o0; v1 = o1; }
                    bf16_t* p = Q + (size_t)t * 576 + c0 + 4 * fq; u32x2 w; w.x = cvt_pk_bf16(v0[0], v0[1]); w.y = cvt_pk_bf16(v0[2], v0[3]); *(u32x2*)p = w; w.x = cvt_pk_bf16(v1[0], v1[1]); w.y = cvt_pk_bf16(v1[2], v1[3]); *(u32x2*)(p + 16) = w; } }
    }
};
struct EpiMlaKV {
    static constexpr bool PERM = true;
    bf16_t* Km; bf16_t* Vm; const float* rs;
    __device__ __forceinline__ void operator()(const f32x4 (&acc)[2][2][4][2], const Unit& u, int wr, int wc, int fr, int fq) const {
        const int row0 = u.pm * BM + wr * 64 + fr;
#pragma unroll
        for (int bj = 0; bj < 2; ++bj) { const int c8 = u.pn * BM + bj * HALF + wc * 32 + 8 * fq; const int head = c8 >> 7, off = c8 & 127;
#pragma unroll
            for (int ai = 0; ai < 2; ++ai)
#pragma unroll
                for (int m = 0; m < 4; ++m) { const int t = row0 + ai * HALF + m * 16; const float sc = rs[t * 2 + 1]; const f32x4 v0 = acc[ai][bj][m][0] * sc, v1 = acc[ai][bj][m][1] * sc;
                    bf16_t* p = (off < 64) ? Km + (size_t)t * 576 + head * 96 + off : Vm + (size_t)t * 384 + head * 64 + (off - 64);
                    u32x4 w; w.x = cvt_pk_bf16(v0[0], v0[1]); w.y = cvt_pk_bf16(v0[2], v0[3]); w.z = cvt_pk_bf16(v1[0], v1[1]); w.w = cvt_pk_bf16(v1[2], v1[3]); *(u32x4*)p = w; } }
    }
};

template <class Epi, class Sched, bool ALIGN_EPI>
__device__ __forceinline__ void gemm_phase(PG8_LAS unsigned char* lds, const Gemm g, const Sched& S, const Epi& E, const int tid) {
    const int wid = __builtin_amdgcn_readfirstlane(tid >> 6), lane = tid & 63, wr = wid >> 2, wc = wid & 3, fr = lane & 15, fq = lane >> 4;
    const int K = g.K, nt = K / BK;
    unsigned voffA[2], voffB[2];
#pragma unroll
    for (int i = 0; i < 2; ++i) { int R, C; stage_rc(tid * 16 + i * 8192, R, C); const int Rb = Epi::PERM ? ((R & ~31) + perm32(R & 31)) : R;
        voffA[i] = (unsigned)(R * g.lda + C) * 2u; voffB[i] = (unsigned)(Rb * g.ldb + C) * 2u; }
    const size_t kstep = (size_t)(BK * 2);
    const size_t hstepA = (size_t)HALF * g.lda * 2, hstepB = (size_t)HALF * g.ldb * 2;
    const size_t tstepA = 2 * hstepA, tstepB = 2 * hstepB;
    const unsigned ldsw = (unsigned)wid * 1024u;
    const int aoff = lds_byte(wr * 64 + fr, fq * 8), boff = lds_byte(wc * 32 + fr, fq * 8);
#define PG8_SA(b, h) (((b) * 2 + (h)) * HTB)
#define PG8_SB(b, h) ((4 + (b) * 2 + (h)) * HTB)
#define PG8_STAGE(bufoff, gbase, voff) do { _Pragma("unroll") for (int _i = 0; _i < 2; ++_i) \
        __builtin_amdgcn_global_load_lds((const unsigned*)((const char*)(gbase) + (voff)[_i]), (PG8_LAS unsigned*)(lds + (bufoff) + ldsw + _i * 8192), 16, 0, 0); } while (0)
#define PG8_LDA(dst, b, h) do { _Pragma("unroll") for (int m = 0; m < 4; ++m) _Pragma("unroll") for (int k = 0; k < 2; ++k) dst[m][k] = *(const PG8_LAS bf16x8*)(lds + PG8_SA(b, h) + aoff + m * 2048 + k * 1024); } while (0)
#define PG8_LDB(dst, b, h) do { _Pragma("unroll") for (int n = 0; n < 2; ++n) _Pragma("unroll") for (int k = 0; k < 2; ++k) dst[n][k] = *(const PG8_LAS bf16x8*)(lds + PG8_SB(b, h) + boff + n * 2048 + k * 1024); } while (0)
#define PG8_MMA(ai, bj, At, Bt) do { __builtin_amdgcn_s_setprio(1); _Pragma("unroll") for (int m = 0; m < 4; ++m) _Pragma("unroll") for (int n = 0; n < 2; ++n) _Pragma("unroll") for (int k = 0; k < 2; ++k) \
        acc[ai][bj][m][n] = __builtin_amdgcn_mfma_f32_16x16x32_bf16(Bt[n][k], At[m][k], acc[ai][bj][m][n], 0, 0, 0); __builtin_amdgcn_s_setprio(0); } while (0)
#define PG8_WAIT_V(n) asm volatile("s_waitcnt vmcnt(" #n ")" ::: "memory")
#define PG8_WAIT_L(n) asm volatile("s_waitcnt lgkmcnt(" #n ")" ::: "memory")
#define PG8_BAR __builtin_amdgcn_s_barrier()
#define PG8_SCHED __builtin_amdgcn_sched_barrier(0)
    Unit cur, nxt; int ui = 0;
    if (!S.next(0, cur)) return;
    f32x4 acc[2][2][4][2];
#pragma unroll
    for (int a = 0; a < 2; ++a)
#pragma unroll
        for (int b = 0; b < 2; ++b)
#pragma unroll
            for (int m = 0; m < 4; ++m)
#pragma unroll
                for (int n = 0; n < 2; ++n) acc[a][b][m][n] = (f32x4){0.f, 0.f, 0.f, 0.f};
    bf16x8 At[4][2], B0[2][2], B1[2][2];
    const char* cA = (const char*)g.A + (size_t)cur.pm * tstepA; const char* cB = (const char*)(g.Bt + (size_t)cur.g * g.gstride) + (size_t)cur.pn * tstepB;
    PG8_STAGE(PG8_SB(0, 0), cB, voffB); PG8_STAGE(PG8_SB(0, 1), cB + hstepB, voffB); PG8_STAGE(PG8_SA(0, 0), cA, voffA); PG8_STAGE(PG8_SA(0, 1), cA + hstepA, voffA);
    if (wr == 1) PG8_BAR;
    PG8_WAIT_V(2); PG8_BAR;
    PG8_STAGE(PG8_SB(1, 0), cB + kstep, voffB); PG8_STAGE(PG8_SA(1, 0), cA + kstep, voffA); PG8_STAGE(PG8_SB(1, 1), cB + hstepB + kstep, voffB);
    PG8_WAIT_V(6); PG8_BAR;
    for (;;) {
        const bool has_next = S.next(ui + 1, nxt);
        const char* nA = has_next ? (const char*)g.A + (size_t)nxt.pm * tstepA : cA; const char* nB = has_next ? (const char*)(g.Bt + (size_t)nxt.g * g.gstride) + (size_t)nxt.pn * tstepB : cB;
#pragma nounroll
        for (int t = 0; t < nt; t += 2) {
            const bool last = (t == nt - 2);
            const char* a1 = cA + (size_t)(t + 1) * kstep;
            const char* a2 = last ? nA : cA + (size_t)(t + 2) * kstep; const char* b2 = last ? nB : cB + (size_t)(t + 2) * kstep;
            const char* a3 = a2 + kstep; const char* b3 = b2 + kstep;
            PG8_LDB(B0, 0, 0); PG8_LDB(B1, 0, 1); PG8_SCHED; PG8_LDA(At, 0, 0); PG8_STAGE(PG8_SA(1, 1), a1 + hstepA, voffA);
            PG8_WAIT_V(8); PG8_WAIT_L(0); PG8_BAR; PG8_MMA(0, 0, At, B0); PG8_MMA(0, 1, At, B1); PG8_BAR; PG8_SCHED;
            PG8_LDA(At, 0, 1); PG8_STAGE(PG8_SB(0, 0), b2, voffB); PG8_STAGE(PG8_SB(0, 1), b2 + hstepB, voffB); PG8_STAGE(PG8_SA(0, 0), a2, voffA);
            PG8_WAIT_V(8); PG8_WAIT_L(0); PG8_BAR; PG8_MMA(1, 0, At, B0); PG8_MMA(1, 1, At, B1); PG8_BAR; PG8_SCHED;
            PG8_LDB(B0, 1, 0); PG8_LDB(B1, 1, 1); PG8_SCHED; PG8_LDA(At, 1, 0); PG8_STAGE(PG8_SA(0, 1), a2 + hstepA, voffA);
            PG8_WAIT_V(8); PG8_WAIT_L(0); PG8_BAR; PG8_MMA(0, 0, At, B0); PG8_MMA(0, 1, At, B1); PG8_BAR; PG8_SCHED;
            PG8_LDA(At, 1, 1); PG8_STAGE(PG8_SB(1, 0), b3, voffB); PG8_STAGE(PG8_SB(1, 1), b3 + hstepB, voffB); PG8_STAGE(PG8_SA(1, 0), a3, voffA);
            PG8_WAIT_V(8); PG8_WAIT_L(0); PG8_BAR; PG8_MMA(1, 0, At, B0); PG8_MMA(1, 1, At, B1); PG8_BAR; PG8_SCHED;
        }
        if constexpr (ALIGN_EPI) { if (wr == 0) PG8_BAR; }
        E(acc, cur, wr, wc, fr, fq);
        if (!has_next) break;
#pragma unroll
        for (int a = 0; a < 2; ++a)
#pragma unroll
            for (int b = 0; b < 2; ++b)
#pragma unroll
                for (int m = 0; m < 4; ++m)
#pragma unroll
                    for (int n = 0; n < 2; ++n) acc[a][b][m][n] = (f32x4){0.f, 0.f, 0.f, 0.f};
        cur = nxt; cA = nA; cB = nB; ++ui;
        if constexpr (ALIGN_EPI) { if (wr == 1) PG8_BAR; }
    }
    PG8_WAIT_V(0);
    if constexpr (!ALIGN_EPI) { if (wr == 0) PG8_BAR; }
    PG8_BAR;
#undef PG8_SA
#undef PG8_SB
#undef PG8_STAGE
#undef PG8_LDA
#undef PG8_LDB
#undef PG8_MMA
#undef PG8_WAIT_V
#undef PG8_WAIT_L
#undef PG8_BAR
#undef PG8_SCHED
}
}
constexpr int NWAVES = 8, NTHREADS = 512;
constexpr int NB = 8, SEQ = 4096, T = NB * SEQ, NL = 4, D = 1024, NEXP = 8;
constexpr int D_IN = 2848, ZLD = 3072;
constexpr int ZO_RQ = 0, ZO_RK = 256, ZO_RV = 512, ZO_RG = 768, ZO_DQ = 1024, ZO_DK = 1408, ZO_DV = 1792, ZO_CQ = 2176, ZO_CKV = 2560, ZO_KR = 2816;
constexpr int QRANK = 384, KVRANK = 256, QLD = 576, KLD = 576, VLD = 384;
constexpr int YO_RET = 0, YO_DIL = 256, YO_MLA = 640;
constexpr int DFF = 2816, DFFE = 3584;
constexpr float LN_EPS = 1e-5f, RMS_EPS = 1e-6f, DN_ALPHA = 1.6817928305074290f;
constexpr float LOG2E = 1.4426950408889634f;
constexpr float MLA_QSCALE = 0.10206207261596577f * LOG2E;
constexpr int MAXSLOT = 2 * T + NEXP * 256;

constexpr size_t MiB = 1u << 20;
constexpr size_t WS_CTL = 0, CTL_ZERO_BYTES = 1 * MiB;
constexpr size_t WS_MOD = 1 * MiB;
constexpr size_t WS_RS = 2 * MiB, WS_TOPI = WS_RS + 256 * 1024, WS_GATE = WS_TOPI + 256 * 1024, WS_TSLOT = WS_GATE + 256 * 1024, WS_SEG = WS_TSLOT + 256 * 1024;
constexpr size_t WS_TAB = 4 * MiB;
constexpr size_t WS_WIN = 16 * MiB, WS_WUQ = 22 * MiB, WS_WUKV = 23 * MiB, WS_WOUT = 24 * MiB, WS_WFF = 26 * MiB;
constexpr size_t WFF_W2_OFF_DENSE = (size_t)2 * DFF * D * 2, WFF_W2_OFF_MOE = (size_t)NEXP * 2 * DFFE * D * 2;
constexpr size_t WS_H = 194 * MiB;
constexpr size_t WS_A = 258 * MiB;
constexpr size_t WS_Z = WS_A, WS_QM = WS_A + 192 * MiB, WS_KM = WS_A + 228 * MiB, WS_VM = WS_A + 264 * MiB, WS_KVS = WS_A + 288 * MiB, WS_DILO = WS_A + 304 * MiB, WS_DILL = WS_A + 376 * MiB, WS_YCAT = WS_A + 380 * MiB;
constexpr size_t WS_FF = WS_A;
constexpr size_t WS_Y = 720 * MiB;
constexpr size_t WS_END = 852 * MiB;
static_assert((size_t)MAXSLOT * DFFE * 2 <= 462 * MiB && (size_t)MAXSLOT * D * 2 <= 132 * MiB && (size_t)T * ZLD * 2 == 192 * MiB, "ws map");
constexpr int CW_TMO = 0, CW_CODE = 1, CW_BAR = 4096, CW_CNT = 8192  , CW_CUR = 8448  , CW_Q = 8704  ;

constexpr int RING_OFF = 0, RING_BYTES = 131072;
constexpr int LDSCTL_OFF = RING_BYTES, MISC_OFF = LDSCTL_OFF + 320;
constexpr int LDS_BYTES = 147456;
constexpr int PTAB_OFF = LDSCTL_OFF + 512;

#define GAS __attribute__((address_space(1)))
#define LAS __attribute__((address_space(3)))
typedef unsigned short bf16;
typedef unsigned v4u __attribute__((ext_vector_type(4)));
typedef unsigned v2u __attribute__((ext_vector_type(2)));
typedef float f32x4 __attribute__((ext_vector_type(4)));
typedef GAS unsigned gu32;
#define RLX_AGENT __ATOMIC_RELAXED, __HIP_MEMORY_SCOPE_AGENT
#define LDS_WAIT() asm volatile("s_waitcnt lgkmcnt(0)" ::: "memory")
#define VM_WAIT() asm volatile("s_waitcnt vmcnt(0)" ::: "memory")
__device__ __forceinline__ unsigned f2bf(float f) { unsigned u = __builtin_bit_cast(unsigned, f); return (u + 0x7fffu + ((u >> 16) & 1u)) >> 16; }
__device__ __forceinline__ unsigned pk2(float lo, float hi) { return f2bf(lo) | (f2bf(hi) << 16); }
__device__ __forceinline__ float bf2f(unsigned short b) { return __builtin_bit_cast(float, (unsigned)b << 16); }
__device__ __forceinline__ float bflo(unsigned w) { return __builtin_bit_cast(float, w << 16); }
__device__ __forceinline__ float bfhi(unsigned w) { return __builtin_bit_cast(float, w & 0xffff0000u); }
__device__ __forceinline__ void ld8(const bf16* p, float* o) { const v4u w = *(const v4u*)p; o[0] = bflo(w.x); o[1] = bfhi(w.x); o[2] = bflo(w.y); o[3] = bfhi(w.y); o[4] = bflo(w.z); o[5] = bfhi(w.z); o[6] = bflo(w.w); o[7] = bfhi(w.w); }
__device__ __forceinline__ float fsilu(float x) { return x * __builtin_amdgcn_rcpf(1.0f + __builtin_amdgcn_exp2f(-LOG2E * x)); }

#define XB_TMO      128
#define XB_XCNT(j)  (256  + 64 * (j))
#define XB_XSUB(j)  (1280 + 64 * (j))
#define XB_XGEN(j)  (2304 + 64 * (j))
#define XB_TOP      3328
#define XB_TOPGEN   3392
#define XCD_BAR_WORDS 3456
#define XB_SPIN_CAP (1u << 18)
__device__ __forceinline__ unsigned xb_ld(unsigned* p)              { return __hip_atomic_load(p, __ATOMIC_RELAXED, __HIP_MEMORY_SCOPE_AGENT); }
__device__ __forceinline__ unsigned xb_add(unsigned* p, unsigned v) { return __hip_atomic_fetch_add(p, v, __ATOMIC_RELAXED, __HIP_MEMORY_SCOPE_AGENT); }
__device__ __forceinline__ unsigned xb_xcc_id() { return (unsigned)__builtin_amdgcn_s_getreg((3 << 11) | 20) & 0xFu; }
#define XB_SPIN(cond, bar) do { unsigned _sp = 0; while (cond) { __builtin_amdgcn_s_sleep(1); \
    if ((++_sp & 255u) == 0u) { if (xb_ld(&(bar)[XB_TMO])) break; if (_sp > XB_SPIN_CAP) { atomicAdd(&(bar)[XB_TMO], 1u); break; } } } } while (0)
struct XcdBarrier { unsigned* bar; unsigned x; volatile LAS unsigned* st; };
__device__ __forceinline__ XcdBarrier xcd_barrier_post(unsigned* bar, volatile LAS unsigned* st) {
    XcdBarrier b; b.bar = bar; b.x = xb_xcc_id(); b.st = st;
    if (threadIdx.x == 0) (void)xb_add(&bar[XB_XCNT(b.x)], 1u);
    return b;
}
__device__ __forceinline__ void xcd_barrier_complete(unsigned* bar, unsigned x, unsigned& nloc, unsigned& nx) {
    const unsigned G = gridDim.x * gridDim.y * gridDim.z;
    unsigned sum, cnt, mine, sp = 0u;
    for (;;) {
        sum = 0u; cnt = 0u; mine = 0u;
#pragma unroll
        for (unsigned j = 0; j < 16; ++j) { const unsigned c = xb_ld(&bar[XB_XCNT(j)]); sum += c; cnt += (c > 0u) ? 1u : 0u; mine = (j == x) ? c : mine; }
        if (sum == G) break;
        __builtin_amdgcn_s_sleep(1);
        if ((++sp & 255u) == 0u) { if (xb_ld(&bar[XB_TMO])) break; if (sp > XB_SPIN_CAP) { atomicAdd(&bar[XB_TMO], 1u); break; } }
    }
    nloc = mine > 0u ? mine : 1u; nx = cnt > 0u ? cnt : 1u;
}
__device__ __forceinline__ void xcd_barrier(const XcdBarrier& b) {
    asm volatile("s_waitcnt vmcnt(0)" ::: "memory");
    __syncthreads();
    if (threadIdx.x == 0) {
        unsigned* bar = b.bar;
        __builtin_amdgcn_s_waitcnt(0);
        unsigned nloc = b.st[0], nx = b.st[1];
        if (nloc == 0u) { xcd_barrier_complete(bar, b.x, nloc, nx); b.st[0] = nloc; b.st[1] = nx; }
        const unsigned old = xb_add(&bar[XB_XSUB(b.x)], 1u);
        const unsigned gen = old / nloc;
        if (old + 1u == (gen + 1u) * nloc) {
            __builtin_amdgcn_fence(__ATOMIC_RELEASE, "agent");
            asm volatile("s_waitcnt vmcnt(0)" ::: "memory");
            const unsigned og = xb_add(&bar[XB_TOP], 1u);
            const unsigned tg = og / nx;
            if (og + 1u == (tg + 1u) * nx) xb_add(&bar[XB_TOPGEN], 1u);
            else XB_SPIN(xb_ld(&bar[XB_TOPGEN]) == tg, bar);
            __builtin_amdgcn_fence(__ATOMIC_ACQUIRE, "agent");
            xb_add(&bar[XB_XGEN(b.x)], 1u);
            asm volatile("s_waitcnt vmcnt(0)" ::: "memory");
        } else {
            XB_SPIN(xb_ld(&bar[XB_XGEN(b.x)]) == gen, bar);
            __builtin_amdgcn_fence(__ATOMIC_ACQUIRE, "agent");
            asm volatile("s_waitcnt vmcnt(0)" ::: "memory");
        }
    }
    __syncthreads();
}

struct Frame {
    LAS unsigned char* lds; volatile LAS unsigned* MISC; gu32* ctl;
    int tid, lane, wave, vcu, G;
    __device__ __forceinline__ unsigned long long ptab(int i) const { const volatile LAS unsigned* p = (const volatile LAS unsigned*)(lds + PTAB_OFF) + 2 * i; const unsigned lo = p[0], hi = p[1];
        return ((unsigned long long)(unsigned)__builtin_amdgcn_readfirstlane((int)hi) << 32) | (unsigned)__builtin_amdgcn_readfirstlane((int)lo); }
    int wave_s;
    __device__ __forceinline__ void refresh() { int w = wave_s; asm volatile("" : "+s"(w)); int ln = (int)__builtin_amdgcn_mbcnt_hi(~0u, __builtin_amdgcn_mbcnt_lo(~0u, 0u)); asm volatile("" : "+v"(ln)); wave = w; lane = ln; tid = w * 64 + ln;
        unsigned long long c = ptab(24); ctl = (gu32*)c; }
    __device__ __forceinline__ const float* in(int i) const { return (const float*)ptab(i); }
    __device__ __forceinline__ float* outp() const { return (float*)ptab(23); }
    __device__ __forceinline__ unsigned char* wsp() const { return (unsigned char*)ptab(24); }
};
__constant__ double INVT[48] = {
0.15915494309189535, 0.11934937021124886, 0.089499401608891013, 0.067115083005227255, 0.050329212104487035, 0.037741584717419771, 0.028302195830623399, 0.02122365276477766, 0.015915494309189534, 0.011934937021124886, 0.0089499401608891024, 0.0067115083005227253, 0.0050329212104487037, 0.0037741584717419772, 0.0028302195830623399, 0.0021223652764777662, 0.0015915494309189536, 0.0011934937021124885, 0.00089499401608891024, 0.0006711508300522726, 0.00050329212104487033, 0.00037741584717419774, 0.00028302195830623395, 0.00021223652764777661, 0.00015915494309189535, 0.00011934937021124886, 8.9499401608891018e-05, 6.7115083005227254e-05, 5.0329212104487035e-05, 3.7741584717419777e-05, 2.8302195830623396e-05, 2.1223652764777659e-05, 0.15915494309189535, 0.089499401608891013, 0.050329212104487035, 0.028302195830623399, 0.015915494309189534, 0.0089499401608891024, 0.0050329212104487037, 0.0028302195830623399, 0.0015915494309189536, 0.00089499401608891024, 0.00050329212104487033, 0.00028302195830623395, 0.00015915494309189535, 8.9499401608891018e-05, 5.0329212104487035e-05, 2.8302195830623396e-05};

__device__ __forceinline__ float wave_sum(float v) {
#pragma unroll
    for (int o = 1; o < 64; o <<= 1) v += __shfl_xor(v, o);
    return v;
}
__device__ __forceinline__ void transpose_item(const float* W, int K, int N, bf16* WT, int mode, const float* kscale, LAS float* scr, int item, int lane) {
    const int nblk = N / 32, kb = item / nblk, nb = item % nblk, k0 = 64 * kb, n0 = 32 * nb;
#pragma unroll 8
    for (int i = 0; i < 32; ++i) { const int kk = 2 * i + (lane >> 5); float v = W[(size_t)(k0 + kk) * N + n0 + (lane & 31)]; if (kscale) v *= kscale[k0 + kk]; scr[kk * 33 + (lane & 31)] = v; }
    LDS_WAIT(); asm volatile("" ::: "memory");
    const int c = lane & 7;
#pragma unroll
    for (int j = 0; j < 4; ++j) { const int n = (lane >> 3) + 8 * j; const LAS float* s = scr + (8 * c) * 33 + n;
        v4u o; o.x = pk2(s[0 * 33], s[1 * 33]); o.y = pk2(s[2 * 33], s[3 * 33]); o.z = pk2(s[4 * 33], s[5 * 33]); o.w = pk2(s[6 * 33], s[7 * 33]);
        const int nn = n0 + n; const int row = (mode == 0) ? nn : (32 * (nn >> 4) + (nn & 15) + (mode == 2 ? 16 : 0));
        *(GAS v4u*)(WT + (size_t)row * K + k0 + 8 * c) = o; }
    LDS_WAIT(); asm volatile("" ::: "memory");
}
__device__ __forceinline__ void phase_convert(Frame& F, int l) {
    LAS float* scr = (LAS float*)(F.lds + RING_OFF + F.wave * 16384);
    const int gw = F.vcu * NWAVES + F.wave, NGW = F.G * NWAVES;
    bf16* WIN = (bf16*)(F.wsp() + WS_WIN); bf16* WUQ = (bf16*)(F.wsp() + WS_WUQ); bf16* WUKV = (bf16*)(F.wsp() + WS_WUKV); bf16* WOUT = (bf16*)(F.wsp() + WS_WOUT); bf16* WFF = (bf16*)(F.wsp() + WS_WFF);
    constexpr int I_IN = 16 * 89, I_UQ = 6 * 18, I_UKV = 4 * 24, I_OUT = 16 * 32, I_D1 = 16 * 88, I_D2 = 44 * 32, I_M1 = 16 * 112, I_M2 = 56 * 32;
    const bool moe = (l & 1) != 0; const int li = l >> 1;
    const int nff = moe ? NEXP * (2 * I_M1 + I_M2) : (2 * I_D1 + I_D2);
    const int nitems = I_IN + I_UQ + I_UKV + I_OUT + nff;
    for (int it = gw; it < nitems; it += NGW) {
        int r = it;
        if (r < I_IN) { transpose_item(F.in(3) + (size_t)l * D * D_IN, D, D_IN, WIN, 0, nullptr, scr, r, F.lane); continue; } r -= I_IN;
        if (r < I_UQ) { transpose_item(F.in(7) + (size_t)l * QRANK * 576, QRANK, 576, WUQ, 0, F.in(5) + l * QRANK, scr, r, F.lane); continue; } r -= I_UQ;
        if (r < I_UKV) { transpose_item(F.in(8) + (size_t)l * KVRANK * 768, KVRANK, 768, WUKV, 0, F.in(6) + l * KVRANK, scr, r, F.lane); continue; } r -= I_UKV;
        if (r < I_OUT) { transpose_item(F.in(9) + (size_t)l * D * D, D, D, WOUT, 0, nullptr, scr, r, F.lane); continue; } r -= I_OUT;
        if (!moe) {
            if (r < I_D1) { transpose_item(F.in(16) + (size_t)li * D * DFF, D, DFF, WFF, 1, nullptr, scr, r, F.lane); continue; } r -= I_D1;
            if (r < I_D1) { transpose_item(F.in(17) + (size_t)li * D * DFF, D, DFF, WFF, 2, nullptr, scr, r, F.lane); continue; } r -= I_D1;
            transpose_item(F.in(18) + (size_t)li * DFF * D, DFF, D, (bf16*)((unsigned char*)WFF + WFF_W2_OFF_DENSE), 0, nullptr, scr, r, F.lane);
        } else {
            const int per = 2 * I_M1 + I_M2; const int e = r / per; r -= e * per;
            bf16* w13 = WFF + (size_t)e * 2 * DFFE * D; bf16* w2 = (bf16*)((unsigned char*)WFF + WFF_W2_OFF_MOE) + (size_t)e * D * DFFE;
            if (r < I_M1) { transpose_item(F.in(20) + ((size_t)li * NEXP + e) * D * DFFE, D, DFFE, w13, 1, nullptr, scr, r, F.lane); continue; } r -= I_M1;
            if (r < I_M1) { transpose_item(F.in(21) + ((size_t)li * NEXP + e) * D * DFFE, D, DFFE, w13, 2, nullptr, scr, r, F.lane); continue; } r -= I_M1;
            transpose_item(F.in(22) + ((size_t)li * NEXP + e) * DFFE * D, DFFE, D, w2, 0, nullptr, scr, r, F.lane);
        }
    }
    const int gt = F.vcu * NTHREADS + F.tid, NT = F.G * NTHREADS;
    { GAS v4u* p = (GAS v4u*)(WIN + (size_t)D_IN * D); const int n = (ZLD - D_IN) * D / 8; unsigned zz = 0u; asm volatile("" : "+v"(zz)); for (int i = gt; i < n; i += NT) p[i] = (v4u){zz, zz, zz, zz}; }
    { GAS v4u* p = (GAS v4u*)(WUQ + (size_t)576 * QRANK); const int n = (768 - 576) * QRANK / 8; unsigned zz = 0u; asm volatile("" : "+v"(zz)); for (int i = gt; i < n; i += NT) p[i] = (v4u){zz, zz, zz, zz}; }
}
__device__ __forceinline__ void phase_mod_tab(Frame& F) {
    const int gt = F.vcu * NTHREADS + F.tid, NT = F.G * NTHREADS;
    float* MOD = (float*)(F.wsp() + WS_MOD); float* TAB = (float*)(F.wsp() + WS_TAB);
    const float* c = F.in(1); const float* w_ada = F.in(10); const float* b_ada = F.in(11); const int* pos = (const int*)F.in(2);
    for (int ix = gt; ix < NL * NB * 6 * D; ix += NT) { const int j = ix % (6 * D), b = (ix / (6 * D)) % NB, l = ix / (6 * D * NB);
        const float* w = w_ada + (size_t)l * D * 6 * D + j; float acc = b_ada[(size_t)l * 6 * D + j];
        for (int k = 0; k < D; ++k) acc += fsilu(c[b * D + k]) * w[(size_t)k * 6 * D];
        MOD[ix] = acc; }
    for (int ix = gt; ix < T * 48; ix += NT) { const int t = ix / 48, i = ix % 48; const double x = (double)pos[t] * INVT[i]; const float fr = (float)(x - floor(x));
        const float s = __builtin_amdgcn_sinf(fr), cc = __builtin_amdgcn_cosf(fr); float* r = TAB + (size_t)t * 96;
        if (i < 32) { r[i] = cc; r[32 + i] = s; } else { r[64 + (i - 32)] = cc; r[80 + (i - 32)] = s; } }
}
__device__ __forceinline__ void phase_modulate0(Frame& F) {
    const int gt = F.vcu * NTHREADS + F.tid, NT = F.G * NTHREADS; const float* MOD = (const float*)(F.wsp() + WS_MOD); bf16* H = (bf16*)(F.wsp() + WS_H); const float* x = F.in(0);
    for (int ix = gt; ix < T * D / 4; ix += NT) { const int t = ix / (D / 4), d = (ix % (D / 4)) * 4, b = t / SEQ; const float* m = MOD + (size_t)b * 6 * D;
        const f32x4 xv = *(const f32x4*)(x + (size_t)ix * 4), sh = *(const f32x4*)(m + d), sc = *(const f32x4*)(m + D + d); const f32x4 h = xv * (1.0f + sc) + sh;
        v2u w; w.x = pk2(h.x, h.y); w.y = pk2(h.z, h.w); *(v2u*)(H + (size_t)ix * 4) = w; }
}
__device__ __forceinline__ void phase_rope_stats(Frame& F) {
    const int gw = F.vcu * NWAVES + F.wave, NGW = F.G * NWAVES, lane = F.lane;
    bf16* Z = (bf16*)(F.wsp() + WS_Z); bf16* KM = (bf16*)(F.wsp() + WS_KM); const float* TAB = (const float*)(F.wsp() + WS_TAB); float* RS = (float*)(F.wsp() + WS_RS);
    for (int t = gw; t < T; t += NGW) { bf16* zr = Z + (size_t)t * ZLD; const float* tb = TAB + (size_t)t * 96;
#pragma unroll
        for (int k = 0; k < 10; ++k) { const int u = lane + 64 * k; int base;
            if (u < 128) base = ZO_RQ + (u >> 5) * 64; else if (u < 256) base = ZO_RK + ((u - 128) >> 5) * 64; else if (u < 448) base = ZO_DQ + ((u - 256) >> 5) * 64; else base = ZO_DK + ((u - 448) >> 5) * 64;
            const int i = u & 31; const float x1 = bf2f(zr[base + i]), x2 = bf2f(zr[base + 32 + i]), c = tb[i], s = tb[32 + i];
            const float qs = (u >= 256 && u < 448) ? 0.125f * LOG2E : 1.0f;
            zr[base + i] = (bf16)f2bf((x1 * c - x2 * s) * qs); zr[base + 32 + i] = (bf16)f2bf((x2 * c + x1 * s) * qs); }
        if (lane < 16) { const float x1 = bf2f(zr[ZO_KR + lane]), x2 = bf2f(zr[ZO_KR + 16 + lane]), c = tb[64 + lane], s = tb[80 + lane]; const bf16 o1 = (bf16)f2bf(x1 * c - x2 * s), o2 = (bf16)f2bf(x2 * c + x1 * s);
#pragma unroll
            for (int h = 0; h < 6; ++h) { KM[(size_t)t * KLD + h * 96 + 64 + lane] = o1; KM[(size_t)t * KLD + h * 96 + 80 + lane] = o2; } }
        float s1 = 0.f, s2 = 0.f;
#pragma unroll
        for (int k = 0; k < 6; ++k) { const float v = bf2f(zr[ZO_CQ + lane + 64 * k]); s1 += v * v; }
#pragma unroll
        for (int k = 0; k < 4; ++k) { const float v = bf2f(zr[ZO_CKV + lane + 64 * k]); s2 += v * v; }
        s1 = wave_sum(s1); s2 = wave_sum(s2);
        if (lane == 0) { RS[t * 2] = 1.0f / sqrtf(s1 * (1.0f / QRANK) + RMS_EPS); RS[t * 2 + 1] = 1.0f / sqrtf(s2 * (1.0f / KVRANK) + RMS_EPS); } }
}
__device__ __forceinline__ void phase_ret_simple(Frame& F, int l) {
    const int gt = F.vcu * NTHREADS + F.tid, NT = F.G * NTHREADS; const bf16* Z = (const bf16*)(F.wsp() + WS_Z); bf16* YC = (bf16*)(F.wsp() + WS_YCAT); const float* gn = F.in(4) + l * 256;
    for (int ix = gt; ix < NB * 4 * SEQ; ix += NT) { const int t = ix % SEQ, h = (ix / SEQ) % 4, b = ix / (SEQ * 4);
        const float lg2 = __builtin_amdgcn_logf(1.0f - __builtin_amdgcn_exp2f(-5.0f - (float)h));
        const bf16* zb = Z + (size_t)b * SEQ * ZLD; float q[64], o[64];
#pragma unroll
        for (int d = 0; d < 64; d += 8) ld8(zb + (size_t)t * ZLD + ZO_RQ + h * 64 + d, q + d);
#pragma unroll
        for (int d = 0; d < 64; ++d) { q[d] *= 0.125f; o[d] = 0.f; }
        for (int j = 0; j <= t; ++j) { const bf16* kp = zb + (size_t)j * ZLD + ZO_RK + h * 64; const bf16* vp = zb + (size_t)j * ZLD + ZO_RV + h * 64; float s = 0.f;
#pragma unroll
            for (int d = 0; d < 64; d += 8) { float kk[8]; ld8(kp + d, kk);
#pragma unroll
                for (int e = 0; e < 8; ++e) s += q[d + e] * kk[e]; }
            s *= __builtin_amdgcn_exp2f((float)(t - j) * lg2);
#pragma unroll
            for (int d = 0; d < 64; d += 8) { float vv[8]; ld8(vp + d, vv);
#pragma unroll
                for (int e = 0; e < 8; ++e) o[d + e] += s * vv[e]; } }
        float mu = 0.f;
#pragma unroll
        for (int d = 0; d < 64; ++d) mu += o[d];
        mu *= (1.0f / 64.0f); float var = 0.f;
#pragma unroll
        for (int d = 0; d < 64; ++d) { const float dd = o[d] - mu; var += dd * dd; }
        const float rs = 1.0f / sqrtf(var * (1.0f / 64.0f) + LN_EPS);
        const bf16* gp = zb + (size_t)t * ZLD + ZO_RG + h * 64; bf16* yp = YC + ((size_t)b * SEQ + t) * D + YO_RET + h * 64;
#pragma unroll
        for (int d = 0; d < 64; d += 8) { float gg[8]; ld8(gp + d, gg); v4u w; float r[8];
#pragma unroll
            for (int e = 0; e < 8; ++e) r[e] = fsilu(gg[e]) * ((o[d + e] - mu) * rs * gn[h * 64 + d + e]);
            w.x = pk2(r[0], r[1]); w.y = pk2(r[2], r[3]); w.z = pk2(r[4], r[5]); w.w = pk2(r[6], r[7]); *(v4u*)(yp + d) = w; } }
}
__device__ __forceinline__ void phase_dil_simple(Frame& F) {
    const int gt = F.vcu * NTHREADS + F.tid, NT = F.G * NTHREADS; const bf16* Z = (const bf16*)(F.wsp() + WS_Z); bf16* YC = (bf16*)(F.wsp() + WS_YCAT);
    for (int ix = gt; ix < NB * 6 * SEQ; ix += NT) { const int t = ix % SEQ, h = (ix / SEQ) % 6, b = ix / (SEQ * 6);
        const bf16* zb = Z + (size_t)b * SEQ * ZLD; float q[64], o[64];
#pragma unroll
        for (int d = 0; d < 64; d += 8) ld8(zb + (size_t)t * ZLD + ZO_DQ + h * 64 + d, q + d);
#pragma unroll
        for (int d = 0; d < 64; ++d) { q[d] *= 0.125f * LOG2E; o[d] = 0.f; }
        float m = -INFINITY, lsum = 0.f;
        for (int p = 0; p < 3; ++p) { const int r = (p == 0) ? 1 : (p == 1) ? 4 : 16;
            for (int j = 0; j <= 128; ++j) { const int kpos = t - j * r; if (kpos < 0) break;
                const bf16* kp = zb + (size_t)kpos * ZLD + ZO_DK + h * 64; const bf16* vp = zb + (size_t)kpos * ZLD + ZO_DV + h * 64; float s = 0.f;
#pragma unroll
                for (int d = 0; d < 64; d += 8) { float kk[8]; ld8(kp + d, kk);
#pragma unroll
                    for (int e = 0; e < 8; ++e) s += q[d + e] * kk[e]; }
                const float mn = fmaxf(m, s), corr = __builtin_amdgcn_exp2f(m - mn), pe = __builtin_amdgcn_exp2f(s - mn); lsum = lsum * corr + pe; m = mn;
#pragma unroll
                for (int d = 0; d < 64; d += 8) { float vv[8]; ld8(vp + d, vv);
#pragma unroll
                    for (int e = 0; e < 8; ++e) o[d + e] = o[d + e] * corr + pe * vv[e]; } } }
        const float il = 1.0f / lsum; bf16* yp = YC + ((size_t)b * SEQ + t) * D + YO_DIL + h * 64;
#pragma unroll
        for (int d = 0; d < 64; d += 8) { v4u w; w.x = pk2(o[d] * il, o[d + 1] * il); w.y = pk2(o[d + 2] * il, o[d + 3] * il); w.z = pk2(o[d + 4] * il, o[d + 5] * il); w.w = pk2(o[d + 6] * il, o[d + 7] * il); *(v4u*)(yp + d) = w; } }
}
__device__ __forceinline__ void phase_mla_simple(Frame& F) {
    const int gt = F.vcu * NTHREADS + F.tid, NT = F.G * NTHREADS; const bf16* QM = (const bf16*)(F.wsp() + WS_QM); const bf16* KM = (const bf16*)(F.wsp() + WS_KM); const bf16* VM = (const bf16*)(F.wsp() + WS_VM); bf16* YC = (bf16*)(F.wsp() + WS_YCAT);
    for (int ix = gt; ix < NB * 6 * SEQ; ix += NT) { const int t = ix % SEQ, h = (ix / SEQ) % 6, b = ix / (SEQ * 6); const size_t r0 = (size_t)b * SEQ;
        float q[96], o[64];
#pragma unroll
        for (int d = 0; d < 96; d += 8) ld8(QM + (r0 + t) * QLD + h * 96 + d, q + d);
#pragma unroll
        for (int d = 0; d < 64; ++d) o[d] = 0.f;
        float m = -INFINITY, lsum = 0.f;
        for (int j = 0; j <= t; ++j) { const bf16* kp = KM + (r0 + j) * KLD + h * 96; const bf16* vp = VM + (r0 + j) * VLD + h * 64; float s = 0.f;
#pragma unroll
            for (int d = 0; d < 96; d += 8) { float kk[8]; ld8(kp + d, kk);
#pragma unroll
                for (int e = 0; e < 8; ++e) s += q[d + e] * kk[e]; }
            const float mn = fmaxf(m, s), corr = __builtin_amdgcn_exp2f(m - mn), pe = __builtin_amdgcn_exp2f(s - mn); lsum = lsum * corr + pe; m = mn;
#pragma unroll
            for (int d = 0; d < 64; d += 8) { float vv[8]; ld8(vp + d, vv);
#pragma unroll
                for (int e = 0; e < 8; ++e) o[d + e] = o[d + e] * corr + pe * vv[e]; } }
        const float il = 1.0f / lsum; bf16* yp = YC + (r0 + t) * D + YO_MLA + h * 64;
#pragma unroll
        for (int d = 0; d < 64; d += 8) { v4u w; w.x = pk2(o[d] * il, o[d + 1] * il); w.y = pk2(o[d + 2] * il, o[d + 3] * il); w.z = pk2(o[d + 4] * il, o[d + 5] * il); w.w = pk2(o[d + 6] * il, o[d + 7] * il); *(v4u*)(yp + d) = w; } }
}
template <bool MOE_Y>
__device__ __forceinline__ void phase_ln(Frame& F, const float* xin, float* xout, const float* gmod  , const float* lng, const float* lnb,
                                         const float* hm  , int sh_off, int sc_off, const float* wr  , int li) {
    const int gw = F.vcu * NWAVES + F.wave, NGW = F.G * NWAVES, lane = F.lane;
    const bf16* Y = (const bf16*)(F.wsp() + WS_Y); bf16* H = (bf16*)(F.wsp() + WS_H); int* TOPI = (int*)(F.wsp() + WS_TOPI); float* GATE = (float*)(F.wsp() + WS_GATE); const int* TSLOT = (const int*)(F.wsp() + WS_TSLOT);
    volatile LAS unsigned* lcnt = F.MISC + 16;
    if (wr) { if (F.tid < 8) lcnt[F.tid] = 0u; __syncthreads(); }
    for (int t = gw; t < T; t += NGW) { const int b = t / SEQ; const float* g = gmod + (size_t)b * 6 * D; f32x4 v[4]; float s = 0.f;
        float g0 = 0.f, g1 = 0.f; const bf16 *y0, *y1 = nullptr;
        if (MOE_Y) { g0 = GATE[t * 2]; g1 = GATE[t * 2 + 1]; y0 = Y + (size_t)TSLOT[t * 2] * D; y1 = Y + (size_t)TSLOT[t * 2 + 1] * D; } else y0 = Y + (size_t)t * D;
#pragma unroll
        for (int j = 0; j < 4; ++j) { const int d = 4 * lane + 256 * j; const f32x4 xv = *(const f32x4*)(xin + (size_t)t * D + d), gv = *(const f32x4*)(g + d);
            const v2u w0 = *(const v2u*)(y0 + d); f32x4 yv = (f32x4){bflo(w0.x), bfhi(w0.x), bflo(w0.y), bfhi(w0.y)};
            if (MOE_Y) { const v2u w1 = *(const v2u*)(y1 + d); yv = yv * g0 + (f32x4){bflo(w1.x), bfhi(w1.x), bflo(w1.y), bfhi(w1.y)} * g1; }
            v[j] = xv * DN_ALPHA + (1.0f + gv) * yv; s += (v[j].x + v[j].y) + (v[j].z + v[j].w); }
        const float mean = wave_sum(s) * (1.f / D); float s2 = 0.f;
#pragma unroll
        for (int j = 0; j < 4; ++j) { v[j] = v[j] - mean; s2 += (v[j].x * v[j].x + v[j].y * v[j].y) + (v[j].z * v[j].z + v[j].w * v[j].w); }
        const float rstd = 1.f / sqrtf(wave_sum(s2) * (1.f / D) + LN_EPS);
        float lg[8];
#pragma unroll
        for (int e = 0; e < 8; ++e) lg[e] = 0.f;
#pragma unroll
        for (int j = 0; j < 4; ++j) { const int d = 4 * lane + 256 * j; const f32x4 xn = v[j] * rstd * *(const f32x4*)(lng + d) + *(const f32x4*)(lnb + d);
            *(f32x4*)(xout + (size_t)t * D + d) = xn;
            if (hm) { const float* m = hm + (size_t)b * 6 * D; const f32x4 hv = xn * (1.0f + *(const f32x4*)(m + sc_off + d)) + *(const f32x4*)(m + sh_off + d);
                v2u w; w.x = pk2(hv.x, hv.y); w.y = pk2(hv.z, hv.w); *(v2u*)(H + (size_t)t * D + d) = w;
                if (wr) {
#pragma unroll
                    for (int i = 0; i < 4; ++i) { const f32x4 wa = *(const f32x4*)(wr + (size_t)(d + i) * 8), wb = *(const f32x4*)(wr + (size_t)(d + i) * 8 + 4); const float hh = hv[i];
                        lg[0] += hh * wa.x; lg[1] += hh * wa.y; lg[2] += hh * wa.z; lg[3] += hh * wa.w; lg[4] += hh * wb.x; lg[5] += hh * wb.y; lg[6] += hh * wb.z; lg[7] += hh * wb.w; } } } }
        if (wr) {
#pragma unroll
            for (int e = 0; e < 8; ++e) lg[e] = wave_sum(lg[e]);
            if (lane == 0) { int i0 = 0; float v0 = lg[0];
#pragma unroll
                for (int e = 1; e < 8; ++e) if (lg[e] > v0) { v0 = lg[e]; i0 = e; }
                int i1 = 0; float v1 = -INFINITY;
#pragma unroll
                for (int e = 0; e < 8; ++e) if (e != i0 && lg[e] > v1) { v1 = lg[e]; i1 = e; }
                const float ga = 1.0f / (1.0f + __expf(v1 - v0)); TOPI[t * 2] = i0; TOPI[t * 2 + 1] = i1; GATE[t * 2] = ga; GATE[t * 2 + 1] = 1.0f - ga;
                __hip_atomic_fetch_add((LAS unsigned*)(lcnt + i0), 1u, __ATOMIC_RELAXED, __HIP_MEMORY_SCOPE_WORKGROUP); __hip_atomic_fetch_add((LAS unsigned*)(lcnt + i1), 1u, __ATOMIC_RELAXED, __HIP_MEMORY_SCOPE_WORKGROUP); } } }
    if (wr) { __syncthreads(); if (F.tid < 8) __hip_atomic_fetch_add(F.ctl + CW_CNT + 64 * li + F.tid, lcnt[F.tid], RLX_AGENT); }
}
__device__ __forceinline__ void phase_moe_assign(Frame& F, int li) {
    const int gw = F.vcu * NWAVES + F.wave, NGW = F.G * NWAVES, lane = F.lane;
    const int* TOPI = (const int*)(F.wsp() + WS_TOPI); int* TSLOT = (int*)(F.wsp() + WS_TSLOT); int* SEG = (int*)(F.wsp() + WS_SEG); const bf16* H = (const bf16*)(F.wsp() + WS_H); bf16* HS = (bf16*)(F.wsp() + WS_Y);
    int seg[9]; { int acc = 0;
#pragma unroll
        for (int e = 0; e < 8; ++e) { seg[e] = acc; const int c = (int)__hip_atomic_load(F.ctl + CW_CNT + 64 * li + e, RLX_AGENT); acc += (c + 255) & ~255; } seg[8] = acc; }
    if (gw == 0 && lane < 9) { int v = seg[0];
#pragma unroll
        for (int k = 1; k < 9; ++k) v = (lane == k) ? seg[k] : v;
        SEG[lane] = v; }
    for (int blk = gw; blk < T / 64; blk += NGW) { const int t = blk * 64 + lane; const int e0 = TOPI[t * 2], e1 = TOPI[t * 2 + 1]; int s0 = 0, s1 = 0;
        const unsigned long long lt = (1ull << lane) - 1ull;
#pragma unroll
        for (int e = 0; e < 8; ++e) { const unsigned long long m0 = __ballot(e0 == e), m1 = __ballot(e1 == e); const int c0 = __popcll(m0), c1 = __popcll(m1);
            int base = 0; if (lane == 0 && (c0 + c1) > 0) base = (int)__hip_atomic_fetch_add(F.ctl + CW_CUR + 64 * li + e, (unsigned)(c0 + c1), RLX_AGENT);
            base = __builtin_amdgcn_readfirstlane(base) + seg[e];
            if (e0 == e) s0 = base + __popcll(m0 & lt); if (e1 == e) s1 = base + c0 + __popcll(m1 & lt); }
        TSLOT[t * 2] = s0; TSLOT[t * 2 + 1] = s1;
        for (int i = 0; i < 64; ++i) { const int sa = __shfl(s0, i), sb = __shfl(s1, i); const bf16* src = H + (size_t)(blk * 64 + i) * D;
#pragma unroll
            for (int k = 0; k < 2; ++k) { const v4u w = *(const v4u*)(src + k * 512 + lane * 8); *(v4u*)(HS + (size_t)sa * D + k * 512 + lane * 8) = w; *(v4u*)(HS + (size_t)sb * D + k * 512 + lane * 8) = w; } } }
}
typedef float f32x16 __attribute__((ext_vector_type(16)));
typedef short bf16x8v __attribute__((ext_vector_type(8)));
typedef short s16x4 __attribute__((ext_vector_type(4)));
typedef float f32x2v __attribute__((ext_vector_type(2)));
typedef __bf16 bf16x2v __attribute__((ext_vector_type(2)));
#define MFMA32(a, b, c) __builtin_amdgcn_mfma_f32_32x32x16_bf16((a), (b), (c), 0, 0, 0)
__device__ __forceinline__ int crow(int reg, int hh) { return (reg & 3) + 8 * (reg >> 2) + 4 * hh; }
__device__ __forceinline__ unsigned cvtpk(float lo, float hi) { f32x2v v = {lo, hi}; bf16x2v b = __builtin_convertvector(v, bf16x2v); return __builtin_bit_cast(unsigned, b); }
__device__ __forceinline__ bf16x8v pack8(const f32x16& x, int s) { v4u p; p.x = cvtpk(x[8 * s], x[8 * s + 1]); p.y = cvtpk(x[8 * s + 2], x[8 * s + 3]); p.z = cvtpk(x[8 * s + 4], x[8 * s + 5]); p.w = cvtpk(x[8 * s + 6], x[8 * s + 7]); return __builtin_bit_cast(bf16x8v, p); }
__device__ __forceinline__ s16x4 trread(const LAS unsigned char* p) { return __builtin_bit_cast(s16x4, __builtin_amdgcn_ds_read_tr16_b64_v4i16((LAS s16x4*)p)); }
__device__ __forceinline__ bf16x8v vt_frag(const LAS unsigned char* vtile, int VP, int krow0, int dvb, int lane) {
    const int i = lane & 15, q_ = i >> 2, p_ = i & 3, hh = lane >> 5, blk = (lane >> 4) & 1;
    const LAS unsigned char* a = vtile + (krow0 + 4 * hh + q_) * VP + (32 * dvb + 16 * blk + 4 * p_) * 2;
    const s16x4 lo = trread(a), hi = trread(a + 8 * VP);
    return (bf16x8v){lo[0], lo[1], lo[2], lo[3], hi[0], hi[1], hi[2], hi[3]};
}
__device__ __forceinline__ float xhalf_max(float m) { auto rr = __builtin_amdgcn_permlane32_swap(__float_as_uint(m), __float_as_uint(m), false, false); return fmaxf(__uint_as_float(rr[0]), __uint_as_float(rr[1])); }
__device__ __forceinline__ float xhalf_sum(float m) { auto rr = __builtin_amdgcn_permlane32_swap(__float_as_uint(m), __float_as_uint(m), false, false); return __uint_as_float(rr[0]) + __uint_as_float(rr[1]); }
__device__ __forceinline__ void softmax_pv(f32x16& st, float& m_run, float& l_run, f32x16 (&ot)[2], const LAS unsigned char* vtile, int VP, int krow0, int lane) {
    float mt = st[0];
#pragma unroll
    for (int i = 1; i < 16; ++i) mt = fmaxf(mt, st[i]);
    mt = xhalf_max(mt);
    const float m_new = fmaxf(m_run, mt), m_use = fmaxf(m_new, -1e30f), corr = __builtin_amdgcn_exp2f(m_run - m_use);
    float ls = 0.f;
#pragma unroll
    for (int i = 0; i < 16; ++i) { st[i] = __builtin_amdgcn_exp2f(st[i] - m_use); ls += st[i]; }
    l_run = l_run * corr + ls; m_run = m_new;
#pragma unroll
    for (int d = 0; d < 2; ++d)
#pragma unroll
        for (int i = 0; i < 16; ++i) ot[d][i] *= corr;
    const bf16x8v p0 = pack8(st, 0), p1 = pack8(st, 1);
#pragma unroll
    for (int d = 0; d < 2; ++d) { ot[d] = MFMA32(vt_frag(vtile, VP, krow0, d, lane), p0, ot[d]); ot[d] = MFMA32(vt_frag(vtile, VP, krow0 + 16, d, lane), p1, ot[d]); }
}
__device__ __forceinline__ int queue_pull(Frame& F, gu32* head) {
    __syncthreads();
    if (F.tid == 0) F.MISC[24] = __hip_atomic_fetch_add(head, 1u, RLX_AGENT);
    __syncthreads();
    return (int)F.MISC[24];
}

constexpr int MLA_KP = 208, MLA_VP = 144, MLA_KBYTES = 64 * MLA_KP, MLA_VBYTES = 64 * MLA_VP, MLA_VOFF = 2 * MLA_KBYTES;
__device__ __forceinline__ void mla_unit(Frame& F, int b, int h, int qb) {
    const int lane = F.lane, w = F.wave, tid = F.tid, r = lane & 31, hh = lane >> 5;
    const bf16* QM = (const bf16*)(F.wsp() + WS_QM); const bf16* KM = (const bf16*)(F.wsp() + WS_KM); const bf16* VM = (const bf16*)(F.wsp() + WS_VM); bf16* YC = (bf16*)(F.wsp() + WS_YCAT);
    LAS unsigned char* lds = F.lds + RING_OFF;
    const size_t row0 = (size_t)b * SEQ;
    const int qpos = qb * 256 + 32 * w + r;
    const int qmax_w = qb * 256 + 32 * w + 31, qmin_w = qb * 256 + 32 * w;
    bf16x8v qf[6];
#pragma unroll
    for (int s = 0; s < 6; ++s) qf[s] = *(const bf16x8v*)(QM + (row0 + qpos) * QLD + h * 96 + 16 * s + 8 * hh);
    const int kc0 = tid, kc1 = 512 + tid; const bool k1 = tid < 256;
    const int kr0 = kc0 / 12, kch0 = kc0 % 12, kr1 = kc1 / 12, kch1 = kc1 % 12, vr = tid >> 3, vch = tid & 7;
    const bf16* ksrc0 = KM + (row0 + kr0) * KLD + h * 96 + kch0 * 8; const bf16* ksrc1 = KM + (row0 + kr1) * KLD + h * 96 + kch1 * 8; const bf16* vsrc = VM + (row0 + vr) * VLD + h * 64 + vch * 8;
    const int kdst0 = kr0 * MLA_KP + kch0 * 16, kdst1 = kr1 * MLA_KP + kch1 * 16, vdst = MLA_VOFF + vr * MLA_VP + vch * 16;
    const int NT = (qb + 1) * 4;
    v4u kreg0, kreg1 = (v4u){0u, 0u, 0u, 0u}, vreg;
    kreg0 = *(const v4u*)ksrc0; if (k1) kreg1 = *(const v4u*)ksrc1; vreg = *(const v4u*)vsrc;
    __syncthreads();
    *(LAS v4u*)(lds + kdst0) = kreg0; if (k1) *(LAS v4u*)(lds + kdst1) = kreg1; *(LAS v4u*)(lds + vdst) = vreg;
    __syncthreads();
    float m_run = -INFINITY, l_run = 0.f; f32x16 ot[2];
#pragma unroll
    for (int i = 0; i < 16; ++i) { ot[0][i] = 0.f; ot[1][i] = 0.f; }
    for (int t = 0; t < NT; ++t) {
        const int buf = t & 1;
        if (t + 1 < NT) { const size_t o = (size_t)(t + 1) * 64; kreg0 = *(const v4u*)(ksrc0 + o * KLD); if (k1) kreg1 = *(const v4u*)(ksrc1 + o * KLD); vreg = *(const v4u*)(vsrc + o * VLD); }
        const LAS unsigned char* kt = lds + buf * MLA_KBYTES; const LAS unsigned char* vt = lds + MLA_VOFF + buf * MLA_VBYTES;
#pragma unroll
        for (int sub = 0; sub < 2; ++sub) { const int kb = 64 * t + 32 * sub;
            if (kb <= qmax_w) {
                f32x16 st;
#pragma unroll
                for (int i = 0; i < 16; ++i) st[i] = 0.f;
#pragma unroll
                for (int s = 0; s < 6; ++s) { const bf16x8v kf = *(const LAS bf16x8v*)(kt + (32 * sub + r) * MLA_KP + (16 * s + 8 * hh) * 2); st = MFMA32(kf, qf[s], st); }
                if (kb + 31 > qmin_w) {
#pragma unroll
                    for (int i = 0; i < 16; ++i) if (kb + crow(i, hh) > qpos) st[i] = -INFINITY; }
                softmax_pv(st, m_run, l_run, ot, vt, MLA_VP, 32 * sub, lane);
            } }
        if (t + 1 < NT) { const int nb = buf ^ 1; *(LAS v4u*)(lds + nb * MLA_KBYTES + kdst0) = kreg0; if (k1) *(LAS v4u*)(lds + nb * MLA_KBYTES + kdst1) = kreg1; *(LAS v4u*)(lds + nb * MLA_VBYTES + vdst) = vreg; }
        __syncthreads();
    }
    const float inv = 1.0f / xhalf_sum(l_run);
    bf16* yp = YC + (row0 + qpos) * D + YO_MLA + h * 64;
#pragma unroll
    for (int d = 0; d < 2; ++d)
#pragma unroll
        for (int g4 = 0; g4 < 4; ++g4) { v2u wv; wv.x = cvtpk(ot[d][4 * g4] * inv, ot[d][4 * g4 + 1] * inv); wv.y = cvtpk(ot[d][4 * g4 + 2] * inv, ot[d][4 * g4 + 3] * inv);
            *(v2u*)(yp + 32 * d + 8 * g4 + 4 * hh) = wv; }
}
__device__ __forceinline__ void phase_mla_mfma(Frame& F, int l) {
    gu32* head = F.ctl + CW_Q + 64 * (4 * l + 0);
    for (;;) { const int idx = queue_pull(F, head); if (idx >= 48 * 16) break; const int qb = 15 - idx / 48, bh = idx % 48; mla_unit(F, bh / 6, bh % 6, qb); }
}

constexpr int DIL_P = 144, DIL_VOFF = 384 * DIL_P;
__device__ __forceinline__ void dil_unit(Frame& F, int b, int h, int p, int rho, int u) {
    const int lane = F.lane, w = F.wave, tid = F.tid, r = lane & 31, hh = lane >> 5;
    const int rs = (p == 0) ? 1 : (p == 1) ? 4 : 16;
    const bf16* Z = (const bf16*)(F.wsp() + WS_Z); bf16* DO = (bf16*)(F.wsp() + WS_DILO) + (size_t)p * T * 384; float* DL = (float*)(F.wsp() + WS_DILL) + (size_t)p * T * 6;
    LAS unsigned char* lds = F.lds + RING_OFF;
    const size_t row0 = (size_t)b * SEQ;
    const int m0 = 256 * u - 128;
    __syncthreads();
#pragma unroll
    for (int i = 0; i < 6; ++i) { const int c = tid + 512 * i, kk = c >> 3, ch = c & 7, mm = m0 + kk; v4u kv = (v4u){0u, 0u, 0u, 0u}, vv = (v4u){0u, 0u, 0u, 0u};
        if (mm >= 0) { const bf16* src = Z + (row0 + (size_t)mm * rs + rho) * ZLD + h * 64 + ch * 8; kv = *(const v4u*)(src + ZO_DK); vv = *(const v4u*)(src + ZO_DV); }
        *(LAS v4u*)(lds + kk * DIL_P + ch * 16) = kv; *(LAS v4u*)(lds + DIL_VOFF + kk * DIL_P + ch * 16) = vv; }
    const int mq = 256 * u + 32 * w + r; const size_t rowq = row0 + (size_t)mq * rs + rho;
    bf16x8v qf[4];
#pragma unroll
    for (int s = 0; s < 4; ++s) qf[s] = *(const bf16x8v*)(Z + rowq * ZLD + ZO_DQ + h * 64 + 16 * s + 8 * hh);
    __syncthreads();
    float m_run = -INFINITY, l_run = 0.f; f32x16 ot[2];
#pragma unroll
    for (int i = 0; i < 16; ++i) { ot[0][i] = 0.f; ot[1][i] = 0.f; }
    for (int j = 0; j < 5; ++j) { const int kt = w + j;
        if (m0 + 32 * kt + 31 < 0) continue;
        f32x16 st;
#pragma unroll
        for (int i = 0; i < 16; ++i) st[i] = 0.f;
#pragma unroll
        for (int s = 0; s < 4; ++s) { const bf16x8v kf = *(const LAS bf16x8v*)(lds + (32 * kt + r) * DIL_P + (16 * s + 8 * hh) * 2); st = MFMA32(kf, qf[s], st); }
#pragma unroll
        for (int i = 0; i < 16; ++i) { const int mk = m0 + 32 * kt + crow(i, hh); if (mk < 0 || mk > mq || mk < mq - 128) st[i] = -INFINITY; }
        softmax_pv(st, m_run, l_run, ot, lds + DIL_VOFF, DIL_P, 32 * kt, lane);
    }
    const float lt = xhalf_sum(l_run), inv = 1.0f / lt;
    bf16* op = DO + rowq * 384 + h * 64;
#pragma unroll
    for (int d = 0; d < 2; ++d)
#pragma unroll
        for (int g4 = 0; g4 < 4; ++g4) { v2u wv; wv.x = cvtpk(ot[d][4 * g4] * inv, ot[d][4 * g4 + 1] * inv); wv.y = cvtpk(ot[d][4 * g4 + 2] * inv, ot[d][4 * g4 + 3] * inv);
            *(v2u*)(op + 32 * d + 8 * g4 + 4 * hh) = wv; }
    if (hh == 0) DL[rowq * 6 + h] = m_run + __builtin_amdgcn_logf(lt);
}
__device__ __forceinline__ void phase_dil_mfma(Frame& F) {
    for (int idx = (int)blockIdx.x; idx < 48 * 48; idx += F.G) { const int bh = idx / 48, wi = idx % 48; int p, rho, u;
        if (wi < 16) { p = 0; rho = 0; u = wi; } else if (wi < 32) { p = 1; rho = (wi - 16) >> 2; u = (wi - 16) & 3; } else { p = 2; rho = wi - 32; u = 0; }
        dil_unit(F, bh / 6, bh % 6, p, rho, u); }
}
__device__ __forceinline__ void phase_dil_merge(Frame& F) {
    const int gt = F.vcu * NTHREADS + F.tid, NT = F.G * NTHREADS;
    const bf16* DO = (const bf16*)(F.wsp() + WS_DILO); const float* DL = (const float*)(F.wsp() + WS_DILL); bf16* YC = (bf16*)(F.wsp() + WS_YCAT);
    for (int ix = gt; ix < T * 48; ix += NT) { const int t = ix / 48, c = ix % 48, h = c >> 3;
        const float l0 = DL[(size_t)t * 6 + h], l1 = DL[(size_t)T * 6 + (size_t)t * 6 + h], l2 = DL[(size_t)2 * T * 6 + (size_t)t * 6 + h];
        const float mx = fmaxf(l0, fmaxf(l1, l2)); float w0 = __builtin_amdgcn_exp2f(l0 - mx), w1 = __builtin_amdgcn_exp2f(l1 - mx), w2 = __builtin_amdgcn_exp2f(l2 - mx); const float inv = 1.0f / (w0 + w1 + w2); w0 *= inv; w1 *= inv; w2 *= inv;
        float a[8], bb[8], cc[8]; ld8(DO + (size_t)t * 384 + c * 8, a); ld8(DO + (size_t)T * 384 + (size_t)t * 384 + c * 8, bb); ld8(DO + (size_t)2 * T * 384 + (size_t)t * 384 + c * 8, cc);
        v4u o; o.x = pk2(w0 * a[0] + w1 * bb[0] + w2 * cc[0], w0 * a[1] + w1 * bb[1] + w2 * cc[1]); o.y = pk2(w0 * a[2] + w1 * bb[2] + w2 * cc[2], w0 * a[3] + w1 * bb[3] + w2 * cc[3]);
        o.z = pk2(w0 * a[4] + w1 * bb[4] + w2 * cc[4], w0 * a[5] + w1 * bb[5] + w2 * cc[5]); o.w = pk2(w0 * a[6] + w1 * bb[6] + w2 * cc[6], w0 * a[7] + w1 * bb[7] + w2 * cc[7]);
        *(v4u*)(YC + (size_t)t * D + YO_DIL + c * 8) = o; }
}

__device__ __forceinline__ bf16x8v tr_frag_nat(const LAS unsigned char* tile, int P, int krow0, int colblk, int lane) {
    const int i = lane & 15, q_ = i >> 2, p_ = i & 3, hh = lane >> 5, blk = (lane >> 4) & 1;
    const LAS unsigned char* a = tile + (krow0 + 8 * hh + q_) * P + (32 * colblk + 16 * blk + 4 * p_) * 2;
    const s16x4 lo = trread(a), hi = trread(a + 4 * P);
    return (bf16x8v){lo[0], lo[1], lo[2], lo[3], hi[0], hi[1], hi[2], hi[3]};
}
__device__ __forceinline__ float ret_lg2(int h) { return __builtin_amdgcn_logf(1.0f - __builtin_amdgcn_exp2f(-5.0f - (float)h)); }
constexpr int RET_P = 144, RET_VOFF = 256 * RET_P, RET_SOFF = 2 * 256 * RET_P, RET_SBYTES = 64 * RET_P;
__device__ __forceinline__ void ret_state_unit(Frame& F, int b, int h, int cp) {
    const int lane = F.lane, w = F.wave, tid = F.tid, r = lane & 31, hh = lane >> 5;
    const bf16* Z = (const bf16*)(F.wsp() + WS_Z); float* KVS = (float*)(F.wsp() + WS_KVS);
    LAS unsigned char* lds = F.lds + RING_OFF; const size_t row0 = (size_t)b * SEQ + 256 * cp; const float lg2 = ret_lg2(h);
    __syncthreads();
#pragma unroll
    for (int i = 0; i < 4; ++i) { const int c = tid + 512 * i, kk = c >> 3, ch = c & 7; const bf16* src = Z + (row0 + kk) * ZLD + h * 64 + ch * 8;
        float kf[8]; ld8(src + ZO_RK, kf); const float sc = 0.125f * __builtin_amdgcn_exp2f((float)(127 - (kk & 127)) * lg2);
        v4u kv; kv.x = cvtpk(kf[0] * sc, kf[1] * sc); kv.y = cvtpk(kf[2] * sc, kf[3] * sc); kv.z = cvtpk(kf[4] * sc, kf[5] * sc); kv.w = cvtpk(kf[6] * sc, kf[7] * sc);
        *(LAS v4u*)(lds + kk * RET_P + ch * 16) = kv; *(LAS v4u*)(lds + RET_VOFF + kk * RET_P + ch * 16) = *(const v4u*)(src + ZO_RV); }
    __syncthreads();
    const int ci = w >> 2, dvb = (w >> 1) & 1, dkb = w & 1;
    f32x16 acc;
#pragma unroll
    for (int i = 0; i < 16; ++i) acc[i] = 0.f;
#pragma unroll
    for (int ks = 0; ks < 8; ++ks) { const int k0 = 128 * ci + 16 * ks; acc = MFMA32(tr_frag_nat(lds + RET_VOFF, RET_P, k0, dvb, lane), tr_frag_nat(lds, RET_P, k0, dkb, lane), acc); }
    float* dst = KVS + ((size_t)((b * 4 + h) * 32 + 2 * cp + ci)) * 4096;
#pragma unroll
    for (int i = 0; i < 16; ++i) dst[(32 * dvb + crow(i, hh)) * 64 + 32 * dkb + r] = acc[i];
}
__device__ __forceinline__ void phase_ret_state(Frame& F) {
    for (int idx = (int)blockIdx.x; idx < 32 * 16; idx += F.G) { const int bh = idx >> 4, cp = idx & 15; ret_state_unit(F, bh >> 2, bh & 3, cp); }
}
__device__ __forceinline__ void ret_out_unit(Frame& F, int l, int b, int h, int cp) {
    const int lane = F.lane, w = F.wave, tid = F.tid, r = lane & 31, hh = lane >> 5;
    const bf16* Z = (const bf16*)(F.wsp() + WS_Z); const float* KVS = (const float*)(F.wsp() + WS_KVS); bf16* YC = (bf16*)(F.wsp() + WS_YCAT); const float* gn = F.in(4) + l * 256 + h * 64;
    LAS unsigned char* lds = F.lds + RING_OFF; const size_t row0 = (size_t)b * SEQ + 256 * cp; const float lg2 = ret_lg2(h);
    const int ci = w >> 2, wi = w & 3, c = 2 * cp + ci;
    __syncthreads();
#pragma unroll
    for (int i = 0; i < 4; ++i) { const int cc = tid + 512 * i, kk = cc >> 3, ch = cc & 7; const bf16* src = Z + (row0 + kk) * ZLD + h * 64 + ch * 8;
        *(LAS v4u*)(lds + kk * RET_P + ch * 16) = *(const v4u*)(src + ZO_RK); *(LAS v4u*)(lds + RET_VOFF + kk * RET_P + ch * 16) = *(const v4u*)(src + ZO_RV); }
    {
        const int tl = tid & 255; const float dec = __builtin_amdgcn_exp2f(128.0f * lg2); const float* base = KVS + (size_t)((b * 4 + h) * 32) * 4096 + tl * 4;
        f32x4 a[4];
#pragma unroll
        for (int k = 0; k < 4; ++k) a[k] = (f32x4){0.f, 0.f, 0.f, 0.f};
        for (int m = 0; m < c; ++m) {
#pragma unroll
            for (int k = 0; k < 4; ++k) a[k] = a[k] * dec + *(const f32x4*)(base + (size_t)m * 4096 + 1024 * k); }
#pragma unroll
        for (int k = 0; k < 4; ++k) { const int e = tl * 4 + 1024 * k, dv = e >> 6, dk = e & 63; v2u wv; wv.x = cvtpk(a[k].x, a[k].y); wv.y = cvtpk(a[k].z, a[k].w);
            *(LAS v2u*)(lds + RET_SOFF + ci * RET_SBYTES + dv * RET_P + dk * 2) = wv; }
    }
    const int iq = 32 * wi + r; const size_t rowq = row0 + 128 * ci + iq;
    bf16x8v qf[4];
#pragma unroll
    for (int s = 0; s < 4; ++s) qf[s] = *(const bf16x8v*)(Z + rowq * ZLD + ZO_RQ + h * 64 + 16 * s + 8 * hh);
    __syncthreads();
    f32x16 ot[2], oc[2];
#pragma unroll
    for (int i = 0; i < 16; ++i) { ot[0][i] = 0.f; ot[1][i] = 0.f; oc[0][i] = 0.f; oc[1][i] = 0.f; }
    for (int kt = 0; kt <= wi; ++kt) { const int krow = 128 * ci + 32 * kt;
        f32x16 st;
#pragma unroll
        for (int i = 0; i < 16; ++i) st[i] = 0.f;
#pragma unroll
        for (int s = 0; s < 4; ++s) { const bf16x8v kf = *(const LAS bf16x8v*)(lds + (krow + r) * RET_P + (16 * s + 8 * hh) * 2); st = MFMA32(kf, qf[s], st); }
#pragma unroll
        for (int i = 0; i < 16; ++i) { const int dj = iq - (32 * kt + crow(i, hh)); st[i] = (dj >= 0) ? st[i] * 0.125f * __builtin_amdgcn_exp2f((float)dj * lg2) : 0.f; }
        const bf16x8v p0 = pack8(st, 0), p1 = pack8(st, 1);
#pragma unroll
        for (int d = 0; d < 2; ++d) { ot[d] = MFMA32(vt_frag(lds + RET_VOFF, RET_P, krow, d, lane), p0, ot[d]); ot[d] = MFMA32(vt_frag(lds + RET_VOFF, RET_P, krow + 16, d, lane), p1, ot[d]); }
    }
    const LAS unsigned char* sT = lds + RET_SOFF + ci * RET_SBYTES;
#pragma unroll
    for (int d = 0; d < 2; ++d)
#pragma unroll
        for (int s = 0; s < 4; ++s) { const bf16x8v sf = *(const LAS bf16x8v*)(sT + (32 * d + r) * RET_P + (16 * s + 8 * hh) * 2); oc[d] = MFMA32(sf, qf[s], oc[d]); }
    const float xi = __builtin_amdgcn_exp2f((float)(iq + 1) * lg2);
    float sum = 0.f;
#pragma unroll
    for (int d = 0; d < 2; ++d)
#pragma unroll
        for (int i = 0; i < 16; ++i) { ot[d][i] += oc[d][i] * xi; sum += ot[d][i]; }
    const float mu = xhalf_sum(sum) * (1.0f / 64.0f); float sq = 0.f;
#pragma unroll
    for (int d = 0; d < 2; ++d)
#pragma unroll
        for (int i = 0; i < 16; ++i) { const float dd = ot[d][i] - mu; sq += dd * dd; }
    const float rstd = 1.0f / sqrtf(xhalf_sum(sq) * (1.0f / 64.0f) + LN_EPS);
    const bf16* gp = Z + rowq * ZLD + ZO_RG + h * 64; bf16* yp = YC + rowq * D + YO_RET + h * 64;
#pragma unroll
    for (int d = 0; d < 2; ++d)
#pragma unroll
        for (int g4 = 0; g4 < 4; ++g4) { const int dv = 32 * d + 8 * g4 + 4 * hh; const v2u gw = *(const v2u*)(gp + dv); const f32x4 gg = *(const f32x4*)(gn + dv);
            const float o0 = fsilu(bflo(gw.x)) * ((ot[d][4 * g4] - mu) * rstd * gg.x), o1 = fsilu(bfhi(gw.x)) * ((ot[d][4 * g4 + 1] - mu) * rstd * gg.y), o2 = fsilu(bflo(gw.y)) * ((ot[d][4 * g4 + 2] - mu) * rstd * gg.z), o3 = fsilu(bfhi(gw.y)) * ((ot[d][4 * g4 + 3] - mu) * rstd * gg.w);
            v2u wv; wv.x = cvtpk(o0, o1); wv.y = cvtpk(o2, o3); *(v2u*)(yp + dv) = wv; }
}
__device__ __forceinline__ void phase_ret_out(Frame& F, int l) {
    for (int idx = (int)blockIdx.x; idx < 32 * 16; idx += F.G) { const int bh = idx >> 4, cp = idx & 15; ret_out_unit(F, l, bh >> 2, bh & 3, cp); }
}
#ifndef MK_PER_PHASE
#define MK_PER_PHASE 0
#endif
constexpr int NPHASES = 43;
struct Args { const float* in[23]; float* out; unsigned char* ws; int ph_lo, ph_hi; };
static_assert(sizeof(Args) == 23 * 8 + 8 + 8 + 8, "no padding");

__global__ void __launch_bounds__(NTHREADS, 2) mk_fwd(Args args) {
    extern __shared__ __attribute__((aligned(16))) unsigned char lds[];
    Frame F;
    F.lds = (LAS unsigned char*)lds; F.MISC = (volatile LAS unsigned*)(F.lds + MISC_OFF);
    F.tid = threadIdx.x; F.lane = F.tid & 63; F.wave = __builtin_amdgcn_readfirstlane(F.tid >> 6); F.wave_s = F.wave;
    F.G = gridDim.x; { const int bx = blockIdx.x; F.vcu = (F.G % 8 == 0) ? (bx % 8) * (F.G / 8) + bx / 8 : bx; }
    F.ctl = (gu32*)(args.ws + WS_CTL);
    for (int u = F.tid; u < (LDS_BYTES - LDSCTL_OFF) / 4; u += NTHREADS) ((LAS unsigned*)(F.lds + LDSCTL_OFF))[u] = 0u;
    __syncthreads();
    if (F.tid == 0) { LAS unsigned long long* pt = (LAS unsigned long long*)(F.lds + PTAB_OFF);
#pragma unroll
        for (int i = 0; i < 23; ++i) pt[i] = (unsigned long long)args.in[i];
        pt[23] = (unsigned long long)args.out; pt[24] = (unsigned long long)args.ws; }
    __syncthreads();
    XcdBarrier bar = xcd_barrier_post((unsigned*)(F.ctl + CW_BAR), F.MISC + 8);
    int pc = 0;
#define PH_ON() (args.ph_lo <= pc && pc < args.ph_hi && (F.refresh(), true))
#define PH_END() do { if (args.ph_lo <= pc && pc + 1 < args.ph_hi) xcd_barrier(bar); ++pc; } while (0)
#define WSB(T_, off) ((T_*)(F.wsp() + (off)))
    if (PH_ON()) { phase_mod_tab(F); phase_convert(F, 0); } PH_END();
    if (PH_ON()) { phase_modulate0(F); } PH_END();
    for (int l = 0; l < NL; ++l) {
        const bool moe = (l & 1) != 0; const int li = l >> 1;
        if (l > 0) { if (PH_ON()) { phase_convert(F, l); } PH_END(); }
        if (PH_ON()) { pg8::Gemm g{WSB(bf16, WS_H), WSB(bf16, WS_WIN), D, D, D, 0, 0}; pg8::StaticOrder S; S.init(T, ZLD, F.G, (int)blockIdx.x); pg8::EpiBf16 E{WSB(bf16, WS_Z), ZLD, D_IN};
            pg8::gemm_phase<pg8::EpiBf16, pg8::StaticOrder, true>(F.lds + RING_OFF, g, S, E, F.tid); } PH_END();
        if (PH_ON()) { phase_rope_stats(F); } PH_END();
        if (PH_ON()) {
            { pg8::Gemm g{WSB(bf16, WS_Z) + ZO_CQ, WSB(bf16, WS_WUQ), ZLD, QRANK, QRANK, 0, 0}; pg8::StaticOrder S; S.init(T, 768, F.G, (int)blockIdx.x); pg8::EpiMlaQ E{WSB(bf16, WS_QM), WSB(const float, WS_RS), WSB(const float, WS_TAB), MLA_QSCALE, 0};
              pg8::gemm_phase<pg8::EpiMlaQ, pg8::StaticOrder, true>(F.lds + RING_OFF, g, S, E, F.tid); }
            { pg8::Gemm g{WSB(bf16, WS_Z) + ZO_CKV, WSB(bf16, WS_WUKV), ZLD, KVRANK, KVRANK, 0, 0}; pg8::StaticOrder S; S.init(T, 768, F.G, (int)blockIdx.x); pg8::EpiMlaKV E{WSB(bf16, WS_KM), WSB(bf16, WS_VM), WSB(const float, WS_RS)};
              pg8::gemm_phase<pg8::EpiMlaKV, pg8::StaticOrder, true>(F.lds + RING_OFF, g, S, E, F.tid); }
            phase_dil_mfma(F); phase_ret_state(F);
        } PH_END();
        if (PH_ON()) { phase_dil_merge(F); phase_ret_out(F, l); phase_mla_mfma(F, l); } PH_END();
        if (PH_ON()) { pg8::Gemm g{WSB(bf16, WS_YCAT), WSB(bf16, WS_WOUT), D, D, D, 0, 0}; pg8::StaticOrder S; S.init(T, D, F.G, (int)blockIdx.x); pg8::EpiBf16 E{WSB(bf16, WS_Y), D, D};
            pg8::gemm_phase<pg8::EpiBf16, pg8::StaticOrder, true>(F.lds + RING_OFF, g, S, E, F.tid); } PH_END();
        if (PH_ON()) { phase_ln<false>(F, l == 0 ? F.in(0) : F.outp(), F.outp(), WSB(const float, WS_MOD) + (size_t)l * NB * 6 * D + 2 * D, F.in(12) + l * D, F.in(13) + l * D, WSB(const float, WS_MOD) + (size_t)l * NB * 6 * D, 3 * D, 4 * D, moe ? F.in(19) + (size_t)li * D * NEXP : nullptr, li); } PH_END();

        if (!moe) {
            if (PH_ON()) { pg8::Gemm g{WSB(bf16, WS_H), WSB(bf16, WS_WFF), D, D, D, 0, 0}; pg8::StaticOrder S; S.init(T, 2 * DFF, F.G, (int)blockIdx.x); pg8::EpiSwiglu E{WSB(bf16, WS_FF), DFF};
                pg8::gemm_phase<pg8::EpiSwiglu, pg8::StaticOrder, true>(F.lds + RING_OFF, g, S, E, F.tid); } PH_END();
            if (PH_ON()) { pg8::Gemm g{WSB(bf16, WS_FF), WSB(const bf16, WS_WFF + WFF_W2_OFF_DENSE), DFF, DFF, DFF, 0, 0}; pg8::StaticOrder S; S.init(T, D, F.G, (int)blockIdx.x); pg8::EpiBf16 E{WSB(bf16, WS_Y), D, D};
                pg8::gemm_phase<pg8::EpiBf16, pg8::StaticOrder, true>(F.lds + RING_OFF, g, S, E, F.tid); } PH_END();
            if (PH_ON()) { phase_ln<false>(F, F.outp(), F.outp(), WSB(const float, WS_MOD) + (size_t)l * NB * 6 * D + 5 * D, F.in(14) + l * D, F.in(15) + l * D, (l + 1 < NL) ? WSB(const float, WS_MOD) + (size_t)(l + 1) * NB * 6 * D : nullptr, 0, D, nullptr, 0); } PH_END();
        } else {
            if (PH_ON()) { phase_moe_assign(F, li); } PH_END();
            if (PH_ON()) { pg8::Gemm g{WSB(bf16, WS_Y), WSB(bf16, WS_WFF), D, D, D, 0, (long)2 * DFFE * D}; pg8::GroupedOrder S; S.init(WSB(const int, WS_SEG), 2 * DFFE / 256, F.G, (int)blockIdx.x); pg8::EpiSwiglu E{WSB(bf16, WS_FF), DFFE};
                pg8::gemm_phase<pg8::EpiSwiglu, pg8::GroupedOrder, true>(F.lds + RING_OFF, g, S, E, F.tid); } PH_END();
            if (PH_ON()) { pg8::Gemm g{WSB(bf16, WS_FF), WSB(const bf16, WS_WFF + WFF_W2_OFF_MOE), DFFE, DFFE, DFFE, 0, (long)D * DFFE}; pg8::GroupedOrder S; S.init(WSB(const int, WS_SEG), D / 256, F.G, (int)blockIdx.x); pg8::EpiBf16 E{WSB(bf16, WS_Y), D, D};
                pg8::gemm_phase<pg8::EpiBf16, pg8::GroupedOrder, true>(F.lds + RING_OFF, g, S, E, F.tid); } PH_END();
            if (PH_ON()) { phase_ln<true>(F, F.outp(), F.outp(), WSB(const float, WS_MOD) + (size_t)l * NB * 6 * D + 5 * D, F.in(14) + l * D, F.in(15) + l * D, (l + 1 < NL) ? WSB(const float, WS_MOD) + (size_t)(l + 1) * NB * 6 * D : nullptr, 0, D, nullptr, 0); } PH_END();
        }
    }
#undef PH_ON
#undef PH_END
}

extern "C" void kernel_launch(void* const* d_in, const int* in_sizes, int n_in, void* d_out, int out_size, void* d_ws, size_t ws_size, hipStream_t stream) {
    static int grid = 0;
    if (grid == 0) {
        if (n_in != 23 || out_size != T * D || ws_size < WS_END) { fprintf(stderr, "kernel_launch: unexpected shapes (n_in %d out %d ws %zu)\n", n_in, out_size, ws_size); grid = -1; return; }
        int dev = 0, cus = 0, per_cu = 0;
        if (hipGetDevice(&dev) != hipSuccess || hipDeviceGetAttribute(&cus, hipDeviceAttributeMultiprocessorCount, dev) != hipSuccess) { grid = -1; return; }
        if (hipFuncSetAttribute((const void*)mk_fwd, hipFuncAttributeMaxDynamicSharedMemorySize, LDS_BYTES) != hipSuccess) { fprintf(stderr, "kernel_launch: hipFuncSetAttribute failed\n"); grid = -1; return; }
        if (hipOccupancyMaxActiveBlocksPerMultiprocessor(&per_cu, (const void*)mk_fwd, NTHREADS, LDS_BYTES) != hipSuccess || per_cu < 1) fprintf(stderr, "kernel_launch: occupancy query reports %d\n", per_cu);
        (void)hipGetLastError();
        grid = cus;
    }
    if (grid < 0) return;
    if (hipMemsetAsync((char*)d_ws + WS_CTL, 0, CTL_ZERO_BYTES, stream) != hipSuccess) return;
    Args a{};
    for (int i = 0; i < 23; ++i) a.in[i] = (const float*)d_in[i];
    a.out = (float*)d_out; a.ws = (unsigned char*)d_ws;
#if MK_PER_PHASE
    for (int p = 0; p < NPHASES; ++p) { a.ph_lo = p; a.ph_hi = p + 1; hipLaunchKernelGGL(mk_fwd, dim3(grid), dim3(NTHREADS), LDS_BYTES, stream, a); }
#else
    a.ph_lo = 0; a.ph_hi = NPHASES; hipLaunchKernelGGL(mk_fwd, dim3(grid), dim3(NTHREADS), LDS_BYTES, stream, a);
#endif
}
```

```cpp
#include <hip/hip_runtime.h>
#include <cstdio>
#include <cstdint>

namespace pg8 {
#define PG8_LAS __attribute__((address_space(3)))
typedef unsigned short bf16_t;
typedef short bf16x8 __attribute__((ext_vector_type(8)));
typedef float f32x4 __attribute__((ext_vector_type(4)));
typedef unsigned u32x4 __attribute__((ext_vector_type(4)));
typedef unsigned u32x2 __attribute__((ext_vector_type(2)));
typedef int i32x4 __attribute__((ext_vector_type(4)));
typedef int i32x8 __attribute__((ext_vector_type(8)));
constexpr int BM = 256, BK = 64, HALF = 128, HTB = HALF * BK * 2, STAGE_BYTES = 8 * HTB, NXCD = 8, WGM = 8;

__host__ __device__ __forceinline__ int lds_byte(int r, int c) { const int st = (r >> 4) * 2 + (c >> 5), rr = r & 15, cc = c & 31, ob = rr * 64 + cc * 2; return st * 1024 + (ob ^ (((ob >> 9) & 1) << 5)); }
__host__ __device__ __forceinline__ void stage_rc(int b, int& R, int& C) { const int st = b / 1024, sb = b % 1024, swz = sb ^ (((sb >> 9) & 1) << 5); R = (st >> 1) * 16 + swz / 64; C = (st & 1) * 32 + (swz % 64) / 2; }
__host__ __device__ __forceinline__ int perm32(int rho) { const int n = rho >> 4, i = rho & 15; return 8 * (i >> 2) + 4 * n + (i & 3); }

struct Unit { int pm, pn, g; };
struct Gemm { const bf16_t* A; const bf16_t* Bt; int lda, ldb, K; int pad; long gstride; };

struct StaticOrder {
    int nM, nN, nwg, G, c;
    __device__ void init(int M, int N, int G_, int c_) { nM = M / BM; nN = N / BM; nwg = nM * nN; G = G_; c = c_; }
    __device__ bool next(int i, Unit& u) const {
        const long L = (long)i * G + c; if (L >= nwg) return false;
        int wgid = (int)L; { const int q = nwg / NXCD, r = nwg % NXCD, xcd = wgid % NXCD, off = wgid / NXCD; wgid = (xcd < r ? xcd * (q + 1) : r * (q + 1) + (xcd - r) * q) + off; }
        const int nig = WGM * nN, gid = wgid / nig, fm = gid * WGM, gsz = (nM - fm) < WGM ? (nM - fm) : WGM;
        u.pm = fm + ((wgid % nig) % gsz); u.pn = (wgid % nig) / gsz; u.g = 0; return true;
    }
};
struct GroupedOrder {
    int tp[9]; int nN, nwg, G, c;
    __device__ void init(const int* seg, int nN_, int G_, int c_) {
#pragma unroll
        for (int k = 0; k < 9; ++k) tp[k] = __builtin_amdgcn_readfirstlane(seg[k]) / BM;
        nN = nN_; nwg = tp[8] * nN; G = G_; c = c_; }
    __device__ bool next(int i, Unit& u) const {
        const long L = (long)i * G + c; if (L >= nwg) return false;
        const int wgid = (int)L, nM = tp[8];
        const int nig = WGM * nN, gid = wgid / nig, fm = gid * WGM, gsz = (nM - fm) < WGM ? (nM - fm) : WGM;
        u.pm = fm + ((wgid % nig) % gsz); u.pn = (wgid % nig) / gsz; int e = 0;
#pragma unroll
        for (int k = 1; k < 8; ++k) e += (u.pm >= tp[k]) ? 1 : 0;
        u.g = e; return true;
    }
};

__device__ __forceinline__ unsigned cvt_pk_bf16(float lo, float hi) { unsigned r; asm volatile("v_cvt_pk_bf16_f32 %0, %1, %2" : "=v"(r) : "v"(lo), "v"(hi)); return r; }

struct EpiBf16 {
    static constexpr bool PERM = true;
    bf16_t* O; int ldc; int ncols;
    __device__ __forceinline__ void operator()(const f32x4 (&acc)[2][2][4][2], const Unit& u, int wr, int wc, int fr, int fq) const {
        const int row0 = u.pm * BM + wr * 64 + fr; const int col0 = u.pn * BM + wc * 32 + 8 * fq;
#pragma unroll
        for (int ai = 0; ai < 2; ++ai)
#pragma unroll
            for (int m = 0; m < 4; ++m) { bf16_t* rowp = O + (size_t)(row0 + ai * HALF + m * 16) * ldc + col0;
#pragma unroll
                for (int bj = 0; bj < 2; ++bj) { if (col0 + bj * HALF >= ncols) continue; const f32x4 v0 = acc[ai][bj][m][0], v1 = acc[ai][bj][m][1];
                    u32x4 w; w.x = cvt_pk_bf16(v0[0], v0[1]); w.y = cvt_pk_bf16(v0[2], v0[3]); w.z = cvt_pk_bf16(v1[0], v1[1]); w.w = cvt_pk_bf16(v1[2], v1[3]);
                    *(u32x4*)(rowp + bj * HALF) = w; } }
    }
};
struct EpiBf16S {
    static constexpr bool PERM = true;
    bf16_t* O; int ldc; float scale;
    __device__ __forceinline__ void operator()(const f32x4 (&acc)[2][2][4][2], const Unit& u, int wr, int wc, int fr, int fq) const {
        const int row0 = u.pm * BM + wr * 64 + fr; const int col0 = u.pn * BM + wc * 32 + 8 * fq;
#pragma unroll
        for (int ai = 0; ai < 2; ++ai)
#pragma unroll
            for (int m = 0; m < 4; ++m) { bf16_t* rowp = O + (size_t)(row0 + ai * HALF + m * 16) * ldc + col0;
#pragma unroll
                for (int bj = 0; bj < 2; ++bj) { const f32x4 v0 = acc[ai][bj][m][0] * scale, v1 = acc[ai][bj][m][1] * scale;
                    u32x4 w; w.x = cvt_pk_bf16(v0[0], v0[1]); w.y = cvt_pk_bf16(v0[2], v0[3]); w.z = cvt_pk_bf16(v1[0], v1[1]); w.w = cvt_pk_bf16(v1[2], v1[3]);
                    *(u32x4*)(rowp + bj * HALF) = w; } }
    }
};
struct EpiSwiglu {
    static constexpr bool PERM = false;
    bf16_t* O; int ldc;
    __device__ __forceinline__ void operator()(const f32x4 (&acc)[2][2][4][2], const Unit& u, int wr, int wc, int fr, int fq) const {
        const int row0 = u.pm * BM + wr * 64 + fr; const int col0 = u.pn * 128 + wc * 16 + 4 * fq;
#pragma unroll
        for (int ai = 0; ai < 2; ++ai)
#pragma unroll
            for (int m = 0; m < 4; ++m) { bf16_t* rowp = O + (size_t)(row0 + ai * HALF + m * 16) * ldc + col0;
#pragma unroll
                for (int bj = 0; bj < 2; ++bj) { const f32x4 a1 = acc[ai][bj][m][0], a3 = acc[ai][bj][m][1]; float o[4];
#pragma unroll
                    for (int j = 0; j < 4; ++j) o[j] = a1[j] * __builtin_amdgcn_rcpf(1.0f + __builtin_amdgcn_exp2f(-1.4426950408889634f * a1[j])) * a3[j];
                    u32x2 w; w.x = cvt_pk_bf16(o[0], o[1]); w.y = cvt_pk_bf16(o[2], o[3]); *(u32x2*)(rowp + bj * 64) = w; } }
    }
};
__device__ __forceinline__ unsigned pack4_fp8(float a, float b, float c, float d) { int p = 0; p = __builtin_amdgcn_cvt_pk_fp8_f32(a, b, p, false); p = __builtin_amdgcn_cvt_pk_fp8_f32(c, d, p, true); return (unsigned)p; }
struct EpiSwiglu8 {
    static constexpr bool PERM = false;
    unsigned char* O; int ldc; float scale;
    __device__ __forceinline__ void operator()(const f32x4 (&acc)[2][2][4][2], const Unit& u, int wr, int wc, int fr, int fq) const {
        const int row0 = u.pm * BM + wr * 64 + fr; const int col0 = u.pn * 128 + wc * 16 + 4 * fq;
#pragma unroll
        for (int ai = 0; ai < 2; ++ai)
#pragma unroll
            for (int m = 0; m < 4; ++m) { unsigned char* rowp = O + (size_t)(row0 + ai * HALF + m * 16) * ldc + col0;
#pragma unroll
                for (int bj = 0; bj < 2; ++bj) { const f32x4 a1 = acc[ai][bj][m][0] * scale, a3 = acc[ai][bj][m][1] * scale; float o[4];
#pragma unroll
                    for (int j = 0; j < 4; ++j) { const float v = a1[j] * __builtin_amdgcn_rcpf(1.0f + __builtin_amdgcn_exp2f(-1.4426950408889634f * a1[j])) * a3[j] * 4.0f; o[j] = __builtin_amdgcn_fmed3f(v, -448.0f, 448.0f); }
                    *(unsigned*)(rowp + bj * 64) = pack4_fp8(o[0], o[1], o[2], o[3]); } }
    }
};
struct EpiMlaQ {
    static constexpr bool PERM = false;
    bf16_t* Q; const float* rs; const float* tab; float qscale; int pad;
    __device__ __forceinline__ void operator()(const f32x4 (&acc)[2][2][4][2], const Unit& u, int wr, int wc, int fr, int fq) const {
        const int row0 = u.pm * BM + wr * 64 + fr;
#pragma unroll
        for (int bj = 0; bj < 2; ++bj) { const int c0 = u.pn * BM + bj * HALF + wc * 32; if (c0 >= 576) continue; const bool rope = (c0 % 96) == 64;
#pragma unroll
            for (int ai = 0; ai < 2; ++ai)
#pragma unroll
                for (int m = 0; m < 4; ++m) { const int t = row0 + ai * HALF + m * 16; const float sc = rs[t * 2] * qscale; f32x4 v0 = acc[ai][bj][m][0] * sc, v1 = acc[ai][bj][m][1] * sc;
                    if (rope) { const f32x4 cs = *(const f32x4*)(tab + (size_t)t * 96 + 64 + 4 * fq), sn = *(const f32x4*)(tab + (size_t)t * 96 + 80 + 4 * fq); const f32x4 o0 = v0 * cs - v1 * sn, o1 = v1 * cs + v0 * sn; v0 = o0; v1 = o1; }
                    bf16_t* p = Q + (size_t)t * 576 + c0 + 4 * fq; u32x2 w; w.x = cvt_pk_bf16(v0[0], v0[1]); w.y = cvt_pk_bf16(v0[2], v0[3]); *(u32x2*)p = w; w.x = cvt_pk_bf16(v1[0], v1[1]); w.y = cvt_pk_bf16(v1[2], v1[3]); *(u32x2*)(p + 16) = w; } }
    }
};
struct EpiMlaKV {
    static constexpr bool PERM = true;
    bf16_t* Km; bf16_t* Vm; const float* rs;
    __device__ __forceinline__ void operator()(const f32x4 (&acc)[2][2][4][2], const Unit& u, int wr, int wc, int fr, int fq) const {
        const int row0 = u.pm * BM + wr * 64 + fr;
#pragma unroll
        for (int bj = 0; bj < 2; ++bj) { const int c8 = u.pn * BM + bj * HALF + wc * 32 + 8 * fq; const int head = c8 >> 7, off = c8 & 127;
#pragma unroll
            for (int ai = 0; ai < 2; ++ai)
#pragma unroll
                for (int m = 0; m < 4; ++m) { const int t = row0 + ai * HALF + m * 16; const float sc = rs[t * 2 + 1]; const f32x4 v0 = acc[ai][bj][m][0] * sc, v1 = acc[ai][bj][m][1] * sc;
                    bf16_t* p = (off < 64) ? Km + (size_t)t * 576 + head * 96 + off : Vm + (size_t)t * 384 + head * 64 + (off - 64);
                    u32x4 w; w.x = cvt_pk_bf16(v0[0], v0[1]); w.y = cvt_pk_bf16(v0[2], v0[3]); w.z = cvt_pk_bf16(v1[0], v1[1]); w.w = cvt_pk_bf16(v1[2], v1[3]); *(u32x4*)p = w; } }
    }
};

template <class Epi, class Sched, bool ALIGN_EPI, int FP8 = 0  >
__device__ __forceinline__ void gemm_phase(PG8_LAS unsigned char* lds, const Gemm g, const Sched& S, const Epi& E, const int tid) {
    const int wid = __builtin_amdgcn_readfirstlane(tid >> 6), lane = tid & 63, wr = wid >> 2, wc = wid & 3, fr = lane & 15, fq = lane >> 4;
    const int K = g.K, nt = K / BK;
    unsigned voffA[2], voffB[2];
#pragma unroll
    for (int i = 0; i < 2; ++i) { int R, C; stage_rc(tid * 16 + i * 8192, R, C); const int Rb = Epi::PERM ? ((R & ~31) + perm32(R & 31)) : R;
        voffA[i] = (unsigned)(R * g.lda + C) * 2u; voffB[i] = (unsigned)(Rb * g.ldb + C) * 2u; }
    const size_t kstep = (size_t)(BK * 2);
    const size_t hstepA = (size_t)HALF * g.lda * 2, hstepB = (size_t)HALF * g.ldb * 2;
    const size_t tstepA = 2 * hstepA, tstepB = 2 * hstepB;
    const unsigned ldsw = (unsigned)wid * 1024u;
    const int aoff = lds_byte(wr * 64 + fr, fq * 8), boff = lds_byte(wc * 32 + fr, fq * 8);
#define PG8_SA(b, h) (((b) * 2 + (h)) * HTB)
#define PG8_SB(b, h) ((4 + (b) * 2 + (h)) * HTB)
#define PG8_STAGE(bufoff, gbase, voff) do { _Pragma("unroll") for (int _i = 0; _i < 2; ++_i) \
        __builtin_amdgcn_global_load_lds((const unsigned*)((const char*)(gbase) + (voff)[_i]), (PG8_LAS unsigned*)(lds + (bufoff) + ldsw + _i * 8192), 16, 0, 0); } while (0)
#define PG8_LD8(addr) __builtin_shufflevector(*(const PG8_LAS i32x4*)(addr), *(const PG8_LAS i32x4*)((addr) + 1024), 0, 1, 2, 3, 4, 5, 6, 7)
#define PG8_LDA(dst, b, h) do { _Pragma("unroll") for (int m = 0; m < 4; ++m) dst[m] = PG8_LD8(lds + PG8_SA(b, h) + aoff + m * 2048); } while (0)
#define PG8_LDB(dst, b, h) do { _Pragma("unroll") for (int n = 0; n < 2; ++n) dst[n] = PG8_LD8(lds + PG8_SB(b, h) + boff + n * 2048); } while (0)
#define PG8_LO(x) __builtin_bit_cast(bf16x8, __builtin_shufflevector((x), (x), 0, 1, 2, 3))
#define PG8_HI(x) __builtin_bit_cast(bf16x8, __builtin_shufflevector((x), (x), 4, 5, 6, 7))
#define PG8_MMA(ai, bj, At, Bt) do { __builtin_amdgcn_s_setprio(1); _Pragma("unroll") for (int m = 0; m < 4; ++m) _Pragma("unroll") for (int n = 0; n < 2; ++n) { \
        if constexpr (FP8 != 0) asm volatile("v_mfma_f32_16x16x128_f8f6f4 %0, %1, %2, %0" : "+v"(acc[ai][bj][m][n]) : "v"(Bt[n]), "v"(At[m])); \
        else { acc[ai][bj][m][n] = __builtin_amdgcn_mfma_f32_16x16x32_bf16(PG8_LO(Bt[n]), PG8_LO(At[m]), acc[ai][bj][m][n], 0, 0, 0); acc[ai][bj][m][n] = __builtin_amdgcn_mfma_f32_16x16x32_bf16(PG8_HI(Bt[n]), PG8_HI(At[m]), acc[ai][bj][m][n], 0, 0, 0); } } __builtin_amdgcn_s_setprio(0); } while (0)
#define PG8_WAIT_V(n) asm volatile("s_waitcnt vmcnt(" #n ")" ::: "memory")
#define PG8_WAIT_L(n) asm volatile("s_waitcnt lgkmcnt(" #n ")" ::: "memory")
#define PG8_BAR __builtin_amdgcn_s_barrier()
#define PG8_SCHED __builtin_amdgcn_sched_barrier(0)
    Unit cur, nxt; int ui = 0;
    if (!S.next(0, cur)) return;
    f32x4 acc[2][2][4][2];
#pragma unroll
    for (int a = 0; a < 2; ++a)
#pragma unroll
        for (int b = 0; b < 2; ++b)
#pragma unroll
            for (int m = 0; m < 4; ++m)
#pragma unroll
                for (int n = 0; n < 2; ++n) acc[a][b][m][n] = (f32x4){0.f, 0.f, 0.f, 0.f};
    i32x8 At[4], B0[2], B1[2];
    const char* cA = (const char*)g.A + (size_t)cur.pm * tstepA; const char* cB = (const char*)(g.Bt + (size_t)cur.g * g.gstride) + (size_t)cur.pn * tstepB;
    PG8_STAGE(PG8_SB(0, 0), cB, voffB); PG8_STAGE(PG8_SB(0, 1), cB + hstepB, voffB); PG8_STAGE(PG8_SA(0, 0), cA, voffA); PG8_STAGE(PG8_SA(0, 1), cA + hstepA, voffA);
    if (wr == 1) PG8_BAR;
    PG8_WAIT_V(2); PG8_BAR;
    PG8_STAGE(PG8_SB(1, 0), cB + kstep, voffB); PG8_STAGE(PG8_SA(1, 0), cA + kstep, voffA); PG8_STAGE(PG8_SB(1, 1), cB + hstepB + kstep, voffB);
    PG8_WAIT_V(6); PG8_BAR;
    for (;;) {
        const bool has_next = S.next(ui + 1, nxt);
        const char* nA = has_next ? (const char*)g.A + (size_t)nxt.pm * tstepA : cA; const char* nB = has_next ? (const char*)(g.Bt + (size_t)nxt.g * g.gstride) + (size_t)nxt.pn * tstepB : cB;
#pragma nounroll
        for (int t = 0; t < nt; t += 2) {
            const bool last = (t == nt - 2);
            const char* a1 = cA + (size_t)(t + 1) * kstep;
            const char* a2 = last ? nA : cA + (size_t)(t + 2) * kstep; const char* b2 = last ? nB : cB + (size_t)(t + 2) * kstep;
            const char* a3 = a2 + kstep; const char* b3 = b2 + kstep;
            PG8_LDB(B0, 0, 0); PG8_LDB(B1, 0, 1); PG8_SCHED; PG8_LDA(At, 0, 0); PG8_STAGE(PG8_SA(1, 1), a1 + hstepA, voffA);
            PG8_WAIT_V(8); PG8_WAIT_L(0); PG8_BAR; PG8_MMA(0, 0, At, B0); PG8_MMA(0, 1, At, B1); PG8_BAR; PG8_SCHED;
            PG8_LDA(At, 0, 1); PG8_STAGE(PG8_SB(0, 0), b2, voffB); PG8_STAGE(PG8_SB(0, 1), b2 + hstepB, voffB); PG8_STAGE(PG8_SA(0, 0), a2, voffA);
            PG8_WAIT_V(8); PG8_WAIT_L(0); PG8_BAR; PG8_MMA(1, 0, At, B0); PG8_MMA(1, 1, At, B1); PG8_BAR; PG8_SCHED;
            PG8_LDB(B0, 1, 0); PG8_LDB(B1, 1, 1); PG8_SCHED; PG8_LDA(At, 1, 0); PG8_STAGE(PG8_SA(0, 1), a2 + hstepA, voffA);
            PG8_WAIT_V(8); PG8_WAIT_L(0); PG8_BAR; PG8_MMA(0, 0, At, B0); PG8_MMA(0, 1, At, B1); PG8_BAR; PG8_SCHED;
            PG8_LDA(At, 1, 1); PG8_STAGE(PG8_SB(1, 0), b3, voffB); PG8_STAGE(PG8_SB(1, 1), b3 + hstepB, voffB); PG8_STAGE(PG8_SA(1, 0), a3, voffA);
            PG8_WAIT_V(8); PG8_WAIT_L(0); PG8_BAR; PG8_MMA(1, 0, At, B0); PG8_MMA(1, 1, At, B1); PG8_BAR; PG8_SCHED;
        }
        if constexpr (ALIGN_EPI) { if (wr == 0) PG8_BAR; }
        if constexpr (FP8 != 0) asm volatile("s_nop 15\n\ts_nop 15" ::: "memory");
        E(acc, cur, wr, wc, fr, fq);
        if (!has_next) break;
#pragma unroll
        for (int a = 0; a < 2; ++a)
#pragma unroll
            for (int b = 0; b < 2; ++b)
#pragma unroll
                for (int m = 0; m < 4; ++m)
#pragma unroll
                    for (int n = 0; n < 2; ++n) acc[a][b][m][n] = (f32x4){0.f, 0.f, 0.f, 0.f};
        cur = nxt; cA = nA; cB = nB; ++ui;
        if constexpr (ALIGN_EPI) { if (wr == 1) PG8_BAR; }
    }
    PG8_WAIT_V(0);
    if constexpr (!ALIGN_EPI) { if (wr == 0) PG8_BAR; }
    PG8_BAR;
#undef PG8_SA
#undef PG8_SB
#undef PG8_STAGE
#undef PG8_LDA
#undef PG8_LDB
#undef PG8_MMA
#undef PG8_LD8
#undef PG8_LO
#undef PG8_HI
#undef PG8_WAIT_V
#undef PG8_WAIT_L
#undef PG8_BAR
#undef PG8_SCHED
}
}
constexpr int NWAVES = 8, NTHREADS = 512;
constexpr int NB = 8, SEQ = 4096, T = NB * SEQ, NL = 4, D = 1024, NEXP = 8;
constexpr int D_IN = 2848, ZLD = 3072;
constexpr int ZO_RQ = 0, ZO_RK = 256, ZO_RV = 512, ZO_RG = 768, ZO_DQ = 1024, ZO_DK = 1408, ZO_DV = 1792, ZO_CQ = 2176, ZO_CKV = 2560, ZO_KR = 2816;
constexpr int QRANK = 384, KVRANK = 256, QLD = 576, KLD = 576, VLD = 384;
constexpr int YO_RET = 0, YO_DIL = 256, YO_MLA = 640;
constexpr int DFF = 2816, DFFE = 3584;
constexpr float LN_EPS = 1e-5f, RMS_EPS = 1e-6f, DN_ALPHA = 1.6817928305074290f;
constexpr float LOG2E = 1.4426950408889634f;
constexpr float MLA_QSCALE = 0.10206207261596577f * LOG2E;
constexpr int MAXSLOT = 2 * T + NEXP * 256;

constexpr size_t MiB = 1u << 20;
constexpr size_t WS_CTL = 0, CTL_ZERO_BYTES = 1 * MiB;
constexpr size_t WS_MOD = 1 * MiB;
constexpr size_t WS_RS = 2 * MiB, WS_TOPI = WS_RS + 256 * 1024, WS_GATE = WS_TOPI + 256 * 1024, WS_TSLOT = WS_GATE + 256 * 1024, WS_SEG = WS_TSLOT + 256 * 1024;
constexpr size_t WS_TAB = 4 * MiB;
constexpr size_t WS_WIN = 16 * MiB, WS_WUQ = 22 * MiB, WS_WUKV = 23 * MiB, WS_WOUT = 24 * MiB, WS_WFF = 26 * MiB;
constexpr size_t WFF_W2_OFF_DENSE = (size_t)2 * DFF * D * 2, WFF_W2_OFF_MOE8 = (size_t)NEXP * 2 * DFFE * D;
constexpr size_t WS_H = 194 * MiB;
constexpr size_t WS_A = 258 * MiB;
constexpr size_t WS_Z = WS_A, WS_QM = WS_A + 192 * MiB, WS_KM = WS_A + 228 * MiB, WS_VM = WS_A + 264 * MiB, WS_KVS = WS_A + 288 * MiB, WS_DILO = WS_A + 304 * MiB, WS_DILL = WS_A + 376 * MiB, WS_YCAT = WS_A + 380 * MiB;
constexpr size_t WS_FF = WS_A;
constexpr size_t WS_Y = 720 * MiB;
constexpr size_t WS_END = 852 * MiB;
static_assert((size_t)MAXSLOT * DFFE * 2 <= 462 * MiB && (size_t)MAXSLOT * D * 2 <= 132 * MiB && (size_t)T * ZLD * 2 == 192 * MiB, "ws map");
constexpr int CW_TMO = 0, CW_CODE = 1, CW_BAR = 4096, CW_CNT = 8192  , CW_CUR = 8448  , CW_Q = 8704  ;

constexpr int RING_OFF = 0, RING_BYTES = 131072;
constexpr int LDSCTL_OFF = RING_BYTES, MISC_OFF = LDSCTL_OFF + 320;
constexpr int LDS_BYTES = 147456;
constexpr int PTAB_OFF = LDSCTL_OFF + 512;

#define GAS __attribute__((address_space(1)))
#define LAS __attribute__((address_space(3)))
typedef unsigned short bf16;
typedef unsigned v4u __attribute__((ext_vector_type(4)));
typedef unsigned v2u __attribute__((ext_vector_type(2)));
typedef float f32x4 __attribute__((ext_vector_type(4)));
typedef GAS unsigned gu32;
#define RLX_AGENT __ATOMIC_RELAXED, __HIP_MEMORY_SCOPE_AGENT
#define LDS_WAIT() asm volatile("s_waitcnt lgkmcnt(0)" ::: "memory")
#define VM_WAIT() asm volatile("s_waitcnt vmcnt(0)" ::: "memory")
__device__ __forceinline__ unsigned f2bf(float f) { unsigned u = __builtin_bit_cast(unsigned, f); return (u + 0x7fffu + ((u >> 16) & 1u)) >> 16; }
__device__ __forceinline__ unsigned pk2(float lo, float hi) { return f2bf(lo) | (f2bf(hi) << 16); }
__device__ __forceinline__ float bf2f(unsigned short b) { return __builtin_bit_cast(float, (unsigned)b << 16); }
__device__ __forceinline__ float bflo(unsigned w) { return __builtin_bit_cast(float, w << 16); }
__device__ __forceinline__ float bfhi(unsigned w) { return __builtin_bit_cast(float, w & 0xffff0000u); }
__device__ __forceinline__ void ld8(const bf16* p, float* o) { const v4u w = *(const v4u*)p; o[0] = bflo(w.x); o[1] = bfhi(w.x); o[2] = bflo(w.y); o[3] = bfhi(w.y); o[4] = bflo(w.z); o[5] = bfhi(w.z); o[6] = bflo(w.w); o[7] = bfhi(w.w); }
__device__ __forceinline__ float fsilu(float x) { return x * __builtin_amdgcn_rcpf(1.0f + __builtin_amdgcn_exp2f(-LOG2E * x)); }

#define XB_TMO      128
#define XB_XCNT(j)  (256  + 64 * (j))
#define XB_XSUB(j)  (1280 + 64 * (j))
#define XB_XGEN(j)  (2304 + 64 * (j))
#define XB_TOP      3328
#define XB_TOPGEN   3392
#define XCD_BAR_WORDS 3456
#define XB_SPIN_CAP (1u << 18)
__device__ __forceinline__ unsigned xb_ld(unsigned* p)              { return __hip_atomic_load(p, __ATOMIC_RELAXED, __HIP_MEMORY_SCOPE_AGENT); }
__device__ __forceinline__ unsigned xb_add(unsigned* p, unsigned v) { return __hip_atomic_fetch_add(p, v, __ATOMIC_RELAXED, __HIP_MEMORY_SCOPE_AGENT); }
__device__ __forceinline__ unsigned xb_xcc_id() { return (unsigned)__builtin_amdgcn_s_getreg((3 << 11) | 20) & 0xFu; }
#define XB_SPIN(cond, bar) do { unsigned _sp = 0; while (cond) { __builtin_amdgcn_s_sleep(1); \
    if ((++_sp & 255u) == 0u) { if (xb_ld(&(bar)[XB_TMO])) break; if (_sp > XB_SPIN_CAP) { atomicAdd(&(bar)[XB_TMO], 1u); break; } } } } while (0)
struct XcdBarrier { unsigned* bar; unsigned x; volatile LAS unsigned* st; };
__device__ __forceinline__ XcdBarrier xcd_barrier_post(unsigned* bar, volatile LAS unsigned* st) {
    XcdBarrier b; b.bar = bar; b.x = xb_xcc_id(); b.st = st;
    if (threadIdx.x == 0) (void)xb_add(&bar[XB_XCNT(b.x)], 1u);
    return b;
}
__device__ __forceinline__ void xcd_barrier_complete(unsigned* bar, unsigned x, unsigned& nloc, unsigned& nx) {
    const unsigned G = gridDim.x * gridDim.y * gridDim.z;
    unsigned sum, cnt, mine, sp = 0u;
    for (;;) {
        sum = 0u; cnt = 0u; mine = 0u;
#pragma unroll
        for (unsigned j = 0; j < 16; ++j) { const unsigned c = xb_ld(&bar[XB_XCNT(j)]); sum += c; cnt += (c > 0u) ? 1u : 0u; mine = (j == x) ? c : mine; }
        if (sum == G) break;
        __builtin_amdgcn_s_sleep(1);
        if ((++sp & 255u) == 0u) { if (xb_ld(&bar[XB_TMO])) break; if (sp > XB_SPIN_CAP) { atomicAdd(&bar[XB_TMO], 1u); break; } }
    }
    nloc = mine > 0u ? mine : 1u; nx = cnt > 0u ? cnt : 1u;
}
__device__ __forceinline__ void xcd_barrier(const XcdBarrier& b) {
    asm volatile("s_waitcnt vmcnt(0)" ::: "memory");
    __syncthreads();
    if (threadIdx.x == 0) {
        unsigned* bar = b.bar; asm volatile("" : "+s"(bar));
        __builtin_amdgcn_s_waitcnt(0);
        unsigned nloc = b.st[0], nx = b.st[1];
        if (nloc == 0u) { xcd_barrier_complete(bar, b.x, nloc, nx); b.st[0] = nloc; b.st[1] = nx; }
        const unsigned old = xb_add(&bar[XB_XSUB(b.x)], 1u);
        const unsigned gen = old / nloc;
        if (old + 1u == (gen + 1u) * nloc) {
            __builtin_amdgcn_fence(__ATOMIC_RELEASE, "agent");
            asm volatile("s_waitcnt vmcnt(0)" ::: "memory");
            const unsigned og = xb_add(&bar[XB_TOP], 1u);
            const unsigned tg = og / nx;
            if (og + 1u == (tg + 1u) * nx) xb_add(&bar[XB_TOPGEN], 1u);
            else XB_SPIN(xb_ld(&bar[XB_TOPGEN]) == tg, bar);
            __builtin_amdgcn_fence(__ATOMIC_ACQUIRE, "agent");
            xb_add(&bar[XB_XGEN(b.x)], 1u);
            asm volatile("s_waitcnt vmcnt(0)" ::: "memory");
        } else {
            XB_SPIN(xb_ld(&bar[XB_XGEN(b.x)]) == gen, bar);
            __builtin_amdgcn_fence(__ATOMIC_ACQUIRE, "agent");
            asm volatile("s_waitcnt vmcnt(0)" ::: "memory");
        }
    }
    __syncthreads();
}

struct Frame {
    LAS unsigned char* lds; volatile LAS unsigned* MISC; gu32* ctl;
    int tid, lane, wave, vcu, G;
    __device__ __forceinline__ unsigned long long ptab(int i) const { const volatile LAS unsigned* p = (const volatile LAS unsigned*)(lds + PTAB_OFF) + 2 * i; const unsigned lo = p[0], hi = p[1];
        return ((unsigned long long)(unsigned)__builtin_amdgcn_readfirstlane((int)hi) << 32) | (unsigned)__builtin_amdgcn_readfirstlane((int)lo); }
    int wave_s;
    __device__ __forceinline__ void refresh() { int w = wave_s; asm volatile("" : "+s"(w)); const unsigned z0 = MISC[30];     int ln = (int)__builtin_amdgcn_mbcnt_hi(~0u, __builtin_amdgcn_mbcnt_lo(~0u, z0)); asm volatile("" : "+v"(ln)); wave = w; lane = ln; tid = w * 64 + ln;
        unsigned long long c = ptab(24); ctl = (gu32*)c; }
    __device__ __forceinline__ const float* in(int i) const { return (const float*)ptab(i); }
    __device__ __forceinline__ float* outp() const { return (float*)ptab(23); }
    __device__ __forceinline__ unsigned char* wsp() const { return (unsigned char*)ptab(24); }
};
__constant__ double INVT[48] = {
0.15915494309189535, 0.11934937021124886, 0.089499401608891013, 0.067115083005227255, 0.050329212104487035, 0.037741584717419771, 0.028302195830623399, 0.02122365276477766, 0.015915494309189534, 0.011934937021124886, 0.0089499401608891024, 0.0067115083005227253, 0.0050329212104487037, 0.0037741584717419772, 0.0028302195830623399, 0.0021223652764777662, 0.0015915494309189536, 0.0011934937021124885, 0.00089499401608891024, 0.0006711508300522726, 0.00050329212104487033, 0.00037741584717419774, 0.00028302195830623395, 0.00021223652764777661, 0.00015915494309189535, 0.00011934937021124886, 8.9499401608891018e-05, 6.7115083005227254e-05, 5.0329212104487035e-05, 3.7741584717419777e-05, 2.8302195830623396e-05, 2.1223652764777659e-05, 0.15915494309189535, 0.089499401608891013, 0.050329212104487035, 0.028302195830623399, 0.015915494309189534, 0.0089499401608891024, 0.0050329212104487037, 0.0028302195830623399, 0.0015915494309189536, 0.00089499401608891024, 0.00050329212104487033, 0.00028302195830623395, 0.00015915494309189535, 8.9499401608891018e-05, 5.0329212104487035e-05, 2.8302195830623396e-05};

__device__ __forceinline__ float shx(float v, int o, int lane) { return __builtin_bit_cast(float, __builtin_amdgcn_ds_bpermute((lane ^ o) << 2, __builtin_bit_cast(int, v))); }
__device__ __forceinline__ void transpose_item(const float* W, int K, int N, bf16* WT, int mode, const float* kscale, LAS float* scr, int item, int lane, bool fp8 = false) {
    const int nblk = N / 32, kb = item / nblk, nb = item % nblk, k0 = 64 * kb, n0 = 32 * nb;
    float tv[32];
#pragma unroll
    for (int i = 0; i < 32; ++i) tv[i] = __builtin_nontemporal_load(W + (size_t)(k0 + 2 * i + (lane >> 5)) * N + n0 + (lane & 31));
#pragma unroll
    for (int i = 0; i < 32; ++i) { const int kk = 2 * i + (lane >> 5); float v = tv[i]; if (kscale) v *= kscale[k0 + kk]; scr[kk * 33 + (lane & 31)] = v; }
    LDS_WAIT(); asm volatile("" ::: "memory");
    const int c = lane & 7;
#pragma unroll
    for (int j = 0; j < 4; ++j) { const int n = (lane >> 3) + 8 * j; const LAS float* s = scr + (8 * c) * 33 + n;
        v4u o; o.x = pk2(s[0 * 33], s[1 * 33]); o.y = pk2(s[2 * 33], s[3 * 33]); o.z = pk2(s[4 * 33], s[5 * 33]); o.w = pk2(s[6 * 33], s[7 * 33]);
        const int nn = n0 + n; const int row = (mode == 0) ? nn : (32 * (nn >> 4) + (nn & 15) + (mode == 2 ? 16 : 0));
        if (fp8) { v2u o8; o8.x = pg8::pack4_fp8(s[0 * 33] * 64.f, s[1 * 33] * 64.f, s[2 * 33] * 64.f, s[3 * 33] * 64.f); o8.y = pg8::pack4_fp8(s[4 * 33] * 64.f, s[5 * 33] * 64.f, s[6 * 33] * 64.f, s[7 * 33] * 64.f);
            *(GAS v2u*)((unsigned char*)WT + (size_t)row * K + k0 + 8 * c) = o8; }
        else *(GAS v4u*)(WT + (size_t)row * K + k0 + 8 * c) = o; }
    LDS_WAIT(); asm volatile("" ::: "memory");
}
__device__ __forceinline__ void phase_convert(Frame& F, int l) {
    LAS float* scr = (LAS float*)(F.lds + RING_OFF + F.wave * 16384);
    const int gw = F.vcu * NWAVES + F.wave, NGW = F.G * NWAVES;
    bf16* WIN = (bf16*)(F.wsp() + WS_WIN); bf16* WUQ = (bf16*)(F.wsp() + WS_WUQ); bf16* WUKV = (bf16*)(F.wsp() + WS_WUKV); bf16* WOUT = (bf16*)(F.wsp() + WS_WOUT); bf16* WFF = (bf16*)(F.wsp() + WS_WFF);
    constexpr int I_IN = 16 * 89, I_UQ = 6 * 18, I_UKV = 4 * 24, I_OUT = 16 * 32, I_D1 = 16 * 88, I_D2 = 44 * 32, I_M1 = 16 * 112, I_M2 = 56 * 32;
    const bool moe = (l & 1) != 0; const int li = l >> 1;
    const int nff = moe ? NEXP * (2 * I_M1 + I_M2) : (2 * I_D1 + I_D2);
    const int nitems = I_IN + I_UQ + I_UKV + I_OUT + nff;
    for (int it = gw; it < nitems; it += NGW) {
        int r = it; const float* W; int K, N, mode = 0; bf16* WT; const float* ks = nullptr; bool f8 = false;
        if (r < I_IN) { W = F.in(3) + (size_t)l * D * D_IN; K = D; N = D_IN; WT = WIN; }
        else if ((r -= I_IN) < I_UQ) { W = F.in(7) + (size_t)l * QRANK * 576; K = QRANK; N = 576; WT = WUQ; ks = F.in(5) + l * QRANK; }
        else if ((r -= I_UQ) < I_UKV) { W = F.in(8) + (size_t)l * KVRANK * 768; K = KVRANK; N = 768; WT = WUKV; ks = F.in(6) + l * KVRANK; }
        else if ((r -= I_UKV) < I_OUT) { W = F.in(9) + (size_t)l * D * D; K = D; N = D; WT = WOUT; }
        else { r -= I_OUT;
            if (!moe) {
                if (r < I_D1) { W = F.in(16) + (size_t)li * D * DFF; K = D; N = DFF; WT = WFF; mode = 1; }
                else if ((r -= I_D1) < I_D1) { W = F.in(17) + (size_t)li * D * DFF; K = D; N = DFF; WT = WFF; mode = 2; }
                else { r -= I_D1; W = F.in(18) + (size_t)li * DFF * D; K = DFF; N = D; WT = (bf16*)((unsigned char*)WFF + WFF_W2_OFF_DENSE); }
            } else { const int per = 2 * I_M1 + I_M2; const int e = r / per; r -= e * per; f8 = true;
                if (r < I_M1) { W = F.in(20) + ((size_t)li * NEXP + e) * D * DFFE; K = D; N = DFFE; WT = (bf16*)((unsigned char*)WFF + (size_t)e * 2 * DFFE * D); mode = 1; }
                else if ((r -= I_M1) < I_M1) { W = F.in(21) + ((size_t)li * NEXP + e) * D * DFFE; K = D; N = DFFE; WT = (bf16*)((unsigned char*)WFF + (size_t)e * 2 * DFFE * D); mode = 2; }
                else { r -= I_M1; W = F.in(22) + ((size_t)li * NEXP + e) * DFFE * D; K = DFFE; N = D; WT = (bf16*)((unsigned char*)WFF + WFF_W2_OFF_MOE8 + (size_t)e * D * DFFE); }
            } }
        transpose_item(W, K, N, WT, mode, ks, scr, r, F.lane, f8);
    }
    const int gt = F.vcu * NTHREADS + F.tid, NT = F.G * NTHREADS;
    { GAS v4u* p = (GAS v4u*)(WIN + (size_t)D_IN * D); const int n = (ZLD - D_IN) * D / 8; unsigned zz = 0u; asm volatile("" : "+v"(zz)); for (int i = gt; i < n; i += NT) p[i] = (v4u){zz, zz, zz, zz}; }
    { GAS v4u* p = (GAS v4u*)(WUQ + (size_t)576 * QRANK); const int n = (768 - 576) * QRANK / 8; unsigned zz = 0u; asm volatile("" : "+v"(zz)); for (int i = gt; i < n; i += NT) p[i] = (v4u){zz, zz, zz, zz}; }
}
__device__ __forceinline__ void phase_mod_tab(Frame& F) {
    const int gt = F.vcu * NTHREADS + F.tid, NT = F.G * NTHREADS;
    float* MOD = (float*)(F.wsp() + WS_MOD); float* TAB = (float*)(F.wsp() + WS_TAB);
    const float* c = F.in(1); const float* w_ada = F.in(10); const float* b_ada = F.in(11); const int* pos = (const int*)F.in(2);
    for (int ix = gt; ix < NL * NB * 6 * D; ix += NT) { const int j = ix % (6 * D), b = (ix / (6 * D)) % NB, l = ix / (6 * D * NB);
        const float* w = w_ada + (size_t)l * D * 6 * D + j; float acc = b_ada[(size_t)l * 6 * D + j];
        for (int k = 0; k < D; ++k) acc += fsilu(c[b * D + k]) * w[(size_t)k * 6 * D];
        MOD[ix] = acc; }
    for (int ix = gt; ix < T * 48; ix += NT) { const int t = ix / 48, i = ix % 48; const double x = (double)pos[t] * INVT[i]; const float fr = (float)(x - floor(x));
        const float s = __builtin_amdgcn_sinf(fr), cc = __builtin_amdgcn_cosf(fr); float* r = TAB + (size_t)t * 96;
        if (i < 32) { r[i] = cc; r[32 + i] = s; } else { r[64 + (i - 32)] = cc; r[80 + (i - 32)] = s; } }
}
__device__ __forceinline__ void phase_modulate0(Frame& F) {
    const int gt = F.vcu * NTHREADS + F.tid, NT = F.G * NTHREADS; const float* MOD = (const float*)(F.wsp() + WS_MOD); bf16* H = (bf16*)(F.wsp() + WS_H); const float* x = F.in(0);
    for (int ix = gt; ix < T * D / 4; ix += NT) { const int t = ix / (D / 4), d = (ix % (D / 4)) * 4, b = t / SEQ; const float* m = MOD + (size_t)b * 6 * D;
        const f32x4 xv = *(const f32x4*)(x + (size_t)ix * 4), sh = *(const f32x4*)(m + d), sc = *(const f32x4*)(m + D + d); const f32x4 h = xv * (1.0f + sc) + sh;
        v2u w; w.x = pk2(h.x, h.y); w.y = pk2(h.z, h.w); *(v2u*)(H + (size_t)ix * 4) = w; }
}
__device__ __forceinline__ void rope8(const v4u a, const v4u b, const float* cs, const float* sn, float qs, v4u& oa, v4u& ob) {
    const f32x4 c0 = *(const f32x4*)cs, c1 = *(const f32x4*)(cs + 4), s0 = *(const f32x4*)sn, s1 = *(const f32x4*)(sn + 4);
    const float x1[8] = {bflo(a.x), bfhi(a.x), bflo(a.y), bfhi(a.y), bflo(a.z), bfhi(a.z), bflo(a.w), bfhi(a.w)}, x2[8] = {bflo(b.x), bfhi(b.x), bflo(b.y), bfhi(b.y), bflo(b.z), bfhi(b.z), bflo(b.w), bfhi(b.w)};
    const float c[8] = {c0.x, c0.y, c0.z, c0.w, c1.x, c1.y, c1.z, c1.w}, s[8] = {s0.x, s0.y, s0.z, s0.w, s1.x, s1.y, s1.z, s1.w}; float o1[8], o2[8];
#pragma unroll
    for (int i = 0; i < 8; ++i) { o1[i] = (x1[i] * c[i] - x2[i] * s[i]) * qs; o2[i] = (x2[i] * c[i] + x1[i] * s[i]) * qs; }
    oa.x = pk2(o1[0], o1[1]); oa.y = pk2(o1[2], o1[3]); oa.z = pk2(o1[4], o1[5]); oa.w = pk2(o1[6], o1[7]); ob.x = pk2(o2[0], o2[1]); ob.y = pk2(o2[2], o2[3]); ob.z = pk2(o2[4], o2[5]); ob.w = pk2(o2[6], o2[7]);
}
__device__ __forceinline__ float sumsq8(const v4u a) { const float x[8] = {bflo(a.x), bfhi(a.x), bflo(a.y), bfhi(a.y), bflo(a.z), bfhi(a.z), bflo(a.w), bfhi(a.w)}; float s = 0.f;
#pragma unroll
    for (int i = 0; i < 8; ++i) s += x[i] * x[i];
    return s; }
__device__ __forceinline__ void phase_rope_stats(Frame& F) {
    const int gw = F.vcu * NWAVES + F.wave, NGW = F.G * NWAVES, lane = F.lane;
    bf16* Z = (bf16*)(F.wsp() + WS_Z); bf16* KM = (bf16*)(F.wsp() + WS_KM); const float* TAB = (const float*)(F.wsp() + WS_TAB); float* RS = (float*)(F.wsp() + WS_RS);
    const int cc = lane & 3, hdA = lane >> 2, hdB = 16 + (lane >> 2);
    const int baseA = (hdA < 4) ? ZO_RQ + hdA * 64 : (hdA < 8) ? ZO_RK + (hdA - 4) * 64 : (hdA < 14) ? ZO_DQ + (hdA - 8) * 64 : ZO_DK + (hdA - 14) * 64;
    const int baseB = ZO_DK + (hdB - 14) * 64;
    const float qsA = (hdA >= 8 && hdA < 14) ? 0.125f * LOG2E : 1.0f;
    for (int t = gw; t < T; t += NGW) { bf16* zr = Z + (size_t)t * ZLD; const float* tb = TAB + (size_t)t * 96;
        const v4u a1 = *(const v4u*)(zr + baseA + 8 * cc), a2 = *(const v4u*)(zr + baseA + 32 + 8 * cc);
        v4u b1 = (v4u){0u, 0u, 0u, 0u}, b2 = b1, k1 = b1, k2 = b1, q1 = b1, q2 = b1;
        if (lane < 16) { b1 = *(const v4u*)(zr + baseB + 8 * cc); b2 = *(const v4u*)(zr + baseB + 32 + 8 * cc); }
        else if (lane < 18) { k1 = *(const v4u*)(zr + ZO_KR + 8 * (lane - 16)); k2 = *(const v4u*)(zr + ZO_KR + 16 + 8 * (lane - 16)); }
        if (lane < 48) q1 = *(const v4u*)(zr + ZO_CQ + 8 * lane);
        if (lane < 32) q2 = *(const v4u*)(zr + ZO_CKV + 8 * lane);
        v4u oa, ob; rope8(a1, a2, tb + 8 * cc, tb + 32 + 8 * cc, qsA, oa, ob); *(v4u*)(zr + baseA + 8 * cc) = oa; *(v4u*)(zr + baseA + 32 + 8 * cc) = ob;
        if (lane < 16) { rope8(b1, b2, tb + 8 * cc, tb + 32 + 8 * cc, 1.0f, oa, ob); *(v4u*)(zr + baseB + 8 * cc) = oa; *(v4u*)(zr + baseB + 32 + 8 * cc) = ob; }
        else if (lane < 18) { const int j = lane - 16; rope8(k1, k2, tb + 64 + 8 * j, tb + 80 + 8 * j, 1.0f, oa, ob);
#pragma unroll
            for (int h = 0; h < 6; ++h) { *(v4u*)(KM + (size_t)t * KLD + h * 96 + 64 + 8 * j) = oa; *(v4u*)(KM + (size_t)t * KLD + h * 96 + 80 + 8 * j) = ob; } }
        float s1 = (lane < 48) ? sumsq8(q1) : 0.f, s2 = (lane < 32) ? sumsq8(q2) : 0.f;
#pragma unroll
        for (int o = 1; o < 64; o <<= 1) { s1 += shx(s1, o, lane); s2 += shx(s2, o, lane); }
        if (lane == 0) { RS[t * 2] = 1.0f / sqrtf(s1 * (1.0f / QRANK) + RMS_EPS); RS[t * 2 + 1] = 1.0f / sqrtf(s2 * (1.0f / KVRANK) + RMS_EPS); } }
}
__device__ __forceinline__ void phase_ret_simple(Frame& F, int l) {
    const int gt = F.vcu * NTHREADS + F.tid, NT = F.G * NTHREADS; const bf16* Z = (const bf16*)(F.wsp() + WS_Z); bf16* YC = (bf16*)(F.wsp() + WS_YCAT); const float* gn = F.in(4) + l * 256;
    for (int ix = gt; ix < NB * 4 * SEQ; ix += NT) { const int t = ix % SEQ, h = (ix / SEQ) % 4, b = ix / (SEQ * 4);
        const float lg2 = __builtin_amdgcn_logf(1.0f - __builtin_amdgcn_exp2f(-5.0f - (float)h));
        const bf16* zb = Z + (size_t)b * SEQ * ZLD; float q[64], o[64];
#pragma unroll
        for (int d = 0; d < 64; d += 8) ld8(zb + (size_t)t * ZLD + ZO_RQ + h * 64 + d, q + d);
#pragma unroll
        for (int d = 0; d < 64; ++d) { q[d] *= 0.125f; o[d] = 0.f; }
        for (int j = 0; j <= t; ++j) { const bf16* kp = zb + (size_t)j * ZLD + ZO_RK + h * 64; const bf16* vp = zb + (size_t)j * ZLD + ZO_RV + h * 64; float s = 0.f;
#pragma unroll
            for (int d = 0; d < 64; d += 8) { float kk[8]; ld8(kp + d, kk);
#pragma unroll
                for (int e = 0; e < 8; ++e) s += q[d + e] * kk[e]; }
            s *= __builtin_amdgcn_exp2f((float)(t - j) * lg2);
#pragma unroll
            for (int d = 0; d < 64; d += 8) { float vv[8]; ld8(vp + d, vv);
#pragma unroll
                for (int e = 0; e < 8; ++e) o[d + e] += s * vv[e]; } }
        float mu = 0.f;
#pragma unroll
        for (int d = 0; d < 64; ++d) mu += o[d];
        mu *= (1.0f / 64.0f); float var = 0.f;
#pragma unroll
        for (int d = 0; d < 64; ++d) { const float dd = o[d] - mu; var += dd * dd; }
        const float rs = 1.0f / sqrtf(var * (1.0f / 64.0f) + LN_EPS);
        const bf16* gp = zb + (size_t)t * ZLD + ZO_RG + h * 64; bf16* yp = YC + ((size_t)b * SEQ + t) * D + YO_RET + h * 64;
#pragma unroll
        for (int d = 0; d < 64; d += 8) { float gg[8]; ld8(gp + d, gg); v4u w; float r[8];
#pragma unroll
            for (int e = 0; e < 8; ++e) r[e] = fsilu(gg[e]) * ((o[d + e] - mu) * rs * gn[h * 64 + d + e]);
            w.x = pk2(r[0], r[1]); w.y = pk2(r[2], r[3]); w.z = pk2(r[4], r[5]); w.w = pk2(r[6], r[7]); *(v4u*)(yp + d) = w; } }
}
__device__ __forceinline__ void phase_dil_simple(Frame& F) {
    const int gt = F.vcu * NTHREADS + F.tid, NT = F.G * NTHREADS; const bf16* Z = (const bf16*)(F.wsp() + WS_Z); bf16* YC = (bf16*)(F.wsp() + WS_YCAT);
    for (int ix = gt; ix < NB * 6 * SEQ; ix += NT) { const int t = ix % SEQ, h = (ix / SEQ) % 6, b = ix / (SEQ * 6);
        const bf16* zb = Z + (size_t)b * SEQ * ZLD; float q[64], o[64];
#pragma unroll
        for (int d = 0; d < 64; d += 8) ld8(zb + (size_t)t * ZLD + ZO_DQ + h * 64 + d, q + d);
#pragma unroll
        for (int d = 0; d < 64; ++d) { q[d] *= 0.125f * LOG2E; o[d] = 0.f; }
        float m = -INFINITY, lsum = 0.f;
        for (int p = 0; p < 3; ++p) { const int r = (p == 0) ? 1 : (p == 1) ? 4 : 16;
            for (int j = 0; j <= 128; ++j) { const int kpos = t - j * r; if (kpos < 0) break;
                const bf16* kp = zb + (size_t)kpos * ZLD + ZO_DK + h * 64; const bf16* vp = zb + (size_t)kpos * ZLD + ZO_DV + h * 64; float s = 0.f;
#pragma unroll
                for (int d = 0; d < 64; d += 8) { float kk[8]; ld8(kp + d, kk);
#pragma unroll
                    for (int e = 0; e < 8; ++e) s += q[d + e] * kk[e]; }
                const float mn = fmaxf(m, s), corr = __builtin_amdgcn_exp2f(m - mn), pe = __builtin_amdgcn_exp2f(s - mn); lsum = lsum * corr + pe; m = mn;
#pragma unroll
                for (int d = 0; d < 64; d += 8) { float vv[8]; ld8(vp + d, vv);
#pragma unroll
                    for (int e = 0; e < 8; ++e) o[d + e] = o[d + e] * corr + pe * vv[e]; } } }
        const float il = 1.0f / lsum; bf16* yp = YC + ((size_t)b * SEQ + t) * D + YO_DIL + h * 64;
#pragma unroll
        for (int d = 0; d < 64; d += 8) { v4u w; w.x = pk2(o[d] * il, o[d + 1] * il); w.y = pk2(o[d + 2] * il, o[d + 3] * il); w.z = pk2(o[d + 4] * il, o[d + 5] * il); w.w = pk2(o[d + 6] * il, o[d + 7] * il); *(v4u*)(yp + d) = w; } }
}
__device__ __forceinline__ void phase_mla_simple(Frame& F) {
    const int gt = F.vcu * NTHREADS + F.tid, NT = F.G * NTHREADS; const bf16* QM = (const bf16*)(F.wsp() + WS_QM); const bf16* KM = (const bf16*)(F.wsp() + WS_KM); const bf16* VM = (const bf16*)(F.wsp() + WS_VM); bf16* YC = (bf16*)(F.wsp() + WS_YCAT);
    for (int ix = gt; ix < NB * 6 * SEQ; ix += NT) { const int t = ix % SEQ, h = (ix / SEQ) % 6, b = ix / (SEQ * 6); const size_t r0 = (size_t)b * SEQ;
        float q[96], o[64];
#pragma unroll
        for (int d = 0; d < 96; d += 8) ld8(QM + (r0 + t) * QLD + h * 96 + d, q + d);
#pragma unroll
        for (int d = 0; d < 64; ++d) o[d] = 0.f;
        float m = -INFINITY, lsum = 0.f;
        for (int j = 0; j <= t; ++j) { const bf16* kp = KM + (r0 + j) * KLD + h * 96; const bf16* vp = VM + (r0 + j) * VLD + h * 64; float s = 0.f;
#pragma unroll
            for (int d = 0; d < 96; d += 8) { float kk[8]; ld8(kp + d, kk);
#pragma unroll
                for (int e = 0; e < 8; ++e) s += q[d + e] * kk[e]; }
            const float mn = fmaxf(m, s), corr = __builtin_amdgcn_exp2f(m - mn), pe = __builtin_amdgcn_exp2f(s - mn); lsum = lsum * corr + pe; m = mn;
#pragma unroll
            for (int d = 0; d < 64; d += 8) { float vv[8]; ld8(vp + d, vv);
#pragma unroll
                for (int e = 0; e < 8; ++e) o[d + e] = o[d + e] * corr + pe * vv[e]; } }
        const float il = 1.0f / lsum; bf16* yp = YC + (r0 + t) * D + YO_MLA + h * 64;
#pragma unroll
        for (int d = 0; d < 64; d += 8) { v4u w; w.x = pk2(o[d] * il, o[d + 1] * il); w.y = pk2(o[d + 2] * il, o[d + 3] * il); w.z = pk2(o[d + 4] * il, o[d + 5] * il); w.w = pk2(o[d + 6] * il, o[d + 7] * il); *(v4u*)(yp + d) = w; } }
}
template <bool MOE_Y>
__device__ __forceinline__ void phase_ln(Frame& F, const float* xin, float* xout, const float* gmod  , const float* lng, const float* lnb,
                                         const float* hm  , int sh_off, int sc_off, const float* wr  , int li) {
    const int gw = F.vcu * NWAVES + F.wave, NGW = F.G * NWAVES, lane = F.lane;
    const bf16* Y = (const bf16*)(F.wsp() + WS_Y); bf16* H = (bf16*)(F.wsp() + WS_H); int* TOPI = (int*)(F.wsp() + WS_TOPI); float* GATE = (float*)(F.wsp() + WS_GATE); const int* TSLOT = (const int*)(F.wsp() + WS_TSLOT);
    volatile LAS unsigned* lcnt = F.MISC + 16;
    if (wr) { if (F.tid < 8) lcnt[F.tid] = 0u; __syncthreads(); }
    f32x4 cg[4], cb[4];
#pragma unroll
    for (int j = 0; j < 4; ++j) { cg[j] = *(const f32x4*)(lng + 4 * lane + 256 * j); cb[j] = *(const f32x4*)(lnb + 4 * lane + 256 * j); }
    f32x4 nx[4]; v2u ny0[4], ny1[4]; float ng0 = 0.f, ng1 = 0.f;
#define LN_LOAD(t_) do { const int t__ = (t_); const bf16 *y0_, *y1_ = nullptr; if (MOE_Y) { ng0 = GATE[t__ * 2]; ng1 = GATE[t__ * 2 + 1]; y0_ = Y + (size_t)TSLOT[t__ * 2] * D; y1_ = Y + (size_t)TSLOT[t__ * 2 + 1] * D; } else y0_ = Y + (size_t)t__ * D; \
        _Pragma("unroll") for (int j = 0; j < 4; ++j) { const int d = 4 * lane + 256 * j; nx[j] = *(const f32x4*)(xin + (size_t)t__ * D + d); ny0[j] = *(const v2u*)(y0_ + d); if (MOE_Y) ny1[j] = *(const v2u*)(y1_ + d); } } while (0)
    int t = gw; if (t < T) LN_LOAD(t);
    for (; t < T; t += NGW) { const int b = t / SEQ; const float* g = gmod + (size_t)b * 6 * D; f32x4 v[4]; float s1 = 0.f, s2 = 0.f;
#pragma unroll
        for (int j = 0; j < 4; ++j) { const int d = 4 * lane + 256 * j; const f32x4 gv = *(const f32x4*)(g + d);
            f32x4 yv = (f32x4){bflo(ny0[j].x), bfhi(ny0[j].x), bflo(ny0[j].y), bfhi(ny0[j].y)};
            if (MOE_Y) yv = yv * ng0 + (f32x4){bflo(ny1[j].x), bfhi(ny1[j].x), bflo(ny1[j].y), bfhi(ny1[j].y)} * ng1;
            v[j] = nx[j] * DN_ALPHA + (1.0f + gv) * yv; s1 += (v[j].x + v[j].y) + (v[j].z + v[j].w); s2 += (v[j].x * v[j].x + v[j].y * v[j].y) + (v[j].z * v[j].z + v[j].w * v[j].w); }
        if (t + NGW < T) LN_LOAD(t + NGW);
#pragma unroll
        for (int o = 1; o < 64; o <<= 1) { s1 += shx(s1, o, lane); s2 += shx(s2, o, lane); }
        const float mean = s1 * (1.f / D); const float rstd = 1.f / sqrtf(fmaxf(s2 * (1.f / D) - mean * mean, 0.f) + LN_EPS);
        float lg[8];
#pragma unroll
        for (int e = 0; e < 8; ++e) lg[e] = 0.f;
#pragma unroll
        for (int j = 0; j < 4; ++j) { const int d = 4 * lane + 256 * j; const f32x4 xn = (v[j] - mean) * rstd * cg[j] + cb[j];
            *(f32x4*)(xout + (size_t)t * D + d) = xn;
            if (hm) { const float* m = hm + (size_t)b * 6 * D; const f32x4 hv = xn * (1.0f + *(const f32x4*)(m + sc_off + d)) + *(const f32x4*)(m + sh_off + d);
                v2u w; w.x = pk2(hv.x, hv.y); w.y = pk2(hv.z, hv.w); *(v2u*)(H + (size_t)t * D + d) = w;
                if (wr) {
#pragma unroll
                    for (int i = 0; i < 4; ++i) { const f32x4 wa = *(const f32x4*)(wr + (size_t)(d + i) * 8), wb = *(const f32x4*)(wr + (size_t)(d + i) * 8 + 4); const float hh = hv[i];
                        lg[0] += hh * wa.x; lg[1] += hh * wa.y; lg[2] += hh * wa.z; lg[3] += hh * wa.w; lg[4] += hh * wb.x; lg[5] += hh * wb.y; lg[6] += hh * wb.z; lg[7] += hh * wb.w; } } } }
        if (wr) {
#pragma unroll
            for (int o = 1; o < 64; o <<= 1) {
#pragma unroll
                for (int e = 0; e < 8; ++e) lg[e] += shx(lg[e], o, lane); }
            if (lane == 0) { int i0 = 0; float v0 = lg[0];
#pragma unroll
                for (int e = 1; e < 8; ++e) if (lg[e] > v0) { v0 = lg[e]; i0 = e; }
                int i1 = 0; float v1 = -INFINITY;
#pragma unroll
                for (int e = 0; e < 8; ++e) if (e != i0 && lg[e] > v1) { v1 = lg[e]; i1 = e; }
                const float ga = 1.0f / (1.0f + __expf(v1 - v0)); TOPI[t * 2] = i0; TOPI[t * 2 + 1] = i1; GATE[t * 2] = ga; GATE[t * 2 + 1] = 1.0f - ga;
                __hip_atomic_fetch_add((LAS unsigned*)(lcnt + i0), 1u, __ATOMIC_RELAXED, __HIP_MEMORY_SCOPE_WORKGROUP); __hip_atomic_fetch_add((LAS unsigned*)(lcnt + i1), 1u, __ATOMIC_RELAXED, __HIP_MEMORY_SCOPE_WORKGROUP); } } }
#undef LN_LOAD
    if (wr) { __syncthreads(); if (F.tid < 8) __hip_atomic_fetch_add(F.ctl + CW_CNT + 64 * li + F.tid, lcnt[F.tid], RLX_AGENT); }
}
__device__ __forceinline__ void phase_moe_assign(Frame& F, int li) {
    const int gw = F.vcu * NWAVES + F.wave, NGW = F.G * NWAVES, lane = F.lane;
    const int* TOPI = (const int*)(F.wsp() + WS_TOPI); int* TSLOT = (int*)(F.wsp() + WS_TSLOT); int* SEG = (int*)(F.wsp() + WS_SEG); const bf16* H = (const bf16*)(F.wsp() + WS_H); bf16* HS = (bf16*)(F.wsp() + WS_Y);
    int seg[9]; { int acc = 0;
#pragma unroll
        for (int e = 0; e < 8; ++e) { seg[e] = acc; const int c = (int)__hip_atomic_load(F.ctl + CW_CNT + 64 * li + e, RLX_AGENT); acc += (c + 255) & ~255; } seg[8] = acc; }
    if (gw == 0 && lane < 9) { int v = seg[0];
#pragma unroll
        for (int k = 1; k < 9; ++k) v = (lane == k) ? seg[k] : v;
        SEG[lane] = v; }
    for (int blk = gw; blk < T / 64; blk += NGW) { const int t = blk * 64 + lane; const int e0 = TOPI[t * 2], e1 = TOPI[t * 2 + 1]; int s0 = 0, s1 = 0;
        const unsigned long long lt = (1ull << lane) - 1ull;
#pragma unroll
        for (int e = 0; e < 8; ++e) { const unsigned long long m0 = __ballot(e0 == e), m1 = __ballot(e1 == e); const int c0 = __popcll(m0), c1 = __popcll(m1);
            int base = 0; if (lane == 0 && (c0 + c1) > 0) base = (int)__hip_atomic_fetch_add(F.ctl + CW_CUR + 64 * li + e, (unsigned)(c0 + c1), RLX_AGENT);
            base = __builtin_amdgcn_readfirstlane(base) + seg[e];
            if (e0 == e) s0 = base + __popcll(m0 & lt); if (e1 == e) s1 = base + c0 + __popcll(m1 & lt); }
        TSLOT[t * 2] = s0; TSLOT[t * 2 + 1] = s1;
        for (int i = 0; i < 64; ++i) { const int sa = __builtin_amdgcn_readlane(s0, i), sb = __builtin_amdgcn_readlane(s1, i); const bf16* src = H + (size_t)(blk * 64 + i) * D;
#pragma unroll
            for (int k = 0; k < 2; ++k) { float hv[8]; ld8(src + k * 512 + lane * 8, hv); v2u w; w.x = pg8::pack4_fp8(hv[0] * 8.f, hv[1] * 8.f, hv[2] * 8.f, hv[3] * 8.f); w.y = pg8::pack4_fp8(hv[4] * 8.f, hv[5] * 8.f, hv[6] * 8.f, hv[7] * 8.f);
                *(v2u*)((unsigned char*)HS + (size_t)sa * D + k * 512 + lane * 8) = w; *(v2u*)((unsigned char*)HS + (size_t)sb * D + k * 512 + lane * 8) = w; } } }
}
typedef float f32x16 __attribute__((ext_vector_type(16)));
typedef short bf16x8v __attribute__((ext_vector_type(8)));
typedef short s16x4 __attribute__((ext_vector_type(4)));
typedef float f32x2v __attribute__((ext_vector_type(2)));
typedef __bf16 bf16x2v __attribute__((ext_vector_type(2)));
#define MFMA32(a, b, c) __builtin_amdgcn_mfma_f32_32x32x16_bf16((a), (b), (c), 0, 0, 0)
__device__ __forceinline__ int crow(int reg, int hh) { return (reg & 3) + 8 * (reg >> 2) + 4 * hh; }
__device__ __forceinline__ unsigned cvtpk(float lo, float hi) { f32x2v v = {lo, hi}; bf16x2v b = __builtin_convertvector(v, bf16x2v); return __builtin_bit_cast(unsigned, b); }
__device__ __forceinline__ bf16x8v pack8(const f32x16& x, int s) { v4u p; p.x = cvtpk(x[8 * s], x[8 * s + 1]); p.y = cvtpk(x[8 * s + 2], x[8 * s + 3]); p.z = cvtpk(x[8 * s + 4], x[8 * s + 5]); p.w = cvtpk(x[8 * s + 6], x[8 * s + 7]); return __builtin_bit_cast(bf16x8v, p); }
__device__ __forceinline__ s16x4 trread(const LAS unsigned char* p) { return __builtin_bit_cast(s16x4, __builtin_amdgcn_ds_read_tr16_b64_v4i16((LAS s16x4*)p)); }
__device__ __forceinline__ bf16x8v vt_frag(const LAS unsigned char* vtile, int VP, int krow0, int dvb, int lane) {
    const int i = lane & 15, q_ = i >> 2, p_ = i & 3, hh = lane >> 5, blk = (lane >> 4) & 1;
    const LAS unsigned char* a = vtile + (krow0 + 4 * hh + q_) * VP + (32 * dvb + 16 * blk + 4 * p_) * 2;
    const s16x4 lo = trread(a), hi = trread(a + 8 * VP);
    return (bf16x8v){lo[0], lo[1], lo[2], lo[3], hi[0], hi[1], hi[2], hi[3]};
}
__device__ __forceinline__ float xhalf_max(float m) { auto rr = __builtin_amdgcn_permlane32_swap(__float_as_uint(m), __float_as_uint(m), false, false); return fmaxf(__uint_as_float(rr[0]), __uint_as_float(rr[1])); }
__device__ __forceinline__ float xhalf_sum(float m) { auto rr = __builtin_amdgcn_permlane32_swap(__float_as_uint(m), __float_as_uint(m), false, false); return __uint_as_float(rr[0]) + __uint_as_float(rr[1]); }
template <int NS>
__device__ __forceinline__ void softmax_pv(f32x16 (&st)[NS], float& m_run, float& l_run, f32x16 (&ot)[2], const LAS unsigned char* vtile, int VP, int krow0, int lane) {
    float mt = st[0][0];
#pragma unroll
    for (int n = 0; n < NS; ++n)
#pragma unroll
        for (int i = 0; i < 16; ++i) mt = fmaxf(mt, st[n][i]);
    mt = xhalf_max(mt);
    if (__any(mt > m_run)) {
        const float m_new = fmaxf(m_run, mt), corr = __builtin_amdgcn_exp2f(m_run - fmaxf(m_new, -1e30f));
        l_run *= corr; m_run = m_new;
#pragma unroll
        for (int d = 0; d < 2; ++d)
#pragma unroll
            for (int i = 0; i < 16; ++i) ot[d][i] *= corr;
    }
    const float m_use = fmaxf(m_run, -1e30f); float ls = 0.f;
#pragma unroll
    for (int n = 0; n < NS; ++n)
#pragma unroll
        for (int i = 0; i < 16; ++i) { st[n][i] = __builtin_amdgcn_exp2f(st[n][i] - m_use); ls += st[n][i]; }
    l_run += ls;
#pragma unroll
    for (int n = 0; n < NS; ++n) { const bf16x8v p0 = pack8(st[n], 0), p1 = pack8(st[n], 1);
#pragma unroll
        for (int d = 0; d < 2; ++d) { ot[d] = MFMA32(vt_frag(vtile, VP, krow0 + 32 * n, d, lane), p0, ot[d]); ot[d] = MFMA32(vt_frag(vtile, VP, krow0 + 32 * n + 16, d, lane), p1, ot[d]); } }
}
__device__ __forceinline__ int queue_pull(Frame& F, gu32* head) {
    __syncthreads();
    if (F.tid == 0) F.MISC[24] = __hip_atomic_fetch_add(head, 1u, RLX_AGENT);
    __syncthreads();
    return (int)F.MISC[24];
}

constexpr int MLA_KP = 208, MLA_VP = 144, MLA_KBYTES = 64 * MLA_KP, MLA_VBYTES = 64 * MLA_VP, MLA_VOFF = 2 * MLA_KBYTES;
__device__ __forceinline__ void mla_unit(Frame& F, int b, int h, int qb) {
    const int lane = F.lane, w = F.wave, tid = F.tid, r = lane & 31, hh = lane >> 5;
    const bf16* QM = (const bf16*)(F.wsp() + WS_QM); const bf16* KM = (const bf16*)(F.wsp() + WS_KM); const bf16* VM = (const bf16*)(F.wsp() + WS_VM); bf16* YC = (bf16*)(F.wsp() + WS_YCAT);
    LAS unsigned char* lds = F.lds + RING_OFF;
    const size_t row0 = (size_t)b * SEQ;
    const int qpos = qb * 256 + 32 * w + r;
    const int qmax_w = qb * 256 + 32 * w + 31, qmin_w = qb * 256 + 32 * w;
    bf16x8v qf[6];
#pragma unroll
    for (int s = 0; s < 6; ++s) qf[s] = *(const bf16x8v*)(QM + (row0 + qpos) * QLD + h * 96 + 16 * s + 8 * hh);
    const int kc0 = tid, kc1 = 512 + tid; const bool k1 = tid < 256;
    const int kr0 = kc0 / 12, kch0 = kc0 % 12, kr1 = kc1 / 12, kch1 = kc1 % 12, vr = tid >> 3, vch = tid & 7;
    const bf16* ksrc0 = KM + (row0 + kr0) * KLD + h * 96 + kch0 * 8; const bf16* ksrc1 = KM + (row0 + kr1) * KLD + h * 96 + kch1 * 8; const bf16* vsrc = VM + (row0 + vr) * VLD + h * 64 + vch * 8;
    const int kdst0 = kr0 * MLA_KP + kch0 * 16, kdst1 = kr1 * MLA_KP + kch1 * 16, vdst = MLA_VOFF + vr * MLA_VP + vch * 16;
    const int NT = (qb + 1) * 4;
    v4u kreg0, kreg1 = (v4u){0u, 0u, 0u, 0u}, vreg;
    kreg0 = *(const v4u*)ksrc0; if (k1) kreg1 = *(const v4u*)ksrc1; vreg = *(const v4u*)vsrc;
    __syncthreads();
    *(LAS v4u*)(lds + kdst0) = kreg0; if (k1) *(LAS v4u*)(lds + kdst1) = kreg1; *(LAS v4u*)(lds + vdst) = vreg;
    __syncthreads();
    float m_run = -INFINITY, l_run = 0.f; f32x16 ot[2];
#pragma unroll
    for (int i = 0; i < 16; ++i) { ot[0][i] = 0.f; ot[1][i] = 0.f; }
    for (int t = 0; t < NT; ++t) {
        const int buf = t & 1;
        if (t + 1 < NT) { const size_t o = (size_t)(t + 1) * 64; kreg0 = *(const v4u*)(ksrc0 + o * KLD); if (k1) kreg1 = *(const v4u*)(ksrc1 + o * KLD); vreg = *(const v4u*)(vsrc + o * VLD); }
        const LAS unsigned char* kt = lds + buf * MLA_KBYTES; const LAS unsigned char* vt = lds + MLA_VOFF + buf * MLA_VBYTES;
        const int kb = 64 * t;
        if (kb <= qmax_w) {
            if (kb + 32 <= qmax_w) {
                f32x16 st[2];
#pragma unroll
                for (int i = 0; i < 16; ++i) { st[0][i] = 0.f; st[1][i] = 0.f; }
#pragma unroll
                for (int s = 0; s < 6; ++s) { const bf16x8v kf0 = *(const LAS bf16x8v*)(kt + r * MLA_KP + (16 * s + 8 * hh) * 2), kf1 = *(const LAS bf16x8v*)(kt + (32 + r) * MLA_KP + (16 * s + 8 * hh) * 2);
                    st[0] = MFMA32(kf0, qf[s], st[0]); st[1] = MFMA32(kf1, qf[s], st[1]); }
                if (kb + 63 > qmin_w) {
#pragma unroll
                    for (int i = 0; i < 16; ++i) { if (kb + crow(i, hh) > qpos) st[0][i] = -INFINITY; if (kb + 32 + crow(i, hh) > qpos) st[1][i] = -INFINITY; } }
                softmax_pv<2>(st, m_run, l_run, ot, vt, MLA_VP, 0, lane);
            } else {
                f32x16 st[1];
#pragma unroll
                for (int i = 0; i < 16; ++i) st[0][i] = 0.f;
#pragma unroll
                for (int s = 0; s < 6; ++s) { const bf16x8v kf0 = *(const LAS bf16x8v*)(kt + r * MLA_KP + (16 * s + 8 * hh) * 2); st[0] = MFMA32(kf0, qf[s], st[0]); }
#pragma unroll
                for (int i = 0; i < 16; ++i) if (kb + crow(i, hh) > qpos) st[0][i] = -INFINITY;
                softmax_pv<1>(st, m_run, l_run, ot, vt, MLA_VP, 0, lane);
            } }
        if (t + 1 < NT) { const int nb = buf ^ 1; *(LAS v4u*)(lds + nb * MLA_KBYTES + kdst0) = kreg0; if (k1) *(LAS v4u*)(lds + nb * MLA_KBYTES + kdst1) = kreg1; *(LAS v4u*)(lds + nb * MLA_VBYTES + vdst) = vreg; }
        __syncthreads();
    }
    const float inv = 1.0f / xhalf_sum(l_run);
    bf16* yp = YC + (row0 + qpos) * D + YO_MLA + h * 64;
#pragma unroll
    for (int d = 0; d < 2; ++d)
#pragma unroll
        for (int g4 = 0; g4 < 4; ++g4) { v2u wv; wv.x = cvtpk(ot[d][4 * g4] * inv, ot[d][4 * g4 + 1] * inv); wv.y = cvtpk(ot[d][4 * g4 + 2] * inv, ot[d][4 * g4 + 3] * inv);
            *(v2u*)(yp + 32 * d + 8 * g4 + 4 * hh) = wv; }
}
constexpr int M3_KBYTES = 12288, M3_VBYTES = 8192, M3_VOFF = 2 * M3_KBYTES;
__device__ __forceinline__ bf16x8v vt_frag3(const LAS unsigned char* vtile, int krow0, int dvb, int lane) {
    const int i = lane & 15, q_ = i >> 2, p_ = i & 3, hh = lane >> 5, blk = (lane >> 4) & 1;
    const LAS unsigned char* a = vtile + ((dvb * 4 + (krow0 >> 4)) << 10) + (4 * hh + q_) * 64 + (16 * blk + 4 * p_) * 2;
    const s16x4 lo = trread(a), hi = trread(a + 512);
    return (bf16x8v){lo[0], lo[1], lo[2], lo[3], hi[0], hi[1], hi[2], hi[3]};
}
__device__ __forceinline__ void mla_unit2(Frame& F, int b, int h, int qb) {
    const int lane = F.lane, w = F.wave, r = lane & 31, hh = lane >> 5;
    const bf16* QM = (const bf16*)(F.wsp() + WS_QM); const bf16* KM = (const bf16*)(F.wsp() + WS_KM); const bf16* VM = (const bf16*)(F.wsp() + WS_VM); bf16* YC = (bf16*)(F.wsp() + WS_YCAT);
    LAS unsigned char* lds = F.lds + RING_OFF;
    const size_t row0 = (size_t)b * SEQ;
    const int qbase = qb * 512 + 64 * w;
    const int qposA = qbase + r, qposB = qbase + 32 + r;
    bf16x8v qf[2][6];
#pragma unroll
    for (int s = 0; s < 6; ++s) { qf[0][s] = *(const bf16x8v*)(QM + (row0 + qposA) * QLD + h * 96 + 16 * s + 8 * hh); qf[1][s] = *(const bf16x8v*)(QM + (row0 + qposB) * QLD + h * 96 + 16 * s + 8 * hh); }
    const int li = lane >> 2, lc = lane & 3; const bool isK = w < 4; const int p0 = 2 * (w & 3);
    const bf16* dbase = isK ? KM + row0 * KLD + h * 96 : VM + row0 * VLD + h * 64;
    const int doff = isK ? (16 * w + li) * KLD + ((lc ^ ((li >> 2) & 3)) << 3) : (16 * (p0 & 3) + li) * VLD + 32 * (p0 >> 2) + 8 * lc;
    const int dsrc_j = isK ? 32 : 16 * VLD, dstep = isK ? 64 * KLD : 64 * VLD, ddst = isK ? 3 * w * 1024 : M3_VOFF + p0 * 1024, dbuf = isK ? M3_KBYTES : M3_VBYTES;
#define M3_DMA(t_, buf_) do { const bf16* s_ = dbase + (doff + (t_) * dstep); const int d_ = ddst + (buf_) * dbuf; \
        __builtin_amdgcn_global_load_lds((const unsigned*)s_, (LAS unsigned*)(lds + d_), 16, 0, 0); __builtin_amdgcn_global_load_lds((const unsigned*)(s_ + dsrc_j), (LAS unsigned*)(lds + d_ + 1024), 16, 0, 0); \
        if (isK) __builtin_amdgcn_global_load_lds((const unsigned*)(s_ + 2 * dsrc_j), (LAS unsigned*)(lds + d_ + 2048), 16, 0, 0); } while (0)
    const int NT = (qb + 1) * 8;
    __syncthreads();
    M3_DMA(0, 0);
    asm volatile("s_waitcnt vmcnt(0)" ::: "memory"); __syncthreads();
    const int kl = r & 15, kx = (kl >> 2) & 3, kbase = ((r >> 4) * 3) * 1024 + kl * 64;
    float m_run[2] = {-INFINITY, -INFINITY}, l_run[2] = {0.f, 0.f}; f32x16 ot[2][2];
#pragma unroll
    for (int i = 0; i < 16; ++i) { ot[0][0][i] = 0.f; ot[0][1][i] = 0.f; ot[1][0][i] = 0.f; ot[1][1][i] = 0.f; }
    for (int t = 0; t < NT; ++t) {
        const int buf = t & 1;
        if (t + 1 < NT) M3_DMA(t + 1, buf ^ 1);
        const LAS unsigned char* kt = lds + buf * M3_KBYTES; const LAS unsigned char* vt = lds + M3_VOFF + buf * M3_VBYTES;
        const int kb = 64 * t;
#pragma unroll
        for (int n = 0; n < 2; ++n) { const int kbn = kb + 32 * n;
            if (kbn <= qbase + 63) {
                f32x16 sa, sb;
#pragma unroll
                for (int i = 0; i < 16; ++i) { sa[i] = 0.f; sb[i] = 0.f; }
#pragma unroll
                for (int s = 0; s < 6; ++s) { const int c = 2 * s + hh; const bf16x8v kf = *(const LAS bf16x8v*)(kt + n * 6144 + kbase + (c >> 2) * 1024 + (((c & 3) ^ kx) << 4)); sa = MFMA32(kf, qf[0][s], sa); sb = MFMA32(kf, qf[1][s], sb); }
                if (kbn + 31 > qbase) {
#pragma unroll
                    for (int i = 0; i < 16; ++i) { const int k0 = kbn + crow(i, hh); if (k0 > qposA) sa[i] = -INFINITY; if (k0 > qposB) sb[i] = -INFINITY; } }
                float mtA = sa[0], mtB = sb[0];
#pragma unroll
                for (int i = 1; i < 16; ++i) { mtA = fmaxf(mtA, sa[i]); mtB = fmaxf(mtB, sb[i]); }
                mtA = xhalf_max(mtA); mtB = xhalf_max(mtB);
                if (__any(mtA > m_run[0] || mtB > m_run[1])) {
                    const float nA = fmaxf(m_run[0], mtA), nB = fmaxf(m_run[1], mtB), cA = __builtin_amdgcn_exp2f(m_run[0] - fmaxf(nA, -1e30f)), cB = __builtin_amdgcn_exp2f(m_run[1] - fmaxf(nB, -1e30f));
                    l_run[0] *= cA; l_run[1] *= cB; m_run[0] = nA; m_run[1] = nB;
#pragma unroll
                    for (int d = 0; d < 2; ++d)
#pragma unroll
                        for (int i = 0; i < 16; ++i) { ot[0][d][i] *= cA; ot[1][d][i] *= cB; } }
                const float muA = fmaxf(m_run[0], -1e30f), muB = fmaxf(m_run[1], -1e30f); float lsA = 0.f, lsB = 0.f;
#pragma unroll
                for (int i = 0; i < 16; ++i) { sa[i] = __builtin_amdgcn_exp2f(sa[i] - muA); lsA += sa[i]; sb[i] = __builtin_amdgcn_exp2f(sb[i] - muB); lsB += sb[i]; }
                l_run[0] += lsA; l_run[1] += lsB;
                const bf16x8v pa0 = pack8(sa, 0), pa1 = pack8(sa, 1), pb0 = pack8(sb, 0), pb1 = pack8(sb, 1);
#pragma unroll
                for (int d = 0; d < 2; ++d) { const bf16x8v v0 = vt_frag3(vt, 32 * n, d, lane), v1 = vt_frag3(vt, 32 * n + 16, d, lane);
                    ot[0][d] = MFMA32(v0, pa0, ot[0][d]); ot[1][d] = MFMA32(v0, pb0, ot[1][d]); ot[0][d] = MFMA32(v1, pa1, ot[0][d]); ot[1][d] = MFMA32(v1, pb1, ot[1][d]); }
            } }
        asm volatile("s_waitcnt vmcnt(0)" ::: "memory"); __syncthreads();
    }
#undef M3_DMA
#pragma unroll
    for (int qi = 0; qi < 2; ++qi) { const float inv = 1.0f / xhalf_sum(l_run[qi]); bf16* yp = YC + (row0 + qbase + 32 * qi + r) * D + YO_MLA + h * 64;
#pragma unroll
        for (int d = 0; d < 2; ++d)
#pragma unroll
            for (int g4 = 0; g4 < 4; ++g4) { v2u wv; wv.x = cvtpk(ot[qi][d][4 * g4] * inv, ot[qi][d][4 * g4 + 1] * inv); wv.y = cvtpk(ot[qi][d][4 * g4 + 2] * inv, ot[qi][d][4 * g4 + 3] * inv);
                *(v2u*)(yp + 32 * d + 8 * g4 + 4 * hh) = wv; } }
}
__device__ __forceinline__ void phase_mla_mfma(Frame& F, int l, int rep) {
    gu32* head = F.ctl + CW_Q + 64 * (4 * l + rep);
    for (;;) { const int idx = queue_pull(F, head); if (idx >= 48 * 8) break; const int qb = 7 - idx / 48, bh = idx % 48; mla_unit2(F, bh / 6, bh % 6, qb); }
}
constexpr int DIL_P = 144, DIL_VOFF = 384 * DIL_P;
__device__ __forceinline__ void dil_unit(Frame& F, int b, int h, int p, int rho, int u) {
    const int lane = F.lane, w = F.wave, tid = F.tid, r = lane & 31, hh = lane >> 5;
    const int rs = (p == 0) ? 1 : (p == 1) ? 4 : 16;
    const bf16* Z = (const bf16*)(F.wsp() + WS_Z); bf16* DO = (bf16*)(F.wsp() + WS_DILO) + (size_t)p * T * 384; float* DL = (float*)(F.wsp() + WS_DILL) + (size_t)p * T * 6;
    LAS unsigned char* lds = F.lds + RING_OFF;
    const size_t row0 = (size_t)b * SEQ;
    const int m0 = 256 * u - 128;
    __syncthreads();
#pragma unroll
    for (int i = 0; i < 6; ++i) { const int c = tid + 512 * i, kk = c >> 3, ch = c & 7, mm = m0 + kk; v4u kv = (v4u){0u, 0u, 0u, 0u}, vv = (v4u){0u, 0u, 0u, 0u};
        if (mm >= 0) { const bf16* src = Z + (row0 + (size_t)mm * rs + rho) * ZLD + h * 64 + ch * 8; kv = *(const v4u*)(src + ZO_DK); vv = *(const v4u*)(src + ZO_DV); }
        *(LAS v4u*)(lds + kk * DIL_P + ch * 16) = kv; *(LAS v4u*)(lds + DIL_VOFF + kk * DIL_P + ch * 16) = vv; }
    const int mq = 256 * u + 32 * w + r; const size_t rowq = row0 + (size_t)mq * rs + rho;
    bf16x8v qf[4];
#pragma unroll
    for (int s = 0; s < 4; ++s) qf[s] = *(const bf16x8v*)(Z + rowq * ZLD + ZO_DQ + h * 64 + 16 * s + 8 * hh);
    __syncthreads();
    float m_run = -INFINITY, l_run = 0.f; f32x16 ot[2];
#pragma unroll
    for (int i = 0; i < 16; ++i) { ot[0][i] = 0.f; ot[1][i] = 0.f; }
#define DIL_QK(ST, KT) do { _Pragma("unroll") for (int i = 0; i < 16; ++i) ST[i] = 0.f; \
        _Pragma("unroll") for (int s = 0; s < 4; ++s) { const bf16x8v kf = *(const LAS bf16x8v*)(lds + (32 * (KT) + r) * DIL_P + (16 * s + 8 * hh) * 2); ST = MFMA32(kf, qf[s], ST); } \
        _Pragma("unroll") for (int i = 0; i < 16; ++i) { const int mk = m0 + 32 * (KT) + crow(i, hh); if (mk < 0 || mk > mq || mk < mq - 128) ST[i] = -INFINITY; } } while (0)
    if (m0 + 32 * w + 31 >= 0) { f32x16 st[2]; DIL_QK(st[0], w); DIL_QK(st[1], w + 1); softmax_pv<2>(st, m_run, l_run, ot, lds + DIL_VOFF, DIL_P, 32 * w, lane); }
    else if (m0 + 32 * (w + 1) + 31 >= 0) { f32x16 st[1]; DIL_QK(st[0], w + 1); softmax_pv<1>(st, m_run, l_run, ot, lds + DIL_VOFF, DIL_P, 32 * (w + 1), lane); }
    if (m0 + 32 * (w + 2) + 31 >= 0) { f32x16 st[2]; DIL_QK(st[0], w + 2); DIL_QK(st[1], w + 3); softmax_pv<2>(st, m_run, l_run, ot, lds + DIL_VOFF, DIL_P, 32 * (w + 2), lane); }
    else if (m0 + 32 * (w + 3) + 31 >= 0) { f32x16 st[1]; DIL_QK(st[0], w + 3); softmax_pv<1>(st, m_run, l_run, ot, lds + DIL_VOFF, DIL_P, 32 * (w + 3), lane); }
    { f32x16 st[1]; DIL_QK(st[0], w + 4); softmax_pv<1>(st, m_run, l_run, ot, lds + DIL_VOFF, DIL_P, 32 * (w + 4), lane); }
#undef DIL_QK
    const float lt = xhalf_sum(l_run), inv = 1.0f / lt;
    bf16* op = DO + rowq * 384 + h * 64;
#pragma unroll
    for (int d = 0; d < 2; ++d)
#pragma unroll
        for (int g4 = 0; g4 < 4; ++g4) { v2u wv; wv.x = cvtpk(ot[d][4 * g4] * inv, ot[d][4 * g4 + 1] * inv); wv.y = cvtpk(ot[d][4 * g4 + 2] * inv, ot[d][4 * g4 + 3] * inv);
            *(v2u*)(op + 32 * d + 8 * g4 + 4 * hh) = wv; }
    if (hh == 0) DL[rowq * 6 + h] = m_run + __builtin_amdgcn_logf(lt);
}
__device__ __forceinline__ void phase_dil_mfma(Frame& F) {
    for (int idx = (int)blockIdx.x; idx < 48 * 48; idx += F.G) { const int bh = idx / 48, wi = idx % 48; int p, rho, u;
        if (wi < 16) { p = 0; rho = 0; u = wi; } else if (wi < 32) { p = 1; rho = (wi - 16) >> 2; u = (wi - 16) & 3; } else { p = 2; rho = wi - 32; u = 0; }
        dil_unit(F, bh / 6, bh % 6, p, rho, u); }
}
__device__ __forceinline__ void phase_dil_merge(Frame& F) {
    const int gt = F.vcu * NTHREADS + F.tid, NT = F.G * NTHREADS;
    const bf16* DO = (const bf16*)(F.wsp() + WS_DILO); const float* DL = (const float*)(F.wsp() + WS_DILL); bf16* YC = (bf16*)(F.wsp() + WS_YCAT);
    for (int ix = gt; ix < T * 48; ix += NT) { const int t = ix / 48, c = ix % 48, h = c >> 3;
        const float l0 = DL[(size_t)t * 6 + h], l1 = DL[(size_t)T * 6 + (size_t)t * 6 + h], l2 = DL[(size_t)2 * T * 6 + (size_t)t * 6 + h];
        const float mx = fmaxf(l0, fmaxf(l1, l2)); float w0 = __builtin_amdgcn_exp2f(l0 - mx), w1 = __builtin_amdgcn_exp2f(l1 - mx), w2 = __builtin_amdgcn_exp2f(l2 - mx); const float inv = 1.0f / (w0 + w1 + w2); w0 *= inv; w1 *= inv; w2 *= inv;
        float a[8], bb[8], cc[8]; ld8(DO + (size_t)t * 384 + c * 8, a); ld8(DO + (size_t)T * 384 + (size_t)t * 384 + c * 8, bb); ld8(DO + (size_t)2 * T * 384 + (size_t)t * 384 + c * 8, cc);
        v4u o; o.x = pk2(w0 * a[0] + w1 * bb[0] + w2 * cc[0], w0 * a[1] + w1 * bb[1] + w2 * cc[1]); o.y = pk2(w0 * a[2] + w1 * bb[2] + w2 * cc[2], w0 * a[3] + w1 * bb[3] + w2 * cc[3]);
        o.z = pk2(w0 * a[4] + w1 * bb[4] + w2 * cc[4], w0 * a[5] + w1 * bb[5] + w2 * cc[5]); o.w = pk2(w0 * a[6] + w1 * bb[6] + w2 * cc[6], w0 * a[7] + w1 * bb[7] + w2 * cc[7]);
        *(v4u*)(YC + (size_t)t * D + YO_DIL + c * 8) = o; }
}

__device__ __forceinline__ bf16x8v tr_frag_nat(const LAS unsigned char* tile, int P, int krow0, int colblk, int lane) {
    const int i = lane & 15, q_ = i >> 2, p_ = i & 3, hh = lane >> 5, blk = (lane >> 4) & 1;
    const LAS unsigned char* a = tile + (krow0 + 8 * hh + q_) * P + (32 * colblk + 16 * blk + 4 * p_) * 2;
    const s16x4 lo = trread(a), hi = trread(a + 4 * P);
    return (bf16x8v){lo[0], lo[1], lo[2], lo[3], hi[0], hi[1], hi[2], hi[3]};
}
__device__ __forceinline__ float ret_lg2(int h) { return __builtin_amdgcn_logf(1.0f - __builtin_amdgcn_exp2f(-5.0f - (float)h)); }
constexpr int RET_P = 144, RET_VOFF = 256 * RET_P, RET_SOFF = 2 * 256 * RET_P, RET_SBYTES = 64 * RET_P;
__device__ __forceinline__ void ret_state_unit(Frame& F, int b, int h, int cp) {
    const int lane = F.lane, w = F.wave, tid = F.tid, r = lane & 31, hh = lane >> 5;
    const bf16* Z = (const bf16*)(F.wsp() + WS_Z); float* KVS = (float*)(F.wsp() + WS_KVS);
    LAS unsigned char* lds = F.lds + RING_OFF; const size_t row0 = (size_t)b * SEQ + 256 * cp; const float lg2 = ret_lg2(h);
    __syncthreads();
#pragma unroll
    for (int i = 0; i < 4; ++i) { const int c = tid + 512 * i, kk = c >> 3, ch = c & 7; const bf16* src = Z + (row0 + kk) * ZLD + h * 64 + ch * 8;
        float kf[8]; ld8(src + ZO_RK, kf); const float sc = 0.125f * __builtin_amdgcn_exp2f((float)(127 - (kk & 127)) * lg2);
        v4u kv; kv.x = cvtpk(kf[0] * sc, kf[1] * sc); kv.y = cvtpk(kf[2] * sc, kf[3] * sc); kv.z = cvtpk(kf[4] * sc, kf[5] * sc); kv.w = cvtpk(kf[6] * sc, kf[7] * sc);
        *(LAS v4u*)(lds + kk * RET_P + ch * 16) = kv; *(LAS v4u*)(lds + RET_VOFF + kk * RET_P + ch * 16) = *(const v4u*)(src + ZO_RV); }
    __syncthreads();
    const int ci = w >> 2, dvb = (w >> 1) & 1, dkb = w & 1;
    f32x16 acc;
#pragma unroll
    for (int i = 0; i < 16; ++i) acc[i] = 0.f;
#pragma unroll
    for (int ks = 0; ks < 8; ++ks) { const int k0 = 128 * ci + 16 * ks; acc = MFMA32(tr_frag_nat(lds + RET_VOFF, RET_P, k0, dvb, lane), tr_frag_nat(lds, RET_P, k0, dkb, lane), acc); }
    float* dst = KVS + ((size_t)((b * 4 + h) * 32 + 2 * cp + ci)) * 4096;
#pragma unroll
    for (int i = 0; i < 16; ++i) dst[(32 * dvb + crow(i, hh)) * 64 + 32 * dkb + r] = acc[i];
}
__device__ __forceinline__ void phase_ret_state(Frame& F) {
    for (int idx = (int)blockIdx.x; idx < 32 * 16; idx += F.G) { const int bh = idx >> 4, cp = idx & 15; ret_state_unit(F, bh >> 2, bh & 3, cp); }
}
__device__ __forceinline__ void ret_out_unit(Frame& F, int l, int b, int h, int cp) {
    const int lane = F.lane, w = F.wave, tid = F.tid, r = lane & 31, hh = lane >> 5;
    const bf16* Z = (const bf16*)(F.wsp() + WS_Z); const float* KVS = (const float*)(F.wsp() + WS_KVS); bf16* YC = (bf16*)(F.wsp() + WS_YCAT); const float* gn = F.in(4) + l * 256 + h * 64;
    LAS unsigned char* lds = F.lds + RING_OFF; const size_t row0 = (size_t)b * SEQ + 256 * cp; const float lg2 = ret_lg2(h);
    const int ci = w >> 2, wi = w & 3, c = 2 * cp + ci;
    __syncthreads();
#pragma unroll
    for (int i = 0; i < 4; ++i) { const int cc = tid + 512 * i, kk = cc >> 3, ch = cc & 7; const bf16* src = Z + (row0 + kk) * ZLD + h * 64 + ch * 8;
        *(LAS v4u*)(lds + kk * RET_P + ch * 16) = *(const v4u*)(src + ZO_RK); *(LAS v4u*)(lds + RET_VOFF + kk * RET_P + ch * 16) = *(const v4u*)(src + ZO_RV); }
    {
        const int tl = tid & 255; const float dec = __builtin_amdgcn_exp2f(128.0f * lg2); const float* base = KVS + (size_t)((b * 4 + h) * 32) * 4096 + tl * 4;
        f32x4 a[4];
#pragma unroll
        for (int k = 0; k < 4; ++k) a[k] = (f32x4){0.f, 0.f, 0.f, 0.f};
        for (int m = 0; m < c; ++m) {
#pragma unroll
            for (int k = 0; k < 4; ++k) a[k] = a[k] * dec + *(const f32x4*)(base + (size_t)m * 4096 + 1024 * k); }
#pragma unroll
        for (int k = 0; k < 4; ++k) { const int e = tl * 4 + 1024 * k, dv = e >> 6, dk = e & 63; v2u wv; wv.x = cvtpk(a[k].x, a[k].y); wv.y = cvtpk(a[k].z, a[k].w);
            *(LAS v2u*)(lds + RET_SOFF + ci * RET_SBYTES + dv * RET_P + dk * 2) = wv; }
    }
    const int iq = 32 * wi + r; const size_t rowq = row0 + 128 * ci + iq;
    bf16x8v qf[4];
#pragma unroll
    for (int s = 0; s < 4; ++s) qf[s] = *(const bf16x8v*)(Z + rowq * ZLD + ZO_RQ + h * 64 + 16 * s + 8 * hh);
    __syncthreads();
    f32x16 ot[2], oc[2];
#pragma unroll
    for (int i = 0; i < 16; ++i) { ot[0][i] = 0.f; ot[1][i] = 0.f; oc[0][i] = 0.f; oc[1][i] = 0.f; }
    for (int kt = 0; kt <= wi; ++kt) { const int krow = 128 * ci + 32 * kt;
        f32x16 st;
#pragma unroll
        for (int i = 0; i < 16; ++i) st[i] = 0.f;
#pragma unroll
        for (int s = 0; s < 4; ++s) { const bf16x8v kf = *(const LAS bf16x8v*)(lds + (krow + r) * RET_P + (16 * s + 8 * hh) * 2); st = MFMA32(kf, qf[s], st); }
#pragma unroll
        for (int i = 0; i < 16; ++i) { const int dj = iq - (32 * kt + crow(i, hh)); st[i] = (dj >= 0) ? st[i] * 0.125f * __builtin_amdgcn_exp2f((float)dj * lg2) : 0.f; }
        const bf16x8v p0 = pack8(st, 0), p1 = pack8(st, 1);
#pragma unroll
        for (int d = 0; d < 2; ++d) { ot[d] = MFMA32(vt_frag(lds + RET_VOFF, RET_P, krow, d, lane), p0, ot[d]); ot[d] = MFMA32(vt_frag(lds + RET_VOFF, RET_P, krow + 16, d, lane), p1, ot[d]); }
    }
    const LAS unsigned char* sT = lds + RET_SOFF + ci * RET_SBYTES;
#pragma unroll
    for (int d = 0; d < 2; ++d)
#pragma unroll
        for (int s = 0; s < 4; ++s) { const bf16x8v sf = *(const LAS bf16x8v*)(sT + (32 * d + r) * RET_P + (16 * s + 8 * hh) * 2); oc[d] = MFMA32(sf, qf[s], oc[d]); }
    const float xi = __builtin_amdgcn_exp2f((float)(iq + 1) * lg2);
    float sum = 0.f;
#pragma unroll
    for (int d = 0; d < 2; ++d)
#pragma unroll
        for (int i = 0; i < 16; ++i) { ot[d][i] += oc[d][i] * xi; sum += ot[d][i]; }
    const float mu = xhalf_sum(sum) * (1.0f / 64.0f); float sq = 0.f;
#pragma unroll
    for (int d = 0; d < 2; ++d)
#pragma unroll
        for (int i = 0; i < 16; ++i) { const float dd = ot[d][i] - mu; sq += dd * dd; }
    const float rstd = 1.0f / sqrtf(xhalf_sum(sq) * (1.0f / 64.0f) + LN_EPS);
    const bf16* gp = Z + rowq * ZLD + ZO_RG + h * 64; bf16* yp = YC + rowq * D + YO_RET + h * 64;
#pragma unroll
    for (int d = 0; d < 2; ++d)
#pragma unroll
        for (int g4 = 0; g4 < 4; ++g4) { const int dv = 32 * d + 8 * g4 + 4 * hh; const v2u gw = *(const v2u*)(gp + dv); const f32x4 gg = *(const f32x4*)(gn + dv);
            const float o0 = fsilu(bflo(gw.x)) * ((ot[d][4 * g4] - mu) * rstd * gg.x), o1 = fsilu(bfhi(gw.x)) * ((ot[d][4 * g4 + 1] - mu) * rstd * gg.y), o2 = fsilu(bflo(gw.y)) * ((ot[d][4 * g4 + 2] - mu) * rstd * gg.z), o3 = fsilu(bfhi(gw.y)) * ((ot[d][4 * g4 + 3] - mu) * rstd * gg.w);
            v2u wv; wv.x = cvtpk(o0, o1); wv.y = cvtpk(o2, o3); *(v2u*)(yp + dv) = wv; }
}
__device__ __forceinline__ void phase_ret_out(Frame& F, int l) {
    for (int idx = (int)blockIdx.x; idx < 32 * 16; idx += F.G) { const int bh = idx >> 4, cp = idx & 15; ret_out_unit(F, l, bh >> 2, bh & 3, cp); }
}
#ifndef MK_PER_PHASE
#define MK_PER_PHASE 0
#endif
constexpr int NPHASES = 43;
#ifndef PROBE
#define PROBE 0
#endif
#define REP(k) for (int rep_ = 0; rep_ < ((PROBE == (k)) ? 2 : 1); ++rep_)
struct Args { const float* in[23]; float* out; unsigned char* ws; int ph_lo, ph_hi; };
static_assert(sizeof(Args) == 23 * 8 + 8 + 8 + 8, "no padding");

__global__ void __launch_bounds__(NTHREADS, 2) mk_fwd(Args args) {
    extern __shared__ __attribute__((aligned(16))) unsigned char lds[];
    Frame F;
    F.lds = (LAS unsigned char*)lds; F.MISC = (volatile LAS unsigned*)(F.lds + MISC_OFF);
    F.tid = threadIdx.x; F.lane = F.tid & 63; F.wave = __builtin_amdgcn_readfirstlane(F.tid >> 6); F.wave_s = F.wave;
    F.G = gridDim.x; { const int bx = blockIdx.x; F.vcu = (F.G % 8 == 0) ? (bx % 8) * (F.G / 8) + bx / 8 : bx; }
    F.ctl = (gu32*)(args.ws + WS_CTL);
    for (int u = F.tid; u < (LDS_BYTES - LDSCTL_OFF) / 4; u += NTHREADS) ((LAS unsigned*)(F.lds + LDSCTL_OFF))[u] = 0u;
    __syncthreads();
    if (F.tid == 0) { LAS unsigned long long* pt = (LAS unsigned long long*)(F.lds + PTAB_OFF);
#pragma unroll
        for (int i = 0; i < 23; ++i) pt[i] = (unsigned long long)args.in[i];
        pt[23] = (unsigned long long)args.out; pt[24] = (unsigned long long)args.ws; }
    __syncthreads();
    XcdBarrier bar = xcd_barrier_post((unsigned*)(F.ctl + CW_BAR), F.MISC + 8);
    int pc = 0;
#define PH_ON() (args.ph_lo <= pc && pc < args.ph_hi && (F.refresh(), true))
#define PH_END() do { if (args.ph_lo <= pc && pc + 1 < args.ph_hi) xcd_barrier(bar); ++pc; } while (0)
#define WSB(T_, off) ((T_*)(F.wsp() + (off)))
    if (PH_ON()) { phase_mod_tab(F); phase_convert(F, 0); } PH_END();
    if (PH_ON()) { phase_modulate0(F); } PH_END();
    if (PROBE == 20) { for (int i = 0; i < 40; ++i) xcd_barrier(bar); }
    for (int l = 0; l < NL; ++l) {
        const bool moe = (l & 1) != 0; const int li = l >> 1;
        if (l > 0) { if (PH_ON()) REP(13) { phase_convert(F, l); } PH_END(); }
        if (PH_ON()) REP(1) { pg8::Gemm g{WSB(bf16, WS_H), WSB(bf16, WS_WIN), D, D, D, 0, 0}; pg8::StaticOrder S; S.init(T, ZLD, F.G, (int)blockIdx.x); pg8::EpiBf16 E{WSB(bf16, WS_Z), ZLD, D_IN};
            pg8::gemm_phase<pg8::EpiBf16, pg8::StaticOrder, true>(F.lds + RING_OFF, g, S, E, F.tid); } PH_END();
        if (PH_ON()) REP(14) { phase_rope_stats(F); } PH_END();
        if (PH_ON()) {
            REP(2) { pg8::Gemm g{WSB(bf16, WS_Z) + ZO_CQ, WSB(bf16, WS_WUQ), ZLD, QRANK, QRANK, 0, 0}; pg8::StaticOrder S; S.init(T, 768, F.G, (int)blockIdx.x); pg8::EpiMlaQ E{WSB(bf16, WS_QM), WSB(const float, WS_RS), WSB(const float, WS_TAB), MLA_QSCALE, 0};
              pg8::gemm_phase<pg8::EpiMlaQ, pg8::StaticOrder, true>(F.lds + RING_OFF, g, S, E, F.tid); }
            REP(2) { pg8::Gemm g{WSB(bf16, WS_Z) + ZO_CKV, WSB(bf16, WS_WUKV), ZLD, KVRANK, KVRANK, 0, 0}; pg8::StaticOrder S; S.init(T, 768, F.G, (int)blockIdx.x); pg8::EpiMlaKV E{WSB(bf16, WS_KM), WSB(bf16, WS_VM), WSB(const float, WS_RS)};
              pg8::gemm_phase<pg8::EpiMlaKV, pg8::StaticOrder, true>(F.lds + RING_OFF, g, S, E, F.tid); }
            REP(3) phase_dil_mfma(F); REP(4) phase_ret_state(F);
        } PH_END();
        if (PH_ON()) { REP(5) phase_dil_merge(F); REP(6) phase_ret_out(F, l); REP(7) phase_mla_mfma(F, l, rep_); } PH_END();
        if (PH_ON()) REP(8) { pg8::Gemm g{WSB(bf16, WS_YCAT), WSB(bf16, WS_WOUT), D, D, D, 0, 0}; pg8::StaticOrder S; S.init(T, D, F.G, (int)blockIdx.x); pg8::EpiBf16 E{WSB(bf16, WS_Y), D, D};
            pg8::gemm_phase<pg8::EpiBf16, pg8::StaticOrder, true>(F.lds + RING_OFF, g, S, E, F.tid); } PH_END();
        if (PH_ON()) { if (PROBE == 21) phase_ln<false>(F, l == 0 ? F.in(0) : F.outp(), WSB(float, WS_END), WSB(const float, WS_MOD) + (size_t)l * NB * 6 * D + 2 * D, F.in(12) + l * D, F.in(13) + l * D, WSB(const float, WS_MOD) + (size_t)l * NB * 6 * D, 3 * D, 4 * D, nullptr, li);
            phase_ln<false>(F, l == 0 ? F.in(0) : F.outp(), F.outp(), WSB(const float, WS_MOD) + (size_t)l * NB * 6 * D + 2 * D, F.in(12) + l * D, F.in(13) + l * D, WSB(const float, WS_MOD) + (size_t)l * NB * 6 * D, 3 * D, 4 * D, moe ? F.in(19) + (size_t)li * D * NEXP : nullptr, li); } PH_END();

        if (!moe) {
            if (PH_ON()) REP(9) { pg8::Gemm g{WSB(bf16, WS_H), WSB(bf16, WS_WFF), D, D, D, 0, 0}; pg8::StaticOrder S; S.init(T, 2 * DFF, F.G, (int)blockIdx.x); pg8::EpiSwiglu E{WSB(bf16, WS_FF), DFF};
                pg8::gemm_phase<pg8::EpiSwiglu, pg8::StaticOrder, true>(F.lds + RING_OFF, g, S, E, F.tid); } PH_END();
            if (PH_ON()) REP(10) { pg8::Gemm g{WSB(bf16, WS_FF), WSB(const bf16, WS_WFF + WFF_W2_OFF_DENSE), DFF, DFF, DFF, 0, 0}; pg8::StaticOrder S; S.init(T, D, F.G, (int)blockIdx.x); pg8::EpiBf16 E{WSB(bf16, WS_Y), D, D};
                pg8::gemm_phase<pg8::EpiBf16, pg8::StaticOrder, true>(F.lds + RING_OFF, g, S, E, F.tid); } PH_END();
            if (PH_ON()) { if (PROBE == 22) phase_ln<false>(F, F.outp(), WSB(float, WS_END), WSB(const float, WS_MOD) + (size_t)l * NB * 6 * D + 5 * D, F.in(14) + l * D, F.in(15) + l * D, (l + 1 < NL) ? WSB(const float, WS_MOD) + (size_t)(l + 1) * NB * 6 * D : nullptr, 0, D, nullptr, 0);
                phase_ln<false>(F, F.outp(), F.outp(), WSB(const float, WS_MOD) + (size_t)l * NB * 6 * D + 5 * D, F.in(14) + l * D, F.in(15) + l * D, (l + 1 < NL) ? WSB(const float, WS_MOD) + (size_t)(l + 1) * NB * 6 * D : nullptr, 0, D, nullptr, 0); } PH_END();
        } else {
            if (PH_ON()) { phase_moe_assign(F, li); } PH_END();
            if (PH_ON()) REP(11) { pg8::Gemm g{WSB(bf16, WS_Y), WSB(bf16, WS_WFF), D / 2, D / 2, D / 2, 0, (long)2 * DFFE * D / 2}; pg8::GroupedOrder S; S.init(WSB(const int, WS_SEG), 2 * DFFE / 256, F.G, (int)blockIdx.x); pg8::EpiSwiglu8 E{WSB(unsigned char, WS_FF), DFFE, 1.0f / 512.0f};
                pg8::gemm_phase<pg8::EpiSwiglu8, pg8::GroupedOrder, true, 1>(F.lds + RING_OFF, g, S, E, F.tid); } PH_END();
            if (PH_ON()) REP(12) { pg8::Gemm g{WSB(bf16, WS_FF), WSB(const bf16, WS_WFF + WFF_W2_OFF_MOE8), DFFE / 2, DFFE / 2, DFFE / 2, 0, (long)D * DFFE / 2}; pg8::GroupedOrder S; S.init(WSB(const int, WS_SEG), D / 256, F.G, (int)blockIdx.x); pg8::EpiBf16S E{WSB(bf16, WS_Y), D, 1.0f / 256.0f};
                pg8::gemm_phase<pg8::EpiBf16S, pg8::GroupedOrder, true, 1>(F.lds + RING_OFF, g, S, E, F.tid); } PH_END();
            if (PH_ON()) { phase_ln<true>(F, F.outp(), F.outp(), WSB(const float, WS_MOD) + (size_t)l * NB * 6 * D + 5 * D, F.in(14) + l * D, F.in(15) + l * D, (l + 1 < NL) ? WSB(const float, WS_MOD) + (size_t)(l + 1) * NB * 6 * D : nullptr, 0, D, nullptr, 0); } PH_END();
        }
    }
#undef PH_ON
#undef PH_END
}

extern "C" void kernel_launch(void* const* d_in, const int* in_sizes, int n_in, void* d_out, int out_size, void* d_ws, size_t ws_size, hipStream_t stream) {
    static int grid = 0;
    if (grid == 0) {
        if (n_in != 23 || out_size != T * D || ws_size < WS_END) { fprintf(stderr, "kernel_launch: unexpected shapes (n_in %d out %d ws %zu)\n", n_in, out_size, ws_size); grid = -1; return; }
        int dev = 0, cus = 0, per_cu = 0;
        if (hipGetDevice(&dev) != hipSuccess || hipDeviceGetAttribute(&cus, hipDeviceAttributeMultiprocessorCount, dev) != hipSuccess) { grid = -1; return; }
        if (hipFuncSetAttribute((const void*)mk_fwd, hipFuncAttributeMaxDynamicSharedMemorySize, LDS_BYTES) != hipSuccess) { fprintf(stderr, "kernel_launch: hipFuncSetAttribute failed\n"); grid = -1; return; }
        if (hipOccupancyMaxActiveBlocksPerMultiprocessor(&per_cu, (const void*)mk_fwd, NTHREADS, LDS_BYTES) != hipSuccess || per_cu < 1) fprintf(stderr, "kernel_launch: occupancy query reports %d\n", per_cu);
        (void)hipGetLastError();
        grid = cus;
    }
    if (grid < 0) return;
    if (hipMemsetAsync((char*)d_ws + WS_CTL, 0, CTL_ZERO_BYTES, stream) != hipSuccess) return;
    Args a{};
    for (int i = 0; i < 23; ++i) a.in[i] = (const float*)d_in[i];
    a.out = (float*)d_out; a.ws = (unsigned char*)d_ws;
#if MK_PER_PHASE
    for (int p = 0; p < NPHASES; ++p) { a.ph_lo = p; a.ph_hi = p + 1; hipLaunchKernelGGL(mk_fwd, dim3(grid), dim3(NTHREADS), LDS_BYTES, stream, a); }
#else
    a.ph_lo = 0; a.ph_hi = NPHASES; hipLaunchKernelGGL(mk_fwd, dim3(grid), dim3(NTHREADS), LDS_BYTES, stream, a);
#endif
}
```

```cpp
#include <hip/hip_runtime.h>
#include <cstdio>
#include <cstdint>

namespace pg8 {
#define PG8_LAS __attribute__((address_space(3)))
typedef unsigned short bf16_t;
typedef short bf16x8 __attribute__((ext_vector_type(8)));
typedef float f32x4 __attribute__((ext_vector_type(4)));
typedef unsigned u32x4 __attribute__((ext_vector_type(4)));
typedef unsigned u32x2 __attribute__((ext_vector_type(2)));
typedef int i32x4 __attribute__((ext_vector_type(4)));
typedef int i32x8 __attribute__((ext_vector_type(8)));
constexpr int BM = 256, BK = 64, HALF = 128, HTB = HALF * BK * 2, STAGE_BYTES = 8 * HTB, NXCD = 8, WGM = 8;

__host__ __device__ __forceinline__ int lds_byte(int r, int c) { const int st = (r >> 4) * 2 + (c >> 5), rr = r & 15, cc = c & 31, ob = rr * 64 + cc * 2; return st * 1024 + (ob ^ (((ob >> 9) & 1) << 5)); }
__host__ __device__ __forceinline__ void stage_rc(int b, int& R, int& C) { const int st = b / 1024, sb = b % 1024, swz = sb ^ (((sb >> 9) & 1) << 5); R = (st >> 1) * 16 + swz / 64; C = (st & 1) * 32 + (swz % 64) / 2; }
__host__ __device__ __forceinline__ int perm32(int rho) { const int n = rho >> 4, i = rho & 15; return 8 * (i >> 2) + 4 * n + (i & 3); }

struct Unit { int pm, pn, g; };
struct Gemm { const bf16_t* A; const bf16_t* Bt; int lda, ldb, K; int pad; long gstride; };

struct StaticOrder {
    int nM, nN, nwg, G, c;
    __device__ void init(int M, int N, int G_, int c_) { nM = M / BM; nN = N / BM; nwg = nM * nN; G = G_; c = c_; }
    __device__ bool next(int i, Unit& u) const {
        const long L = (long)i * G + c; if (L >= nwg) return false;
        int wgid = (int)L; { const int q = nwg / NXCD, r = nwg % NXCD, xcd = wgid % NXCD, off = wgid / NXCD; wgid = (xcd < r ? xcd * (q + 1) : r * (q + 1) + (xcd - r) * q) + off; }
        const int nig = WGM * nN, gid = wgid / nig, fm = gid * WGM, gsz = (nM - fm) < WGM ? (nM - fm) : WGM;
        u.pm = fm + ((wgid % nig) % gsz); u.pn = (wgid % nig) / gsz; u.g = 0; return true;
    }
};
struct GroupedOrder {
    int tp[9]; int nN, nwg, G, c;
    __device__ void init(const int* seg, int nN_, int G_, int c_) {
#pragma unroll
        for (int k = 0; k < 9; ++k) tp[k] = __builtin_amdgcn_readfirstlane(seg[k]) / BM;
        nN = nN_; nwg = tp[8] * nN; G = G_; c = c_; }
    __device__ bool next(int i, Unit& u) const {
        const long L = (long)i * G + c; if (L >= nwg) return false;
        const int wgid = (int)L, nM = tp[8];
        const int nig = WGM * nN, gid = wgid / nig, fm = gid * WGM, gsz = (nM - fm) < WGM ? (nM - fm) : WGM;
        u.pm = fm + ((wgid % nig) % gsz); u.pn = (wgid % nig) / gsz; int e = 0;
#pragma unroll
        for (int k = 1; k < 8; ++k) e += (u.pm >= tp[k]) ? 1 : 0;
        u.g = e; return true;
    }
};

__device__ __forceinline__ unsigned cvt_pk_bf16(float lo, float hi) { unsigned r; asm volatile("v_cvt_pk_bf16_f32 %0, %1, %2" : "=v"(r) : "v"(lo), "v"(hi)); return r; }

struct EpiBf16 {
    static constexpr bool PERM = true;
    bf16_t* O; int ldc; int ncols;
    __device__ __forceinline__ void operator()(const f32x4 (&acc)[2][2][4][2], const Unit& u, int wr, int wc, int fr, int fq) const {
        const int row0 = u.pm * BM + wr * 64 + fr; const int col0 = u.pn * BM + wc * 32 + 8 * fq;
#pragma unroll
        for (int ai = 0; ai < 2; ++ai)
#pragma unroll
            for (int m = 0; m < 4; ++m) { bf16_t* rowp = O + (size_t)(row0 + ai * HALF + m * 16) * ldc + col0;
#pragma unroll
                for (int bj = 0; bj < 2; ++bj) { if (col0 + bj * HALF >= ncols) continue; const f32x4 v0 = acc[ai][bj][m][0], v1 = acc[ai][bj][m][1];
                    u32x4 w; w.x = cvt_pk_bf16(v0[0], v0[1]); w.y = cvt_pk_bf16(v0[2], v0[3]); w.z = cvt_pk_bf16(v1[0], v1[1]); w.w = cvt_pk_bf16(v1[2], v1[3]);
                    *(u32x4*)(rowp + bj * HALF) = w; } }
    }
};
struct EpiBf16S {
    static constexpr bool PERM = true;
    bf16_t* O; int ldc; float scale;
    __device__ __forceinline__ void operator()(const f32x4 (&acc)[2][2][4][2], const Unit& u, int wr, int wc, int fr, int fq) const {
        const int row0 = u.pm * BM + wr * 64 + fr; const int col0 = u.pn * BM + wc * 32 + 8 * fq;
#pragma unroll
        for (int ai = 0; ai < 2; ++ai)
#pragma unroll
            for (int m = 0; m < 4; ++m) { bf16_t* rowp = O + (size_t)(row0 + ai * HALF + m * 16) * ldc + col0;
#pragma unroll
                for (int bj = 0; bj < 2; ++bj) { const f32x4 v0 = acc[ai][bj][m][0] * scale, v1 = acc[ai][bj][m][1] * scale;
                    u32x4 w; w.x = cvt_pk_bf16(v0[0], v0[1]); w.y = cvt_pk_bf16(v0[2], v0[3]); w.z = cvt_pk_bf16(v1[0], v1[1]); w.w = cvt_pk_bf16(v1[2], v1[3]);
                    *(u32x4*)(rowp + bj * HALF) = w; } }
    }
};
struct EpiSwiglu {
    static constexpr bool PERM = false;
    bf16_t* O; int ldc;
    __device__ __forceinline__ void operator()(const f32x4 (&acc)[2][2][4][2], const Unit& u, int wr, int wc, int fr, int fq) const {
        const int row0 = u.pm * BM + wr * 64 + fr; const int col0 = u.pn * 128 + wc * 16 + 4 * fq;
#pragma unroll
        for (int ai = 0; ai < 2; ++ai)
#pragma unroll
            for (int m = 0; m < 4; ++m) { bf16_t* rowp = O + (size_t)(row0 + ai * HALF + m * 16) * ldc + col0;
#pragma unroll
                for (int bj = 0; bj < 2; ++bj) { const f32x4 a1 = acc[ai][bj][m][0], a3 = acc[ai][bj][m][1]; float o[4];
#pragma unroll
                    for (int j = 0; j < 4; ++j) o[j] = a1[j] * __builtin_amdgcn_rcpf(1.0f + __builtin_amdgcn_exp2f(-1.4426950408889634f * a1[j])) * a3[j];
                    u32x2 w; w.x = cvt_pk_bf16(o[0], o[1]); w.y = cvt_pk_bf16(o[2], o[3]); *(u32x2*)(rowp + bj * 64) = w; } }
    }
};
__device__ __forceinline__ unsigned pack4_fp8(float a, float b, float c, float d) { int p = 0; p = __builtin_amdgcn_cvt_pk_fp8_f32(a, b, p, false); p = __builtin_amdgcn_cvt_pk_fp8_f32(c, d, p, true); return (unsigned)p; }
struct EpiSwiglu8 {
    static constexpr bool PERM = false;
    unsigned char* O; int ldc; float scale;
    __device__ __forceinline__ void operator()(const f32x4 (&acc)[2][2][4][2], const Unit& u, int wr, int wc, int fr, int fq) const {
        const int row0 = u.pm * BM + wr * 64 + fr; const int col0 = u.pn * 128 + wc * 16 + 4 * fq;
#pragma unroll
        for (int ai = 0; ai < 2; ++ai)
#pragma unroll
            for (int m = 0; m < 4; ++m) { unsigned char* rowp = O + (size_t)(row0 + ai * HALF + m * 16) * ldc + col0;
#pragma unroll
                for (int bj = 0; bj < 2; ++bj) { const f32x4 a1 = acc[ai][bj][m][0] * scale, a3 = acc[ai][bj][m][1] * scale; float o[4];
#pragma unroll
                    for (int j = 0; j < 4; ++j) { const float v = a1[j] * __builtin_amdgcn_rcpf(1.0f + __builtin_amdgcn_exp2f(-1.4426950408889634f * a1[j])) * a3[j] * 4.0f; o[j] = __builtin_amdgcn_fmed3f(v, -448.0f, 448.0f); }
                    *(unsigned*)(rowp + bj * 64) = pack4_fp8(o[0], o[1], o[2], o[3]); } }
    }
};

__device__ __forceinline__ float swz_xor16(float v) { return __builtin_bit_cast(float, __builtin_amdgcn_ds_swizzle(__builtin_bit_cast(int, v), 0x401F)); }
__device__ __forceinline__ float other_half(float v) { auto rr = __builtin_amdgcn_permlane32_swap(__builtin_bit_cast(unsigned, v), __builtin_bit_cast(unsigned, v), false, false); return __builtin_bit_cast(float, rr[0]) + __builtin_bit_cast(float, rr[1]); }

__host__ __device__ __forceinline__ int zmap(int nl) {
    const int tile = nl >> 8, w = nl & 255;
    if (tile == 0 || tile == 1 || (tile >= 4 && tile <= 6)) { const int hb = w >> 6, il = w & 63, nn = il >> 5, rem = il & 31, a = rem >> 4, i = rem & 15; return (tile << 8) + hb * 64 + 32 * a + 16 * nn + i; }
    if (tile == 11) return nl;
    const int g32 = w >> 5, lg = w & 31, n = (lg >> 2) & 1, i = 4 * (lg >> 3) + (lg & 3); return (tile << 8) + g32 * 32 + 16 * n + i;
}
struct EpiZ {
    static constexpr bool PERM = false;
    bf16_t* Z; bf16_t* Km; const float* tab; float* rsp; int zld; float qscale;
    __device__ __forceinline__ void operator()(const f32x4 (&acc)[2][2][4][2], const Unit& u, int wr, int wc, int fr, int fq) const {
        const int pn = u.pn, row0 = u.pm * BM + wr * 64 + fr;
        if (pn <= 1 || (pn >= 4 && pn <= 6)) {
#pragma unroll
            for (int bj = 0; bj < 2; ++bj) { const int headbase = pn * BM + bj * HALF + (wc >> 1) * 64, il = 16 * (wc & 1) + 4 * fq; const float qs = (headbase >= 1024 && headbase < 1408) ? qscale : 1.0f;
#pragma unroll
                for (int ai = 0; ai < 2; ++ai)
#pragma unroll
                    for (int m = 0; m < 4; ++m) { const int t = row0 + ai * HALF + m * 16; const f32x4 cs = *(const f32x4*)(tab + (size_t)t * 96 + il), sn = *(const f32x4*)(tab + (size_t)t * 96 + 32 + il);
                        const f32x4 x1 = acc[ai][bj][m][0], x2 = acc[ai][bj][m][1]; const f32x4 o1 = (x1 * cs - x2 * sn) * qs, o2 = (x2 * cs + x1 * sn) * qs;
                        bf16_t* p = Z + (size_t)t * zld + headbase + il; u32x2 w; w.x = cvt_pk_bf16(o1[0], o1[1]); w.y = cvt_pk_bf16(o1[2], o1[3]); *(u32x2*)p = w; w.x = cvt_pk_bf16(o2[0], o2[1]); w.y = cvt_pk_bf16(o2[2], o2[3]); *(u32x2*)(p + 32) = w; } }
        } else if (pn == 11) {
            if (wc == 0) {
#pragma unroll
                for (int ai = 0; ai < 2; ++ai)
#pragma unroll
                    for (int m = 0; m < 4; ++m) { const int t = row0 + ai * HALF + m * 16; const f32x4 cs = *(const f32x4*)(tab + (size_t)t * 96 + 64 + 4 * fq), sn = *(const f32x4*)(tab + (size_t)t * 96 + 80 + 4 * fq);
                        const f32x4 x1 = acc[ai][0][m][0], x2 = acc[ai][0][m][1]; const f32x4 o1 = x1 * cs - x2 * sn, o2 = x2 * cs + x1 * sn;
                        u32x2 w1, w2; w1.x = cvt_pk_bf16(o1[0], o1[1]); w1.y = cvt_pk_bf16(o1[2], o1[3]); w2.x = cvt_pk_bf16(o2[0], o2[1]); w2.y = cvt_pk_bf16(o2[2], o2[3]);
#pragma unroll
                        for (int h = 0; h < 6; ++h) { bf16_t* p = Km + (size_t)t * 576 + h * 96 + 64 + 4 * fq; *(u32x2*)p = w1; *(u32x2*)(p + 16) = w2; } } }
        } else {
            const int slot = (pn == 8) ? 0 : (pn == 9) ? 1 : 2; const bool stat = pn >= 8;
#pragma unroll
            for (int ai = 0; ai < 2; ++ai)
#pragma unroll
                for (int m = 0; m < 4; ++m) { const int t = row0 + ai * HALF + m * 16; bf16_t* rowp = Z + (size_t)t * zld + pn * BM + wc * 32 + 8 * fq; float ss = 0.f;
#pragma unroll
                    for (int bj = 0; bj < 2; ++bj) { const f32x4 v0 = acc[ai][bj][m][0], v1 = acc[ai][bj][m][1];
                        u32x4 w; w.x = cvt_pk_bf16(v0[0], v0[1]); w.y = cvt_pk_bf16(v0[2], v0[3]); w.z = cvt_pk_bf16(v1[0], v1[1]); w.w = cvt_pk_bf16(v1[2], v1[3]); *(u32x4*)(rowp + bj * HALF) = w;
                        if (stat && (pn != 8 || bj == 1)) ss += (v0[0] * v0[0] + v0[1] * v0[1]) + (v0[2] * v0[2] + v0[3] * v0[3]) + (v1[0] * v1[0] + v1[1] * v1[1]) + (v1[2] * v1[2] + v1[3] * v1[3]); }
                    if (stat) { ss += swz_xor16(ss); ss = other_half(ss); if (fq == 0) rsp[(size_t)t * 16 + slot * 4 + wc] = ss; } }
        }
    }
};
struct EpiMlaQ {
    static constexpr bool PERM = false;
    bf16_t* Q; const float* rs; const float* tab; float qscale; int pad;
    __device__ __forceinline__ void operator()(const f32x4 (&acc)[2][2][4][2], const Unit& u, int wr, int wc, int fr, int fq) const {
        const int row0 = u.pm * BM + wr * 64 + fr;
#pragma unroll
        for (int bj = 0; bj < 2; ++bj) { const int c0 = u.pn * BM + bj * HALF + wc * 32; if (c0 >= 576) continue; const bool rope = (c0 % 96) == 64;
#pragma unroll
            for (int ai = 0; ai < 2; ++ai)
#pragma unroll
                for (int m = 0; m < 4; ++m) { const int t = row0 + ai * HALF + m * 16; const f32x4 pa = *(const f32x4*)(rs + (size_t)t * 16), pb = *(const f32x4*)(rs + (size_t)t * 16 + 4); const float sc = qscale / sqrtf(((pa[0] + pa[1]) + (pa[2] + pa[3]) + (pb[0] + pb[1]) + (pb[2] + pb[3])) * (1.0f / 384.0f) + 1e-6f); f32x4 v0 = acc[ai][bj][m][0] * sc, v1 = acc[ai][bj][m][1] * sc;
                    if (rope) { const f32x4 cs = *(const f32x4*)(tab + (size_t)t * 96 + 64 + 4 * fq), sn = *(const f32x4*)(tab + (size_t)t * 96 + 80 + 4 * fq); const f32x4 o0 = v0 * cs - v1 * sn, o1 = v1 * cs + v0 * sn; v0 = o0; v1 = o1; }
                    bf16_t* p = Q + (size_t)t * 576 + c0 + 4 * fq; u32x2 w; w.x = cvt_pk_bf16(v0[0], v0[1]); w.y = cvt_pk_bf16(v0[2], v0[3]); *(u32x2*)p = w; w.x = cvt_pk_bf16(v1[0], v1[1]); w.y = cvt_pk_bf16(v1[2], v1[3]); *(u32x2*)(p + 16) = w; } }
    }
};
struct EpiMlaKV {
    static constexpr bool PERM = true;
    bf16_t* Km; bf16_t* Vm; const float* rs;
    __device__ __forceinline__ void operator()(const f32x4 (&acc)[2][2][4][2], const Unit& u, int wr, int wc, int fr, int fq) const {
        const int row0 = u.pm * BM + wr * 64 + fr;
#pragma unroll
        for (int bj = 0; bj < 2; ++bj) { const int c8 = u.pn * BM + bj * HALF + wc * 32 + 8 * fq; const int head = c8 >> 7, off = c8 & 127;
#pragma unroll
            for (int ai = 0; ai < 2; ++ai)
#pragma unroll
                for (int m = 0; m < 4; ++m) { const int t = row0 + ai * HALF + m * 16; const f32x4 pc = *(const f32x4*)(rs + (size_t)t * 16 + 8); const float sc = 1.0f / sqrtf(((pc[0] + pc[1]) + (pc[2] + pc[3])) * (1.0f / 256.0f) + 1e-6f); const f32x4 v0 = acc[ai][bj][m][0] * sc, v1 = acc[ai][bj][m][1] * sc;
                    bf16_t* p = (off < 64) ? Km + (size_t)t * 576 + head * 96 + off : Vm + (size_t)t * 384 + head * 64 + (off - 64);
                    u32x4 w; w.x = cvt_pk_bf16(v0[0], v0[1]); w.y = cvt_pk_bf16(v0[2], v0[3]); w.z = cvt_pk_bf16(v1[0], v1[1]); w.w = cvt_pk_bf16(v1[2], v1[3]); *(u32x4*)p = w; } }
    }
};

template <class Epi, class Sched, bool ALIGN_EPI, int FP8 = 0  >
__device__ __forceinline__ void gemm_phase(PG8_LAS unsigned char* lds, const Gemm g, const Sched& S, const Epi& E, const int tid) {
    const int wid = __builtin_amdgcn_readfirstlane(tid >> 6), lane = tid & 63, wr = wid >> 2, wc = wid & 3, fr = lane & 15, fq = lane >> 4;
    const int K = g.K, nt = K / BK;
    unsigned voffA[2], voffB[2];
#pragma unroll
    for (int i = 0; i < 2; ++i) { int R, C; stage_rc(tid * 16 + i * 8192, R, C); const int Rb = Epi::PERM ? ((R & ~31) + perm32(R & 31)) : R;
        voffA[i] = (unsigned)(R * g.lda + C) * 2u; voffB[i] = (unsigned)(Rb * g.ldb + C) * 2u; }
    const size_t kstep = (size_t)(BK * 2);
    const size_t hstepA = (size_t)HALF * g.lda * 2, hstepB = (size_t)HALF * g.ldb * 2;
    const size_t tstepA = 2 * hstepA, tstepB = 2 * hstepB;
    const unsigned ldsw = (unsigned)wid * 1024u;
    const int aoff = lds_byte(wr * 64 + fr, fq * 8), boff = lds_byte(wc * 32 + fr, fq * 8);
#define PG8_SA(b, h) (((b) * 2 + (h)) * HTB)
#define PG8_SB(b, h) ((4 + (b) * 2 + (h)) * HTB)
#define PG8_STAGE(bufoff, gbase, voff) do { _Pragma("unroll") for (int _i = 0; _i < 2; ++_i) \
        __builtin_amdgcn_global_load_lds((const unsigned*)((const char*)(gbase) + (voff)[_i]), (PG8_LAS unsigned*)(lds + (bufoff) + ldsw + _i * 8192), 16, 0, 0); } while (0)
#define PG8_LD8(addr) __builtin_shufflevector(*(const PG8_LAS i32x4*)(addr), *(const PG8_LAS i32x4*)((addr) + 1024), 0, 1, 2, 3, 4, 5, 6, 7)
#define PG8_LDA(dst, b, h) do { _Pragma("unroll") for (int m = 0; m < 4; ++m) dst[m] = PG8_LD8(lds + PG8_SA(b, h) + aoff + m * 2048); } while (0)
#define PG8_LDB(dst, b, h) do { _Pragma("unroll") for (int n = 0; n < 2; ++n) dst[n] = PG8_LD8(lds + PG8_SB(b, h) + boff + n * 2048); } while (0)
#define PG8_LO(x) __builtin_bit_cast(bf16x8, __builtin_shufflevector((x), (x), 0, 1, 2, 3))
#define PG8_HI(x) __builtin_bit_cast(bf16x8, __builtin_shufflevector((x), (x), 4, 5, 6, 7))
#define PG8_MMA(ai, bj, At, Bt) do { __builtin_amdgcn_s_setprio(1); _Pragma("unroll") for (int m = 0; m < 4; ++m) _Pragma("unroll") for (int n = 0; n < 2; ++n) { \
        if constexpr (FP8 != 0) asm volatile("v_mfma_f32_16x16x128_f8f6f4 %0, %1, %2, %0" : "+v"(acc[ai][bj][m][n]) : "v"(Bt[n]), "v"(At[m])); \
        else { acc[ai][bj][m][n] = __builtin_amdgcn_mfma_f32_16x16x32_bf16(PG8_LO(Bt[n]), PG8_LO(At[m]), acc[ai][bj][m][n], 0, 0, 0); acc[ai][bj][m][n] = __builtin_amdgcn_mfma_f32_16x16x32_bf16(PG8_HI(Bt[n]), PG8_HI(At[m]), acc[ai][bj][m][n], 0, 0, 0); } } __builtin_amdgcn_s_setprio(0); } while (0)
#define PG8_WAIT_V(n) asm volatile("s_waitcnt vmcnt(" #n ")" ::: "memory")
#define PG8_WAIT_L(n) asm volatile("s_waitcnt lgkmcnt(" #n ")" ::: "memory")
#define PG8_BAR __builtin_amdgcn_s_barrier()
#define PG8_SCHED __builtin_amdgcn_sched_barrier(0)
    Unit cur, nxt; int ui = 0;
    if (!S.next(0, cur)) return;
    f32x4 acc[2][2][4][2];
#pragma unroll
    for (int a = 0; a < 2; ++a)
#pragma unroll
        for (int b = 0; b < 2; ++b)
#pragma unroll
            for (int m = 0; m < 4; ++m)
#pragma unroll
                for (int n = 0; n < 2; ++n) acc[a][b][m][n] = (f32x4){0.f, 0.f, 0.f, 0.f};
    i32x8 At[4], B0[2], B1[2];
    const char* cA = (const char*)g.A + (size_t)cur.pm * tstepA; const char* cB = (const char*)(g.Bt + (size_t)cur.g * g.gstride) + (size_t)cur.pn * tstepB;
    PG8_STAGE(PG8_SB(0, 0), cB, voffB); PG8_STAGE(PG8_SB(0, 1), cB + hstepB, voffB); PG8_STAGE(PG8_SA(0, 0), cA, voffA); PG8_STAGE(PG8_SA(0, 1), cA + hstepA, voffA);
    if (wr == 1) PG8_BAR;
    PG8_WAIT_V(2); PG8_BAR;
    PG8_STAGE(PG8_SB(1, 0), cB + kstep, voffB); PG8_STAGE(PG8_SA(1, 0), cA + kstep, voffA); PG8_STAGE(PG8_SB(1, 1), cB + hstepB + kstep, voffB);
    PG8_WAIT_V(6); PG8_BAR;
    for (;;) {
        const bool has_next = S.next(ui + 1, nxt);
        const char* nA = has_next ? (const char*)g.A + (size_t)nxt.pm * tstepA : cA; const char* nB = has_next ? (const char*)(g.Bt + (size_t)nxt.g * g.gstride) + (size_t)nxt.pn * tstepB : cB;
#pragma nounroll
        for (int t = 0; t < nt; t += 2) {
            const bool last = (t == nt - 2);
            const char* a1 = cA + (size_t)(t + 1) * kstep;
            const char* a2 = last ? nA : cA + (size_t)(t + 2) * kstep; const char* b2 = last ? nB : cB + (size_t)(t + 2) * kstep;
            const char* a3 = a2 + kstep; const char* b3 = b2 + kstep;
            PG8_LDB(B0, 0, 0); PG8_LDB(B1, 0, 1); PG8_SCHED; PG8_LDA(At, 0, 0); PG8_STAGE(PG8_SA(1, 1), a1 + hstepA, voffA);
            PG8_WAIT_V(8); PG8_WAIT_L(0); PG8_BAR; PG8_MMA(0, 0, At, B0); PG8_MMA(0, 1, At, B1); PG8_BAR; PG8_SCHED;
            PG8_LDA(At, 0, 1); PG8_STAGE(PG8_SB(0, 0), b2, voffB); PG8_STAGE(PG8_SB(0, 1), b2 + hstepB, voffB); PG8_STAGE(PG8_SA(0, 0), a2, voffA);
            PG8_WAIT_V(8); PG8_WAIT_L(0); PG8_BAR; PG8_MMA(1, 0, At, B0); PG8_MMA(1, 1, At, B1); PG8_BAR; PG8_SCHED;
            PG8_LDB(B0, 1, 0); PG8_LDB(B1, 1, 1); PG8_SCHED; PG8_LDA(At, 1, 0); PG8_STAGE(PG8_SA(0, 1), a2 + hstepA, voffA);
            PG8_WAIT_V(8); PG8_WAIT_L(0); PG8_BAR; PG8_MMA(0, 0, At, B0); PG8_MMA(0, 1, At, B1); PG8_BAR; PG8_SCHED;
            PG8_LDA(At, 1, 1); PG8_STAGE(PG8_SB(1, 0), b3, voffB); PG8_STAGE(PG8_SB(1, 1), b3 + hstepB, voffB); PG8_STAGE(PG8_SA(1, 0), a3, voffA);
            PG8_WAIT_V(8); PG8_WAIT_L(0); PG8_BAR; PG8_MMA(1, 0, At, B0); PG8_MMA(1, 1, At, B1); PG8_BAR; PG8_SCHED;
        }
        if constexpr (ALIGN_EPI) { if (wr == 0) PG8_BAR; }
        if constexpr (FP8 != 0) asm volatile("s_nop 15\n\ts_nop 15" ::: "memory");
        E(acc, cur, wr, wc, fr, fq);
        if (!has_next) break;
#pragma unroll
        for (int a = 0; a < 2; ++a)
#pragma unroll
            for (int b = 0; b < 2; ++b)
#pragma unroll
                for (int m = 0; m < 4; ++m)
#pragma unroll
                    for (int n = 0; n < 2; ++n) acc[a][b][m][n] = (f32x4){0.f, 0.f, 0.f, 0.f};
        cur = nxt; cA = nA; cB = nB; ++ui;
        if constexpr (ALIGN_EPI) { if (wr == 1) PG8_BAR; }
    }
    PG8_WAIT_V(0);
    if constexpr (!ALIGN_EPI) { if (wr == 0) PG8_BAR; }
    PG8_BAR;
#undef PG8_SA
#undef PG8_SB
#undef PG8_STAGE
#undef PG8_LDA
#undef PG8_LDB
#undef PG8_MMA
#undef PG8_LD8
#undef PG8_LO
#undef PG8_HI
#undef PG8_WAIT_V
#undef PG8_WAIT_L
#undef PG8_BAR
#undef PG8_SCHED
}
}
constexpr int NWAVES = 8, NTHREADS = 512;
constexpr int NB = 8, SEQ = 4096, T = NB * SEQ, NL = 4, D = 1024, NEXP = 8;
constexpr int D_IN = 2848, ZLD = 3072;
constexpr int ZO_RQ = 0, ZO_RK = 256, ZO_RV = 512, ZO_RG = 768, ZO_DQ = 1024, ZO_DK = 1408, ZO_DV = 1792, ZO_CQ = 2176, ZO_CKV = 2560, ZO_KR = 2816;
constexpr int QRANK = 384, KVRANK = 256, QLD = 576, KLD = 576, VLD = 384;
constexpr int YO_RET = 0, YO_DIL = 256, YO_MLA = 640;
constexpr int DFF = 2816, DFFE = 3584;
constexpr float LN_EPS = 1e-5f, RMS_EPS = 1e-6f, DN_ALPHA = 1.6817928305074290f;
constexpr float LOG2E = 1.4426950408889634f;
constexpr float MLA_QSCALE = 0.10206207261596577f * LOG2E;
constexpr int MAXSLOT = 2 * T + NEXP * 256;

constexpr size_t MiB = 1u << 20;
constexpr size_t WS_CTL = 0, CTL_ZERO_BYTES = 1 * MiB;
constexpr size_t WS_MOD = 1 * MiB;
constexpr size_t WS_RS = 2 * MiB, WS_TOPI = WS_RS + 256 * 1024, WS_GATE = WS_TOPI + 256 * 1024, WS_TSLOT = WS_GATE + 256 * 1024, WS_SEG = WS_TSLOT + 256 * 1024;
constexpr size_t WS_TAB = 4 * MiB;
constexpr size_t WS_WIN = 16 * MiB, WS_WUQ = 22 * MiB, WS_WUKV = 23 * MiB, WS_WOUT = 24 * MiB, WS_WFF = 26 * MiB;
constexpr size_t WFF_W2_OFF_DENSE = (size_t)2 * DFF * D * 2, WFF_W2_OFF_MOE8 = (size_t)NEXP * 2 * DFFE * D;
constexpr size_t WS_H = 194 * MiB;
constexpr size_t WS_A = 258 * MiB;
constexpr size_t WS_Z = WS_A, WS_QM = WS_A + 192 * MiB, WS_KM = WS_A + 228 * MiB, WS_VM = WS_A + 264 * MiB, WS_KVS = WS_A + 288 * MiB, WS_DILO = WS_A + 304 * MiB, WS_DILL = WS_A + 376 * MiB, WS_YCAT = WS_A + 380 * MiB;
constexpr size_t WS_FF = WS_A;
constexpr size_t WS_Y = 720 * MiB;
constexpr size_t WS_XB = 852 * MiB;
constexpr size_t WS_RSP = 916 * MiB;
constexpr size_t WS_END = 918 * MiB;
static_assert((size_t)MAXSLOT * DFFE * 2 <= 462 * MiB && (size_t)MAXSLOT * D * 2 <= 132 * MiB && (size_t)T * ZLD * 2 == 192 * MiB, "ws map");
constexpr int CW_TMO = 0, CW_CODE = 1, CW_BAR = 4096, CW_CNT = 8192  , CW_CUR = 8448  , CW_Q = 8704  ;

constexpr int RING_OFF = 0, RING_BYTES = 131072;
constexpr int LDSCTL_OFF = RING_BYTES, MISC_OFF = LDSCTL_OFF + 320;
constexpr int LDS_BYTES = 147456;
constexpr int PTAB_OFF = LDSCTL_OFF + 512;

#define GAS __attribute__((address_space(1)))
#define LAS __attribute__((address_space(3)))
typedef unsigned short bf16;
typedef unsigned v4u __attribute__((ext_vector_type(4)));
typedef unsigned v2u __attribute__((ext_vector_type(2)));
typedef float f32x4 __attribute__((ext_vector_type(4)));
typedef GAS unsigned gu32;
#define RLX_AGENT __ATOMIC_RELAXED, __HIP_MEMORY_SCOPE_AGENT
#define LDS_WAIT() asm volatile("s_waitcnt lgkmcnt(0)" ::: "memory")
#define VM_WAIT() asm volatile("s_waitcnt vmcnt(0)" ::: "memory")
__device__ __forceinline__ unsigned f2bf(float f) { unsigned u = __builtin_bit_cast(unsigned, f); return (u + 0x7fffu + ((u >> 16) & 1u)) >> 16; }
__device__ __forceinline__ unsigned pk2(float lo, float hi) { return f2bf(lo) | (f2bf(hi) << 16); }
__device__ __forceinline__ float bf2f(unsigned short b) { return __builtin_bit_cast(float, (unsigned)b << 16); }
__device__ __forceinline__ float bflo(unsigned w) { return __builtin_bit_cast(float, w << 16); }
__device__ __forceinline__ float bfhi(unsigned w) { return __builtin_bit_cast(float, w & 0xffff0000u); }
__device__ __forceinline__ void ld8(const bf16* p, float* o) { const v4u w = *(const v4u*)p; o[0] = bflo(w.x); o[1] = bfhi(w.x); o[2] = bflo(w.y); o[3] = bfhi(w.y); o[4] = bflo(w.z); o[5] = bfhi(w.z); o[6] = bflo(w.w); o[7] = bfhi(w.w); }
__device__ __forceinline__ float fsilu(float x) { return x * __builtin_amdgcn_rcpf(1.0f + __builtin_amdgcn_exp2f(-LOG2E * x)); }

#define XB_TMO      128
#define XB_XCNT(j)  (256  + 64 * (j))
#define XB_XSUB(j)  (1280 + 64 * (j))
#define XB_XGEN(j)  (2304 + 64 * (j))
#define XB_TOP      3328
#define XB_TOPGEN   3392
#define XCD_BAR_WORDS 3456
#define XB_SPIN_CAP (1u << 18)
__device__ __forceinline__ unsigned xb_ld(unsigned* p)              { return __hip_atomic_load(p, __ATOMIC_RELAXED, __HIP_MEMORY_SCOPE_AGENT); }
__device__ __forceinline__ unsigned xb_add(unsigned* p, unsigned v) { return __hip_atomic_fetch_add(p, v, __ATOMIC_RELAXED, __HIP_MEMORY_SCOPE_AGENT); }
__device__ __forceinline__ unsigned xb_xcc_id() { return (unsigned)__builtin_amdgcn_s_getreg((3 << 11) | 20) & 0xFu; }
#define XB_SPIN(cond, bar) do { unsigned _sp = 0; while (cond) { __builtin_amdgcn_s_sleep(1); \
    if ((++_sp & 255u) == 0u) { if (xb_ld(&(bar)[XB_TMO])) break; if (_sp > XB_SPIN_CAP) { atomicAdd(&(bar)[XB_TMO], 1u); break; } } } } while (0)
struct XcdBarrier { unsigned* bar; unsigned x; volatile LAS unsigned* st; };
__device__ __forceinline__ XcdBarrier xcd_barrier_post(unsigned* bar, volatile LAS unsigned* st) {
    XcdBarrier b; b.bar = bar; b.x = xb_xcc_id(); b.st = st;
    if (threadIdx.x == 0) (void)xb_add(&bar[XB_XCNT(b.x)], 1u);
    return b;
}
__device__ __forceinline__ void xcd_barrier_complete(unsigned* bar, unsigned x, unsigned& nloc, unsigned& nx) {
    const unsigned G = gridDim.x * gridDim.y * gridDim.z;
    unsigned sum, cnt, mine, sp = 0u;
    for (;;) {
        sum = 0u; cnt = 0u; mine = 0u;
#pragma unroll
        for (unsigned j = 0; j < 16; ++j) { const unsigned c = xb_ld(&bar[XB_XCNT(j)]); sum += c; cnt += (c > 0u) ? 1u : 0u; mine = (j == x) ? c : mine; }
        if (sum == G) break;
        __builtin_amdgcn_s_sleep(1);
        if ((++sp & 255u) == 0u) { if (xb_ld(&bar[XB_TMO])) break; if (sp > XB_SPIN_CAP) { atomicAdd(&bar[XB_TMO], 1u); break; } }
    }
    nloc = mine > 0u ? mine : 1u; nx = cnt > 0u ? cnt : 1u;
}
__device__ __forceinline__ void xcd_barrier(const XcdBarrier& b) {
    asm volatile("s_waitcnt vmcnt(0)" ::: "memory");
    __syncthreads();
    if (threadIdx.x == 0) {
        unsigned* bar = b.bar; asm volatile("" : "+s"(bar));
        __builtin_amdgcn_s_waitcnt(0);
        unsigned nloc = b.st[0], nx = b.st[1];
        if (nloc == 0u) { xcd_barrier_complete(bar, b.x, nloc, nx); b.st[0] = nloc; b.st[1] = nx; }
        const unsigned old = xb_add(&bar[XB_XSUB(b.x)], 1u);
        const unsigned gen = old / nloc;
        if (old + 1u == (gen + 1u) * nloc) {
            __builtin_amdgcn_fence(__ATOMIC_RELEASE, "agent");
            asm volatile("s_waitcnt vmcnt(0)" ::: "memory");
            const unsigned og = xb_add(&bar[XB_TOP], 1u);
            const unsigned tg = og / nx;
            if (og + 1u == (tg + 1u) * nx) xb_add(&bar[XB_TOPGEN], 1u);
            else XB_SPIN(xb_ld(&bar[XB_TOPGEN]) == tg, bar);
            __builtin_amdgcn_fence(__ATOMIC_ACQUIRE, "agent");
            xb_add(&bar[XB_XGEN(b.x)], 1u);
            asm volatile("s_waitcnt vmcnt(0)" ::: "memory");
        } else {
            XB_SPIN(xb_ld(&bar[XB_XGEN(b.x)]) == gen, bar);
            __builtin_amdgcn_fence(__ATOMIC_ACQUIRE, "agent");
            asm volatile("s_waitcnt vmcnt(0)" ::: "memory");
        }
    }
    __syncthreads();
}

struct Frame {
    LAS unsigned char* lds; volatile LAS unsigned* MISC; gu32* ctl;
    int tid, lane, wave, vcu, G;
    __device__ __forceinline__ unsigned long long ptab(int i) const { const volatile LAS unsigned* p = (const volatile LAS unsigned*)(lds + PTAB_OFF) + 2 * i; const unsigned lo = p[0], hi = p[1];
        return ((unsigned long long)(unsigned)__builtin_amdgcn_readfirstlane((int)hi) << 32) | (unsigned)__builtin_amdgcn_readfirstlane((int)lo); }
    int wave_s;
    __device__ __forceinline__ void refresh() { int w = wave_s; asm volatile("" : "+s"(w)); const unsigned z0 = MISC[30];     int ln = (int)__builtin_amdgcn_mbcnt_hi(~0u, __builtin_amdgcn_mbcnt_lo(~0u, z0)); asm volatile("" : "+v"(ln)); wave = w; lane = ln; tid = w * 64 + ln;
        unsigned long long c = ptab(24); ctl = (gu32*)c; }
    __device__ __forceinline__ const float* in(int i) const { return (const float*)ptab(i); }
    __device__ __forceinline__ float* outp() const { return (float*)ptab(23); }
    __device__ __forceinline__ unsigned char* wsp() const { return (unsigned char*)ptab(24); }
};
__constant__ double INVT[48] = {
0.15915494309189535, 0.11934937021124886, 0.089499401608891013, 0.067115083005227255, 0.050329212104487035, 0.037741584717419771, 0.028302195830623399, 0.02122365276477766, 0.015915494309189534, 0.011934937021124886, 0.0089499401608891024, 0.0067115083005227253, 0.0050329212104487037, 0.0037741584717419772, 0.0028302195830623399, 0.0021223652764777662, 0.0015915494309189536, 0.0011934937021124885, 0.00089499401608891024, 0.0006711508300522726, 0.00050329212104487033, 0.00037741584717419774, 0.00028302195830623395, 0.00021223652764777661, 0.00015915494309189535, 0.00011934937021124886, 8.9499401608891018e-05, 6.7115083005227254e-05, 5.0329212104487035e-05, 3.7741584717419777e-05, 2.8302195830623396e-05, 2.1223652764777659e-05, 0.15915494309189535, 0.089499401608891013, 0.050329212104487035, 0.028302195830623399, 0.015915494309189534, 0.0089499401608891024, 0.0050329212104487037, 0.0028302195830623399, 0.0015915494309189536, 0.00089499401608891024, 0.00050329212104487033, 0.00028302195830623395, 0.00015915494309189535, 8.9499401608891018e-05, 5.0329212104487035e-05, 2.8302195830623396e-05};

#define dpp_f(v, ctrl) __builtin_bit_cast(float, __builtin_amdgcn_update_dpp(0, __builtin_bit_cast(int, (v)), (ctrl), 0xf, 0xf, false))
__device__ __forceinline__ float wave_sum_dpp(float v) {
    v += dpp_f(v, 0xB1); v += dpp_f(v, 0x4E); v += dpp_f(v, 0x141); v += dpp_f(v, 0x140);
    const int iv = __builtin_bit_cast(int, v);
    return (__builtin_bit_cast(float, __builtin_amdgcn_readlane(iv, 0)) + __builtin_bit_cast(float, __builtin_amdgcn_readlane(iv, 16))) + (__builtin_bit_cast(float, __builtin_amdgcn_readlane(iv, 32)) + __builtin_bit_cast(float, __builtin_amdgcn_readlane(iv, 48)));
}
__device__ __forceinline__ float shx(float v, int o, int lane) { return __builtin_bit_cast(float, __builtin_amdgcn_ds_bpermute((lane ^ o) << 2, __builtin_bit_cast(int, v))); }
__device__ __forceinline__ void transpose_item(const float* W, int K, int N, bf16* WT, int mode, const float* kscale, LAS float* scr, int item, int lane, bool fp8 = false) {
    const int nblk = N / 32, kb = item / nblk, nb = item % nblk, k0 = 64 * kb, n0 = 32 * nb;
    float tv[32];
#pragma unroll
    for (int i = 0; i < 32; ++i) tv[i] = __builtin_nontemporal_load(W + (size_t)(k0 + 2 * i + (lane >> 5)) * N + n0 + (lane & 31));
#pragma unroll
    for (int i = 0; i < 32; ++i) { const int kk = 2 * i + (lane >> 5); float v = tv[i]; if (kscale) v *= kscale[k0 + kk]; scr[kk * 33 + (lane & 31)] = v; }
    LDS_WAIT(); asm volatile("" ::: "memory");
    const int c = lane & 7;
#pragma unroll
    for (int j = 0; j < 4; ++j) { const int n = (lane >> 3) + 8 * j; const LAS float* s = scr + (8 * c) * 33 + n;
        v4u o; o.x = pk2(s[0 * 33], s[1 * 33]); o.y = pk2(s[2 * 33], s[3 * 33]); o.z = pk2(s[4 * 33], s[5 * 33]); o.w = pk2(s[6 * 33], s[7 * 33]);
        const int nn = n0 + n; const int row = (mode == 0) ? nn : (mode == 3) ? pg8::zmap(nn) : (32 * (nn >> 4) + (nn & 15) + (mode == 2 ? 16 : 0));
        if (fp8) { v2u o8; o8.x = pg8::pack4_fp8(s[0 * 33] * 64.f, s[1 * 33] * 64.f, s[2 * 33] * 64.f, s[3 * 33] * 64.f); o8.y = pg8::pack4_fp8(s[4 * 33] * 64.f, s[5 * 33] * 64.f, s[6 * 33] * 64.f, s[7 * 33] * 64.f);
            *(GAS v2u*)((unsigned char*)WT + (size_t)row * K + k0 + 8 * c) = o8; }
        else *(GAS v4u*)(WT + (size_t)row * K + k0 + 8 * c) = o; }
    LDS_WAIT(); asm volatile("" ::: "memory");
}
__device__ __forceinline__ void phase_convert(Frame& F, int l) {
    LAS float* scr = (LAS float*)(F.lds + RING_OFF + F.wave * 16384);
    const int gw = F.vcu * NWAVES + F.wave, NGW = F.G * NWAVES;
    bf16* WIN = (bf16*)(F.wsp() + WS_WIN); bf16* WUQ = (bf16*)(F.wsp() + WS_WUQ); bf16* WUKV = (bf16*)(F.wsp() + WS_WUKV); bf16* WOUT = (bf16*)(F.wsp() + WS_WOUT); bf16* WFF = (bf16*)(F.wsp() + WS_WFF);
    constexpr int I_IN = 16 * 89, I_UQ = 6 * 18, I_UKV = 4 * 24, I_OUT = 16 * 32, I_D1 = 16 * 88, I_D2 = 44 * 32, I_M1 = 16 * 112, I_M2 = 56 * 32;
    const bool moe = (l & 1) != 0; const int li = l >> 1;
    const int nff = moe ? NEXP * (2 * I_M1 + I_M2) : (2 * I_D1 + I_D2);
    const int nitems = I_IN + I_UQ + I_UKV + I_OUT + nff;
    for (int it = gw; it < nitems; it += NGW) {
        int r = it; const float* W; int K, N, mode = 0; bf16* WT; const float* ks = nullptr; bool f8 = false;
        if (r < I_IN) { W = F.in(3) + (size_t)l * D * D_IN; K = D; N = D_IN; WT = WIN; mode = 3; }
        else if ((r -= I_IN) < I_UQ) { W = F.in(7) + (size_t)l * QRANK * 576; K = QRANK; N = 576; WT = WUQ; ks = F.in(5) + l * QRANK; }
        else if ((r -= I_UQ) < I_UKV) { W = F.in(8) + (size_t)l * KVRANK * 768; K = KVRANK; N = 768; WT = WUKV; ks = F.in(6) + l * KVRANK; }
        else if ((r -= I_UKV) < I_OUT) { W = F.in(9) + (size_t)l * D * D; K = D; N = D; WT = WOUT; }
        else { r -= I_OUT;
            if (!moe) {
                if (r < I_D1) { W = F.in(16) + (size_t)li * D * DFF; K = D; N = DFF; WT = WFF; mode = 1; }
                else if ((r -= I_D1) < I_D1) { W = F.in(17) + (size_t)li * D * DFF; K = D; N = DFF; WT = WFF; mode = 2; }
                else { r -= I_D1; W = F.in(18) + (size_t)li * DFF * D; K = DFF; N = D; WT = (bf16*)((unsigned char*)WFF + WFF_W2_OFF_DENSE); }
            } else { const int per = 2 * I_M1 + I_M2; const int e = r / per; r -= e * per; f8 = true;
                if (r < I_M1) { W = F.in(20) + ((size_t)li * NEXP + e) * D * DFFE; K = D; N = DFFE; WT = (bf16*)((unsigned char*)WFF + (size_t)e * 2 * DFFE * D); mode = 1; }
                else if ((r -= I_M1) < I_M1) { W = F.in(21) + ((size_t)li * NEXP + e) * D * DFFE; K = D; N = DFFE; WT = (bf16*)((unsigned char*)WFF + (size_t)e * 2 * DFFE * D); mode = 2; }
                else { r -= I_M1; W = F.in(22) + ((size_t)li * NEXP + e) * DFFE * D; K = DFFE; N = D; WT = (bf16*)((unsigned char*)WFF + WFF_W2_OFF_MOE8 + (size_t)e * D * DFFE); }
            } }
        transpose_item(W, K, N, WT, mode, ks, scr, r, F.lane, f8);
    }
    const int gt = F.vcu * NTHREADS + F.tid, NT = F.G * NTHREADS;
    { GAS v4u* p = (GAS v4u*)(WIN + (size_t)D_IN * D); const int n = (ZLD - D_IN) * D / 8; unsigned zz = 0u; asm volatile("" : "+v"(zz)); for (int i = gt; i < n; i += NT) p[i] = (v4u){zz, zz, zz, zz}; }
    { GAS v4u* p = (GAS v4u*)(WUQ + (size_t)576 * QRANK); const int n = (768 - 576) * QRANK / 8; unsigned zz = 0u; asm volatile("" : "+v"(zz)); for (int i = gt; i < n; i += NT) p[i] = (v4u){zz, zz, zz, zz}; }
}
__device__ __forceinline__ void phase_mod_tab(Frame& F) {
    const int gt = F.vcu * NTHREADS + F.tid, NT = F.G * NTHREADS;
    float* MOD = (float*)(F.wsp() + WS_MOD); float* TAB = (float*)(F.wsp() + WS_TAB);
    const float* c = F.in(1); const float* w_ada = F.in(10); const float* b_ada = F.in(11); const int* pos = (const int*)F.in(2);
    for (int ix = gt; ix < NL * NB * 6 * D; ix += NT) { const int j = ix % (6 * D), b = (ix / (6 * D)) % NB, l = ix / (6 * D * NB);
        const float* w = w_ada + (size_t)l * D * 6 * D + j; float acc = b_ada[(size_t)l * 6 * D + j];
        for (int k = 0; k < D; ++k) acc += fsilu(c[b * D + k]) * w[(size_t)k * 6 * D];
        MOD[ix] = acc; }
    for (int ix = gt; ix < T * 48; ix += NT) { const int t = ix / 48, i = ix % 48; const double x = (double)pos[t] * INVT[i]; const float fr = (float)(x - floor(x));
        const float s = __builtin_amdgcn_sinf(fr), cc = __builtin_amdgcn_cosf(fr); float* r = TAB + (size_t)t * 96;
        if (i < 32) { r[i] = cc; r[32 + i] = s; } else { r[64 + (i - 32)] = cc; r[80 + (i - 32)] = s; } }
}
__device__ __forceinline__ void phase_modulate0(Frame& F) {
    const int gt = F.vcu * NTHREADS + F.tid, NT = F.G * NTHREADS; const float* MOD = (const float*)(F.wsp() + WS_MOD); bf16* H = (bf16*)(F.wsp() + WS_H); const float* x = F.in(0);
    for (int ix = gt; ix < T * D / 4; ix += NT) { const int t = ix / (D / 4), d = (ix % (D / 4)) * 4, b = t / SEQ; const float* m = MOD + (size_t)b * 6 * D;
        const f32x4 xv = *(const f32x4*)(x + (size_t)ix * 4), sh = *(const f32x4*)(m + d), sc = *(const f32x4*)(m + D + d); const f32x4 h = xv * (1.0f + sc) + sh;
        v2u w; w.x = pk2(h.x, h.y); w.y = pk2(h.z, h.w); *(v2u*)(H + (size_t)ix * 4) = w; }
}
__device__ __forceinline__ void rope8(const v4u a, const v4u b, const float* cs, const float* sn, float qs, v4u& oa, v4u& ob) {
    const f32x4 c0 = *(const f32x4*)cs, c1 = *(const f32x4*)(cs + 4), s0 = *(const f32x4*)sn, s1 = *(const f32x4*)(sn + 4);
    const float x1[8] = {bflo(a.x), bfhi(a.x), bflo(a.y), bfhi(a.y), bflo(a.z), bfhi(a.z), bflo(a.w), bfhi(a.w)}, x2[8] = {bflo(b.x), bfhi(b.x), bflo(b.y), bfhi(b.y), bflo(b.z), bfhi(b.z), bflo(b.w), bfhi(b.w)};
    const float c[8] = {c0.x, c0.y, c0.z, c0.w, c1.x, c1.y, c1.z, c1.w}, s[8] = {s0.x, s0.y, s0.z, s0.w, s1.x, s1.y, s1.z, s1.w}; float o1[8], o2[8];
#pragma unroll
    for (int i = 0; i < 8; ++i) { o1[i] = (x1[i] * c[i] - x2[i] * s[i]) * qs; o2[i] = (x2[i] * c[i] + x1[i] * s[i]) * qs; }
    oa.x = pk2(o1[0], o1[1]); oa.y = pk2(o1[2], o1[3]); oa.z = pk2(o1[4], o1[5]); oa.w = pk2(o1[6], o1[7]); ob.x = pk2(o2[0], o2[1]); ob.y = pk2(o2[2], o2[3]); ob.z = pk2(o2[4], o2[5]); ob.w = pk2(o2[6], o2[7]);
}
__device__ __forceinline__ float sumsq8(const v4u a) { const float x[8] = {bflo(a.x), bfhi(a.x), bflo(a.y), bfhi(a.y), bflo(a.z), bfhi(a.z), bflo(a.w), bfhi(a.w)}; float s = 0.f;
#pragma unroll
    for (int i = 0; i < 8; ++i) s += x[i] * x[i];
    return s; }
__device__ __forceinline__ void phase_rope_stats(Frame& F) {
    const int gw = F.vcu * NWAVES + F.wave, NGW = F.G * NWAVES, lane = F.lane;
    bf16* Z = (bf16*)(F.wsp() + WS_Z); bf16* KM = (bf16*)(F.wsp() + WS_KM); const float* TAB = (const float*)(F.wsp() + WS_TAB); float* RS = (float*)(F.wsp() + WS_RS);
    const int cc = lane & 3, hdA = lane >> 2, hdB = 16 + (lane >> 2);
    const int baseA = (hdA < 4) ? ZO_RQ + hdA * 64 : (hdA < 8) ? ZO_RK + (hdA - 4) * 64 : (hdA < 14) ? ZO_DQ + (hdA - 8) * 64 : ZO_DK + (hdA - 14) * 64;
    const int baseB = ZO_DK + (hdB - 14) * 64;
    const float qsA = (hdA >= 8 && hdA < 14) ? 0.125f * LOG2E : 1.0f;
    for (int t = gw; t < T; t += NGW) { bf16* zr = Z + (size_t)t * ZLD; const float* tb = TAB + (size_t)t * 96;
        const v4u a1 = *(const v4u*)(zr + baseA + 8 * cc), a2 = *(const v4u*)(zr + baseA + 32 + 8 * cc);
        v4u b1 = (v4u){0u, 0u, 0u, 0u}, b2 = b1, k1 = b1, k2 = b1, q1 = b1, q2 = b1;
        if (lane < 16) { b1 = *(const v4u*)(zr + baseB + 8 * cc); b2 = *(const v4u*)(zr + baseB + 32 + 8 * cc); }
        else if (lane < 18) { k1 = *(const v4u*)(zr + ZO_KR + 8 * (lane - 16)); k2 = *(const v4u*)(zr + ZO_KR + 16 + 8 * (lane - 16)); }
        if (lane < 48) q1 = *(const v4u*)(zr + ZO_CQ + 8 * lane);
        if (lane < 32) q2 = *(const v4u*)(zr + ZO_CKV + 8 * lane);
        v4u oa, ob; rope8(a1, a2, tb + 8 * cc, tb + 32 + 8 * cc, qsA, oa, ob); *(v4u*)(zr + baseA + 8 * cc) = oa; *(v4u*)(zr + baseA + 32 + 8 * cc) = ob;
        if (lane < 16) { rope8(b1, b2, tb + 8 * cc, tb + 32 + 8 * cc, 1.0f, oa, ob); *(v4u*)(zr + baseB + 8 * cc) = oa; *(v4u*)(zr + baseB + 32 + 8 * cc) = ob; }
        else if (lane < 18) { const int j = lane - 16; rope8(k1, k2, tb + 64 + 8 * j, tb + 80 + 8 * j, 1.0f, oa, ob);
#pragma unroll
            for (int h = 0; h < 6; ++h) { *(v4u*)(KM + (size_t)t * KLD + h * 96 + 64 + 8 * j) = oa; *(v4u*)(KM + (size_t)t * KLD + h * 96 + 80 + 8 * j) = ob; } }
        float s1 = (lane < 48) ? sumsq8(q1) : 0.f, s2 = (lane < 32) ? sumsq8(q2) : 0.f;
        s1 = wave_sum_dpp(s1); s2 = wave_sum_dpp(s2);
        if (lane == 0) { RS[t * 2] = 1.0f / sqrtf(s1 * (1.0f / QRANK) + RMS_EPS); RS[t * 2 + 1] = 1.0f / sqrtf(s2 * (1.0f / KVRANK) + RMS_EPS); } }
}
__device__ __forceinline__ void phase_ret_simple(Frame& F, int l) {
    const int gt = F.vcu * NTHREADS + F.tid, NT = F.G * NTHREADS; const bf16* Z = (const bf16*)(F.wsp() + WS_Z); bf16* YC = (bf16*)(F.wsp() + WS_YCAT); const float* gn = F.in(4) + l * 256;
    for (int ix = gt; ix < NB * 4 * SEQ; ix += NT) { const int t = ix % SEQ, h = (ix / SEQ) % 4, b = ix / (SEQ * 4);
        const float lg2 = __builtin_amdgcn_logf(1.0f - __builtin_amdgcn_exp2f(-5.0f - (float)h));
        const bf16* zb = Z + (size_t)b * SEQ * ZLD; float q[64], o[64];
#pragma unroll
        for (int d = 0; d < 64; d += 8) ld8(zb + (size_t)t * ZLD + ZO_RQ + h * 64 + d, q + d);
#pragma unroll
        for (int d = 0; d < 64; ++d) { q[d] *= 0.125f; o[d] = 0.f; }
        for (int j = 0; j <= t; ++j) { const bf16* kp = zb + (size_t)j * ZLD + ZO_RK + h * 64; const bf16* vp = zb + (size_t)j * ZLD + ZO_RV + h * 64; float s = 0.f;
#pragma unroll
            for (int d = 0; d < 64; d += 8) { float kk[8]; ld8(kp + d, kk);
#pragma unroll
                for (int e = 0; e < 8; ++e) s += q[d + e] * kk[e]; }
            s *= __builtin_amdgcn_exp2f((float)(t - j) * lg2);
#pragma unroll
            for (int d = 0; d < 64; d += 8) { float vv[8]; ld8(vp + d, vv);
#pragma unroll
                for (int e = 0; e < 8; ++e) o[d + e] += s * vv[e]; } }
        float mu = 0.f;
#pragma unroll
        for (int d = 0; d < 64; ++d) mu += o[d];
        mu *= (1.0f / 64.0f); float var = 0.f;
#pragma unroll
        for (int d = 0; d < 64; ++d) { const float dd = o[d] - mu; var += dd * dd; }
        const float rs = 1.0f / sqrtf(var * (1.0f / 64.0f) + LN_EPS);
        const bf16* gp = zb + (size_t)t * ZLD + ZO_RG + h * 64; bf16* yp = YC + ((size_t)b * SEQ + t) * D + YO_RET + h * 64;
#pragma unroll
        for (int d = 0; d < 64; d += 8) { float gg[8]; ld8(gp + d, gg); v4u w; float r[8];
#pragma unroll
            for (int e = 0; e < 8; ++e) r[e] = fsilu(gg[e]) * ((o[d + e] - mu) * rs * gn[h * 64 + d + e]);
            w.x = pk2(r[0], r[1]); w.y = pk2(r[2], r[3]); w.z = pk2(r[4], r[5]); w.w = pk2(r[6], r[7]); *(v4u*)(yp + d) = w; } }
}
__device__ __forceinline__ void phase_dil_simple(Frame& F) {
    const int gt = F.vcu * NTHREADS + F.tid, NT = F.G * NTHREADS; const bf16* Z = (const bf16*)(F.wsp() + WS_Z); bf16* YC = (bf16*)(F.wsp() + WS_YCAT);
    for (int ix = gt; ix < NB * 6 * SEQ; ix += NT) { const int t = ix % SEQ, h = (ix / SEQ) % 6, b = ix / (SEQ * 6);
        const bf16* zb = Z + (size_t)b * SEQ * ZLD; float q[64], o[64];
#pragma unroll
        for (int d = 0; d < 64; d += 8) ld8(zb + (size_t)t * ZLD + ZO_DQ + h * 64 + d, q + d);
#pragma unroll
        for (int d = 0; d < 64; ++d) { q[d] *= 0.125f * LOG2E; o[d] = 0.f; }
        float m = -INFINITY, lsum = 0.f;
        for (int p = 0; p < 3; ++p) { const int r = (p == 0) ? 1 : (p == 1) ? 4 : 16;
            for (int j = 0; j <= 128; ++j) { const int kpos = t - j * r; if (kpos < 0) break;
                const bf16* kp = zb + (size_t)kpos * ZLD + ZO_DK + h * 64; const bf16* vp = zb + (size_t)kpos * ZLD + ZO_DV + h * 64; float s = 0.f;
#pragma unroll
                for (int d = 0; d < 64; d += 8) { float kk[8]; ld8(kp + d, kk);
#pragma unroll
                    for (int e = 0; e < 8; ++e) s += q[d + e] * kk[e]; }
                const float mn = fmaxf(m, s), corr = __builtin_amdgcn_exp2f(m - mn), pe = __builtin_amdgcn_exp2f(s - mn); lsum = lsum * corr + pe; m = mn;
#pragma unroll
                for (int d = 0; d < 64; d += 8) { float vv[8]; ld8(vp + d, vv);
#pragma unroll
                    for (int e = 0; e < 8; ++e) o[d + e] = o[d + e] * corr + pe * vv[e]; } } }
        const float il = 1.0f / lsum; bf16* yp = YC + ((size_t)b * SEQ + t) * D + YO_DIL + h * 64;
#pragma unroll
        for (int d = 0; d < 64; d += 8) { v4u w; w.x = pk2(o[d] * il, o[d + 1] * il); w.y = pk2(o[d + 2] * il, o[d + 3] * il); w.z = pk2(o[d + 4] * il, o[d + 5] * il); w.w = pk2(o[d + 6] * il, o[d + 7] * il); *(v4u*)(yp + d) = w; } }
}
__device__ __forceinline__ void phase_mla_simple(Frame& F) {
    const int gt = F.vcu * NTHREADS + F.tid, NT = F.G * NTHREADS; const bf16* QM = (const bf16*)(F.wsp() + WS_QM); const bf16* KM = (const bf16*)(F.wsp() + WS_KM); const bf16* VM = (const bf16*)(F.wsp() + WS_VM); bf16* YC = (bf16*)(F.wsp() + WS_YCAT);
    for (int ix = gt; ix < NB * 6 * SEQ; ix += NT) { const int t = ix % SEQ, h = (ix / SEQ) % 6, b = ix / (SEQ * 6); const size_t r0 = (size_t)b * SEQ;
        float q[96], o[64];
#pragma unroll
        for (int d = 0; d < 96; d += 8) ld8(QM + (r0 + t) * QLD + h * 96 + d, q + d);
#pragma unroll
        for (int d = 0; d < 64; ++d) o[d] = 0.f;
        float m = -INFINITY, lsum = 0.f;
        for (int j = 0; j <= t; ++j) { const bf16* kp = KM + (r0 + j) * KLD + h * 96; const bf16* vp = VM + (r0 + j) * VLD + h * 64; float s = 0.f;
#pragma unroll
            for (int d = 0; d < 96; d += 8) { float kk[8]; ld8(kp + d, kk);
#pragma unroll
                for (int e = 0; e < 8; ++e) s += q[d + e] * kk[e]; }
            const float mn = fmaxf(m, s), corr = __builtin_amdgcn_exp2f(m - mn), pe = __builtin_amdgcn_exp2f(s - mn); lsum = lsum * corr + pe; m = mn;
#pragma unroll
            for (int d = 0; d < 64; d += 8) { float vv[8]; ld8(vp + d, vv);
#pragma unroll
                for (int e = 0; e < 8; ++e) o[d + e] = o[d + e] * corr + pe * vv[e]; } }
        const float il = 1.0f / lsum; bf16* yp = YC + (r0 + t) * D + YO_MLA + h * 64;
#pragma unroll
        for (int d = 0; d < 64; d += 8) { v4u w; w.x = pk2(o[d] * il, o[d + 1] * il); w.y = pk2(o[d + 2] * il, o[d + 3] * il); w.z = pk2(o[d + 4] * il, o[d + 5] * il); w.w = pk2(o[d + 6] * il, o[d + 7] * il); *(v4u*)(yp + d) = w; } }
}
template <bool MOE_Y>
__device__ __forceinline__ void phase_ln(Frame& F, const float* xin  , float* xout  , const float* gmod  , const float* lng, const float* lnb,
                                         const float* hm  , int sh_off, int sc_off, const float* wr  , int li) {
    const int gw = F.vcu * NWAVES + F.wave, NGW = F.G * NWAVES, lane = F.lane;
    bf16* XB = (bf16*)(F.wsp() + WS_XB); const bf16* Y = (const bf16*)(F.wsp() + WS_Y); bf16* H = (bf16*)(F.wsp() + WS_H); int* TOPI = (int*)(F.wsp() + WS_TOPI); float* GATE = (float*)(F.wsp() + WS_GATE); const int* TSLOT = (const int*)(F.wsp() + WS_TSLOT);
    volatile LAS unsigned* lcnt = F.MISC + 16;
    if (wr) { if (F.tid < 8) lcnt[F.tid] = 0u; __syncthreads(); }
    f32x4 cg[4], cb[4];
#pragma unroll
    for (int j = 0; j < 4; ++j) { cg[j] = *(const f32x4*)(lng + 4 * lane + 256 * j); cb[j] = *(const f32x4*)(lnb + 4 * lane + 256 * j); }
    f32x4 nx[4]; v2u nxb[4], ny0[4], ny1[4]; float ng0 = 0.f, ng1 = 0.f;
#define LN_LOAD(t_) do { const int t__ = (t_); const bf16 *y0_, *y1_ = nullptr; if (MOE_Y) { ng0 = GATE[t__ * 2]; ng1 = GATE[t__ * 2 + 1]; y0_ = Y + (size_t)TSLOT[t__ * 2] * D; y1_ = Y + (size_t)TSLOT[t__ * 2 + 1] * D; } else y0_ = Y + (size_t)t__ * D; \
        _Pragma("unroll") for (int j = 0; j < 4; ++j) { const int d = 4 * lane + 256 * j; if (xin) nx[j] = *(const f32x4*)(xin + (size_t)t__ * D + d); else nxb[j] = *(const v2u*)(XB + (size_t)t__ * D + d); ny0[j] = *(const v2u*)(y0_ + d); if (MOE_Y) ny1[j] = *(const v2u*)(y1_ + d); } } while (0)
    int t = gw; if (t < T) LN_LOAD(t);
    for (; t < T; t += NGW) { const int b = t / SEQ; const float* g = gmod + (size_t)b * 6 * D; f32x4 v[4]; float s1 = 0.f, s2 = 0.f;
#pragma unroll
        for (int j = 0; j < 4; ++j) { const int d = 4 * lane + 256 * j; const f32x4 gv = *(const f32x4*)(g + d);
            f32x4 yv = (f32x4){bflo(ny0[j].x), bfhi(ny0[j].x), bflo(ny0[j].y), bfhi(ny0[j].y)};
            if (MOE_Y) yv = yv * ng0 + (f32x4){bflo(ny1[j].x), bfhi(ny1[j].x), bflo(ny1[j].y), bfhi(ny1[j].y)} * ng1;
            const f32x4 xv = xin ? nx[j] : (f32x4){bflo(nxb[j].x), bfhi(nxb[j].x), bflo(nxb[j].y), bfhi(nxb[j].y)};
            v[j] = xv * DN_ALPHA + (1.0f + gv) * yv; s1 += (v[j].x + v[j].y) + (v[j].z + v[j].w); s2 += (v[j].x * v[j].x + v[j].y * v[j].y) + (v[j].z * v[j].z + v[j].w * v[j].w); }
        if (t + NGW < T) LN_LOAD(t + NGW);
        s1 = wave_sum_dpp(s1); s2 = wave_sum_dpp(s2);
        const float mean = s1 * (1.f / D); const float rstd = 1.f / sqrtf(fmaxf(s2 * (1.f / D) - mean * mean, 0.f) + LN_EPS);
        float lg[8];
#pragma unroll
        for (int e = 0; e < 8; ++e) lg[e] = 0.f;
#pragma unroll
        for (int j = 0; j < 4; ++j) { const int d = 4 * lane + 256 * j; const f32x4 xn = (v[j] - mean) * rstd * cg[j] + cb[j];
            if (xout) *(f32x4*)(xout + (size_t)t * D + d) = xn; else { v2u wx; wx.x = pk2(xn.x, xn.y); wx.y = pk2(xn.z, xn.w); *(v2u*)(XB + (size_t)t * D + d) = wx; }
            if (hm) { const float* m = hm + (size_t)b * 6 * D; const f32x4 hv = xn * (1.0f + *(const f32x4*)(m + sc_off + d)) + *(const f32x4*)(m + sh_off + d);
                v2u w; w.x = pk2(hv.x, hv.y); w.y = pk2(hv.z, hv.w); *(v2u*)(H + (size_t)t * D + d) = w;
                if (wr) {
#pragma unroll
                    for (int i = 0; i < 4; ++i) { const f32x4 wa = *(const f32x4*)(wr + (size_t)(d + i) * 8), wb = *(const f32x4*)(wr + (size_t)(d + i) * 8 + 4); const float hh = hv[i];
                        lg[0] += hh * wa.x; lg[1] += hh * wa.y; lg[2] += hh * wa.z; lg[3] += hh * wa.w; lg[4] += hh * wb.x; lg[5] += hh * wb.y; lg[6] += hh * wb.z; lg[7] += hh * wb.w; } } } }
        if (wr) {
#pragma unroll
            for (int e = 0; e < 8; ++e) lg[e] = wave_sum_dpp(lg[e]);
            if (lane == 0) { int i0 = 0; float v0 = lg[0];
#pragma unroll
                for (int e = 1; e < 8; ++e) if (lg[e] > v0) { v0 = lg[e]; i0 = e; }
                int i1 = 0; float v1 = -INFINITY;
#pragma unroll
                for (int e = 0; e < 8; ++e) if (e != i0 && lg[e] > v1) { v1 = lg[e]; i1 = e; }
                const float ga = 1.0f / (1.0f + __expf(v1 - v0)); TOPI[t * 2] = i0; TOPI[t * 2 + 1] = i1; GATE[t * 2] = ga; GATE[t * 2 + 1] = 1.0f - ga;
                __hip_atomic_fetch_add((LAS unsigned*)(lcnt + i0), 1u, __ATOMIC_RELAXED, __HIP_MEMORY_SCOPE_WORKGROUP); __hip_atomic_fetch_add((LAS unsigned*)(lcnt + i1), 1u, __ATOMIC_RELAXED, __HIP_MEMORY_SCOPE_WORKGROUP); } } }
#undef LN_LOAD
    if (wr) { __syncthreads(); if (F.tid < 8) __hip_atomic_fetch_add(F.ctl + CW_CNT + 64 * li + F.tid, lcnt[F.tid], RLX_AGENT); }
}
__device__ __forceinline__ void phase_moe_assign(Frame& F, int li) {
    const int gw = F.vcu * NWAVES + F.wave, NGW = F.G * NWAVES, lane = F.lane;
    const int* TOPI = (const int*)(F.wsp() + WS_TOPI); int* TSLOT = (int*)(F.wsp() + WS_TSLOT); int* SEG = (int*)(F.wsp() + WS_SEG); const bf16* H = (const bf16*)(F.wsp() + WS_H); bf16* HS = (bf16*)(F.wsp() + WS_Y);
    int seg[9]; { int acc = 0;
#pragma unroll
        for (int e = 0; e < 8; ++e) { seg[e] = acc; const int c = (int)__hip_atomic_load(F.ctl + CW_CNT + 64 * li + e, RLX_AGENT); acc += (c + 255) & ~255; } seg[8] = acc; }
    if (gw == 0 && lane < 9) { int v = seg[0];
#pragma unroll
        for (int k = 1; k < 9; ++k) v = (lane == k) ? seg[k] : v;
        SEG[lane] = v; }
    for (int blk = gw; blk < T / 64; blk += NGW) { const int t = blk * 64 + lane; const int e0 = TOPI[t * 2], e1 = TOPI[t * 2 + 1]; int s0 = 0, s1 = 0;
        const unsigned long long lt = (1ull << lane) - 1ull;
#pragma unroll
        for (int e = 0; e < 8; ++e) { const unsigned long long m0 = __ballot(e0 == e), m1 = __ballot(e1 == e); const int c0 = __popcll(m0), c1 = __popcll(m1);
            int base = 0; if (lane == 0 && (c0 + c1) > 0) base = (int)__hip_atomic_fetch_add(F.ctl + CW_CUR + 64 * li + e, (unsigned)(c0 + c1), RLX_AGENT);
            base = __builtin_amdgcn_readfirstlane(base) + seg[e];
            if (e0 == e) s0 = base + __popcll(m0 & lt); if (e1 == e) s1 = base + c0 + __popcll(m1 & lt); }
        TSLOT[t * 2] = s0; TSLOT[t * 2 + 1] = s1;
        for (int i = 0; i < 64; ++i) { const int sa = __builtin_amdgcn_readlane(s0, i), sb = __builtin_amdgcn_readlane(s1, i); const bf16* src = H + (size_t)(blk * 64 + i) * D;
#pragma unroll
            for (int k = 0; k < 2; ++k) { float hv[8]; ld8(src + k * 512 + lane * 8, hv); v2u w; w.x = pg8::pack4_fp8(hv[0] * 8.f, hv[1] * 8.f, hv[2] * 8.f, hv[3] * 8.f); w.y = pg8::pack4_fp8(hv[4] * 8.f, hv[5] * 8.f, hv[6] * 8.f, hv[7] * 8.f);
                *(v2u*)((unsigned char*)HS + (size_t)sa * D + k * 512 + lane * 8) = w; *(v2u*)((unsigned char*)HS + (size_t)sb * D + k * 512 + lane * 8) = w; } } }
}
typedef float f32x16 __attribute__((ext_vector_type(16)));
typedef short bf16x8v __attribute__((ext_vector_type(8)));
typedef short s16x4 __attribute__((ext_vector_type(4)));
typedef float f32x2v __attribute__((ext_vector_type(2)));
typedef __bf16 bf16x2v __attribute__((ext_vector_type(2)));
#define MFMA32(a, b, c) __builtin_amdgcn_mfma_f32_32x32x16_bf16((a), (b), (c), 0, 0, 0)
__device__ __forceinline__ int crow(int reg, int hh) { return (reg & 3) + 8 * (reg >> 2) + 4 * hh; }
__device__ __forceinline__ unsigned cvtpk(float lo, float hi) { f32x2v v = {lo, hi}; bf16x2v b = __builtin_convertvector(v, bf16x2v); return __builtin_bit_cast(unsigned, b); }
__device__ __forceinline__ bf16x8v pack8(const f32x16& x, int s) { v4u p; p.x = cvtpk(x[8 * s], x[8 * s + 1]); p.y = cvtpk(x[8 * s + 2], x[8 * s + 3]); p.z = cvtpk(x[8 * s + 4], x[8 * s + 5]); p.w = cvtpk(x[8 * s + 6], x[8 * s + 7]); return __builtin_bit_cast(bf16x8v, p); }
__device__ __forceinline__ s16x4 trread(const LAS unsigned char* p) { return __builtin_bit_cast(s16x4, __builtin_amdgcn_ds_read_tr16_b64_v4i16((LAS s16x4*)p)); }
__device__ __forceinline__ bf16x8v vt_frag(const LAS unsigned char* vtile, int VP, int krow0, int dvb, int lane) {
    const int i = lane & 15, q_ = i >> 2, p_ = i & 3, hh = lane >> 5, blk = (lane >> 4) & 1;
    const LAS unsigned char* a = vtile + (krow0 + 4 * hh + q_) * VP + (32 * dvb + 16 * blk + 4 * p_) * 2;
    const s16x4 lo = trread(a), hi = trread(a + 8 * VP);
    return (bf16x8v){lo[0], lo[1], lo[2], lo[3], hi[0], hi[1], hi[2], hi[3]};
}
__device__ __forceinline__ float xhalf_max(float m) { auto rr = __builtin_amdgcn_permlane32_swap(__float_as_uint(m), __float_as_uint(m), false, false); return fmaxf(__uint_as_float(rr[0]), __uint_as_float(rr[1])); }
__device__ __forceinline__ float xhalf_sum(float m) { auto rr = __builtin_amdgcn_permlane32_swap(__float_as_uint(m), __float_as_uint(m), false, false); return __uint_as_float(rr[0]) + __uint_as_float(rr[1]); }
template <int NS>
__device__ __forceinline__ void softmax_pv(f32x16 (&st)[NS], float& m_run, float& l_run, f32x16 (&ot)[2], const LAS unsigned char* vtile, int VP, int krow0, int lane) {
    float mt = st[0][0];
#pragma unroll
    for (int n = 0; n < NS; ++n)
#pragma unroll
        for (int i = 0; i < 16; ++i) mt = fmaxf(mt, st[n][i]);
    mt = xhalf_max(mt);
    if (__any(mt > m_run)) {
        const float m_new = fmaxf(m_run, mt), corr = __builtin_amdgcn_exp2f(m_run - fmaxf(m_new, -1e30f));
        l_run *= corr; m_run = m_new;
#pragma unroll
        for (int d = 0; d < 2; ++d)
#pragma unroll
            for (int i = 0; i < 16; ++i) ot[d][i] *= corr;
    }
    const float m_use = fmaxf(m_run, -1e30f); float ls = 0.f;
#pragma unroll
    for (int n = 0; n < NS; ++n)
#pragma unroll
        for (int i = 0; i < 16; ++i) { st[n][i] = __builtin_amdgcn_exp2f(st[n][i] - m_use); ls += st[n][i]; }
    l_run += ls;
#pragma unroll
    for (int n = 0; n < NS; ++n) { const bf16x8v p0 = pack8(st[n], 0), p1 = pack8(st[n], 1);
#pragma unroll
        for (int d = 0; d < 2; ++d) { ot[d] = MFMA32(vt_frag(vtile, VP, krow0 + 32 * n, d, lane), p0, ot[d]); ot[d] = MFMA32(vt_frag(vtile, VP, krow0 + 32 * n + 16, d, lane), p1, ot[d]); } }
}
__device__ __forceinline__ int queue_pull(Frame& F, gu32* head) {
    __syncthreads();
    if (F.tid == 0) F.MISC[24] = __hip_atomic_fetch_add(head, 1u, RLX_AGENT);
    __syncthreads();
    return (int)F.MISC[24];
}

constexpr int MLA_KP = 208, MLA_VP = 144, MLA_KBYTES = 64 * MLA_KP, MLA_VBYTES = 64 * MLA_VP, MLA_VOFF = 2 * MLA_KBYTES;
__device__ __forceinline__ void mla_unit(Frame& F, int b, int h, int qb) {
    const int lane = F.lane, w = F.wave, tid = F.tid, r = lane & 31, hh = lane >> 5;
    const bf16* QM = (const bf16*)(F.wsp() + WS_QM); const bf16* KM = (const bf16*)(F.wsp() + WS_KM); const bf16* VM = (const bf16*)(F.wsp() + WS_VM); bf16* YC = (bf16*)(F.wsp() + WS_YCAT);
    LAS unsigned char* lds = F.lds + RING_OFF;
    const size_t row0 = (size_t)b * SEQ;
    const int qpos = qb * 256 + 32 * w + r;
    const int qmax_w = qb * 256 + 32 * w + 31, qmin_w = qb * 256 + 32 * w;
    bf16x8v qf[6];
#pragma unroll
    for (int s = 0; s < 6; ++s) qf[s] = *(const bf16x8v*)(QM + (row0 + qpos) * QLD + h * 96 + 16 * s + 8 * hh);
    const int kc0 = tid, kc1 = 512 + tid; const bool k1 = tid < 256;
    const int kr0 = kc0 / 12, kch0 = kc0 % 12, kr1 = kc1 / 12, kch1 = kc1 % 12, vr = tid >> 3, vch = tid & 7;
    const bf16* ksrc0 = KM + (row0 + kr0) * KLD + h * 96 + kch0 * 8; const bf16* ksrc1 = KM + (row0 + kr1) * KLD + h * 96 + kch1 * 8; const bf16* vsrc = VM + (row0 + vr) * VLD + h * 64 + vch * 8;
    const int kdst0 = kr0 * MLA_KP + kch0 * 16, kdst1 = kr1 * MLA_KP + kch1 * 16, vdst = MLA_VOFF + vr * MLA_VP + vch * 16;
    const int NT = (qb + 1) * 4;
    v4u kreg0, kreg1 = (v4u){0u, 0u, 0u, 0u}, vreg;
    kreg0 = *(const v4u*)ksrc0; if (k1) kreg1 = *(const v4u*)ksrc1; vreg = *(const v4u*)vsrc;
    __syncthreads();
    *(LAS v4u*)(lds + kdst0) = kreg0; if (k1) *(LAS v4u*)(lds + kdst1) = kreg1; *(LAS v4u*)(lds + vdst) = vreg;
    __syncthreads();
    float m_run = -INFINITY, l_run = 0.f; f32x16 ot[2];
#pragma unroll
    for (int i = 0; i < 16; ++i) { ot[0][i] = 0.f; ot[1][i] = 0.f; }
    for (int t = 0; t < NT; ++t) {
        const int buf = t & 1;
        if (t + 1 < NT) { const size_t o = (size_t)(t + 1) * 64; kreg0 = *(const v4u*)(ksrc0 + o * KLD); if (k1) kreg1 = *(const v4u*)(ksrc1 + o * KLD); vreg = *(const v4u*)(vsrc + o * VLD); }
        const LAS unsigned char* kt = lds + buf * MLA_KBYTES; const LAS unsigned char* vt = lds + MLA_VOFF + buf * MLA_VBYTES;
        const int kb = 64 * t;
        if (kb <= qmax_w) {
            if (kb + 32 <= qmax_w) {
                f32x16 st[2];
#pragma unroll
                for (int i = 0; i < 16; ++i) { st[0][i] = 0.f; st[1][i] = 0.f; }
#pragma unroll
                for (int s = 0; s < 6; ++s) { const bf16x8v kf0 = *(const LAS bf16x8v*)(kt + r * MLA_KP + (16 * s + 8 * hh) * 2), kf1 = *(const LAS bf16x8v*)(kt + (32 + r) * MLA_KP + (16 * s + 8 * hh) * 2);
                    st[0] = MFMA32(kf0, qf[s], st[0]); st[1] = MFMA32(kf1, qf[s], st[1]); }
                if (kb + 63 > qmin_w) {
#pragma unroll
                    for (int i = 0; i < 16; ++i) { if (kb + crow(i, hh) > qpos) st[0][i] = -INFINITY; if (kb + 32 + crow(i, hh) > qpos) st[1][i] = -INFINITY; } }
                softmax_pv<2>(st, m_run, l_run, ot, vt, MLA_VP, 0, lane);
            } else {
                f32x16 st[1];
#pragma unroll
                for (int i = 0; i < 16; ++i) st[0][i] = 0.f;
#pragma unroll
                for (int s = 0; s < 6; ++s) { const bf16x8v kf0 = *(const LAS bf16x8v*)(kt + r * MLA_KP + (16 * s + 8 * hh) * 2); st[0] = MFMA32(kf0, qf[s], st[0]); }
#pragma unroll
                for (int i = 0; i < 16; ++i) if (kb + crow(i, hh) > qpos) st[0][i] = -INFINITY;
                softmax_pv<1>(st, m_run, l_run, ot, vt, MLA_VP, 0, lane);
            } }
        if (t + 1 < NT) { const int nb = buf ^ 1; *(LAS v4u*)(lds + nb * MLA_KBYTES + kdst0) = kreg0; if (k1) *(LAS v4u*)(lds + nb * MLA_KBYTES + kdst1) = kreg1; *(LAS v4u*)(lds + nb * MLA_VBYTES + vdst) = vreg; }
        __syncthreads();
    }
    const float inv = 1.0f / xhalf_sum(l_run);
    bf16* yp = YC + (row0 + qpos) * D + YO_MLA + h * 64;
#pragma unroll
    for (int d = 0; d < 2; ++d)
#pragma unroll
        for (int g4 = 0; g4 < 4; ++g4) { v2u wv; wv.x = cvtpk(ot[d][4 * g4] * inv, ot[d][4 * g4 + 1] * inv); wv.y = cvtpk(ot[d][4 * g4 + 2] * inv, ot[d][4 * g4 + 3] * inv);
            *(v2u*)(yp + 32 * d + 8 * g4 + 4 * hh) = wv; }
}
constexpr int M3_KBYTES = 12288, M3_VBYTES = 8192, M3_VOFF = 2 * M3_KBYTES;
__device__ __forceinline__ bf16x8v vt_frag3(const LAS unsigned char* vtile, int krow0, int dvb, int lane) {
    const int i = lane & 15, q_ = i >> 2, p_ = i & 3, hh = lane >> 5, blk = (lane >> 4) & 1;
    const LAS unsigned char* a = vtile + ((dvb * 4 + (krow0 >> 4)) << 10) + (4 * hh + q_) * 64 + (16 * blk + 4 * p_) * 2;
    const s16x4 lo = trread(a), hi = trread(a + 512);
    return (bf16x8v){lo[0], lo[1], lo[2], lo[3], hi[0], hi[1], hi[2], hi[3]};
}
__device__ __forceinline__ void mla_unit2(Frame& F, int b, int h, int qb) {
    const int lane = F.lane, w = F.wave, r = lane & 31, hh = lane >> 5;
    const bf16* QM = (const bf16*)(F.wsp() + WS_QM); const bf16* KM = (const bf16*)(F.wsp() + WS_KM); const bf16* VM = (const bf16*)(F.wsp() + WS_VM); bf16* YC = (bf16*)(F.wsp() + WS_YCAT);
    LAS unsigned char* lds = F.lds + RING_OFF;
    const size_t row0 = (size_t)b * SEQ;
    const int qbase = qb * 512 + 64 * w;
    const int qposA = qbase + r, qposB = qbase + 32 + r;
    bf16x8v qf[2][6];
#pragma unroll
    for (int s = 0; s < 6; ++s) { qf[0][s] = *(const bf16x8v*)(QM + (row0 + qposA) * QLD + h * 96 + 16 * s + 8 * hh); qf[1][s] = *(const bf16x8v*)(QM + (row0 + qposB) * QLD + h * 96 + 16 * s + 8 * hh); }
    const int li = lane >> 2, lc = lane & 3; const bool isK = w < 4; const int p0 = 2 * (w & 3);
    const bf16* dbase = isK ? KM + row0 * KLD + h * 96 : VM + row0 * VLD + h * 64;
    const int doff = isK ? (16 * w + li) * KLD + ((lc ^ ((li >> 2) & 3)) << 3) : (16 * (p0 & 3) + li) * VLD + 32 * (p0 >> 2) + 8 * lc;
    const int dsrc_j = isK ? 32 : 16 * VLD, dstep = isK ? 64 * KLD : 64 * VLD, ddst = isK ? 3 * w * 1024 : M3_VOFF + p0 * 1024, dbuf = isK ? M3_KBYTES : M3_VBYTES;
#define M3_DMA(t_, buf_) do { const bf16* s_ = dbase + (doff + (t_) * dstep); const int d_ = ddst + (buf_) * dbuf; \
        __builtin_amdgcn_global_load_lds((const unsigned*)s_, (LAS unsigned*)(lds + d_), 16, 0, 0); __builtin_amdgcn_global_load_lds((const unsigned*)(s_ + dsrc_j), (LAS unsigned*)(lds + d_ + 1024), 16, 0, 0); \
        if (isK) __builtin_amdgcn_global_load_lds((const unsigned*)(s_ + 2 * dsrc_j), (LAS unsigned*)(lds + d_ + 2048), 16, 0, 0); } while (0)
    const int NT = (qb + 1) * 8;
    __syncthreads();
    M3_DMA(0, 0);
    asm volatile("s_waitcnt vmcnt(0)" ::: "memory"); __syncthreads();
    const int kl = r & 15, kx = (kl >> 2) & 3, kbase = ((r >> 4) * 3) * 1024 + kl * 64;
    float m_run[2] = {-INFINITY, -INFINITY}, l_run[2] = {0.f, 0.f}; f32x16 ot[2][2];
#pragma unroll
    for (int i = 0; i < 16; ++i) { ot[0][0][i] = 0.f; ot[0][1][i] = 0.f; ot[1][0][i] = 0.f; ot[1][1][i] = 0.f; }
    for (int t = 0; t < NT; ++t) {
        const int buf = t & 1;
        if (t + 1 < NT) M3_DMA(t + 1, buf ^ 1);
        const LAS unsigned char* kt = lds + buf * M3_KBYTES; const LAS unsigned char* vt = lds + M3_VOFF + buf * M3_VBYTES;
        const int kb = 64 * t;
#pragma unroll
        for (int n = 0; n < 2; ++n) { const int kbn = kb + 32 * n;
            if (kbn <= qbase + 63) {
                f32x16 sa, sb;
#pragma unroll
                for (int i = 0; i < 16; ++i) { sa[i] = 0.f; sb[i] = 0.f; }
#pragma unroll
                for (int s = 0; s < 6; ++s) { const int c = 2 * s + hh; const bf16x8v kf = *(const LAS bf16x8v*)(kt + n * 6144 + kbase + (c >> 2) * 1024 + (((c & 3) ^ kx) << 4)); sa = MFMA32(kf, qf[0][s], sa); sb = MFMA32(kf, qf[1][s], sb); }
                if (kbn + 31 > qbase) {
#pragma unroll
                    for (int i = 0; i < 16; ++i) { const int k0 = kbn + crow(i, hh); if (k0 > qposA) sa[i] = -INFINITY; if (k0 > qposB) sb[i] = -INFINITY; } }
                float mtA = sa[0], mtB = sb[0];
#pragma unroll
                for (int i = 1; i < 16; ++i) { mtA = fmaxf(mtA, sa[i]); mtB = fmaxf(mtB, sb[i]); }
                mtA = xhalf_max(mtA); mtB = xhalf_max(mtB);
                if (__any(mtA > m_run[0] || mtB > m_run[1])) {
                    const float nA = fmaxf(m_run[0], mtA), nB = fmaxf(m_run[1], mtB), cA = __builtin_amdgcn_exp2f(m_run[0] - fmaxf(nA, -1e30f)), cB = __builtin_amdgcn_exp2f(m_run[1] - fmaxf(nB, -1e30f));
                    l_run[0] *= cA; l_run[1] *= cB; m_run[0] = nA; m_run[1] = nB;
#pragma unroll
                    for (int d = 0; d < 2; ++d)
#pragma unroll
                        for (int i = 0; i < 16; ++i) { ot[0][d][i] *= cA; ot[1][d][i] *= cB; } }
                const float muA = fmaxf(m_run[0], -1e30f), muB = fmaxf(m_run[1], -1e30f); float lsA = 0.f, lsB = 0.f;
#pragma unroll
                for (int i = 0; i < 16; ++i) { sa[i] = __builtin_amdgcn_exp2f(sa[i] - muA); lsA += sa[i]; sb[i] = __builtin_amdgcn_exp2f(sb[i] - muB); lsB += sb[i]; }
                l_run[0] += lsA; l_run[1] += lsB;
                const bf16x8v pa0 = pack8(sa, 0), pa1 = pack8(sa, 1), pb0 = pack8(sb, 0), pb1 = pack8(sb, 1);
#pragma unroll
                for (int d = 0; d < 2; ++d) { const bf16x8v v0 = vt_frag3(vt, 32 * n, d, lane), v1 = vt_frag3(vt, 32 * n + 16, d, lane);
                    ot[0][d] = MFMA32(v0, pa0, ot[0][d]); ot[1][d] = MFMA32(v0, pb0, ot[1][d]); ot[0][d] = MFMA32(v1, pa1, ot[0][d]); ot[1][d] = MFMA32(v1, pb1, ot[1][d]); }
            } }
        asm volatile("s_waitcnt vmcnt(0)" ::: "memory"); __syncthreads();
    }
#undef M3_DMA
#pragma unroll
    for (int qi = 0; qi < 2; ++qi) { const float inv = 1.0f / xhalf_sum(l_run[qi]); bf16* yp = YC + (row0 + qbase + 32 * qi + r) * D + YO_MLA + h * 64;
#pragma unroll
        for (int d = 0; d < 2; ++d)
#pragma unroll
            for (int g4 = 0; g4 < 4; ++g4) { v2u wv; wv.x = cvtpk(ot[qi][d][4 * g4] * inv, ot[qi][d][4 * g4 + 1] * inv); wv.y = cvtpk(ot[qi][d][4 * g4 + 2] * inv, ot[qi][d][4 * g4 + 3] * inv);
                *(v2u*)(yp + 32 * d + 8 * g4 + 4 * hh) = wv; } }
}
__device__ __forceinline__ void phase_mla_mfma(Frame& F, int l, int rep) {
    gu32* head = F.ctl + CW_Q + 64 * (4 * l + rep);
    for (;;) { const int idx = queue_pull(F, head); if (idx >= 48 * 8) break; const int qb = 7 - idx / 48, bh = idx % 48; mla_unit2(F, bh / 6, bh % 6, qb); }
}
constexpr int DIL_P = 144, DIL_VOFF = 384 * DIL_P;
struct DilUnit { int b, h, p, rho, u; };
__device__ __forceinline__ bool dil_decode(int idx, DilUnit& d) { if (idx >= 48 * 48) return false; const int bh = idx / 48, wi = idx % 48; d.b = bh / 6; d.h = bh % 6;
    if (wi < 16) { d.p = 0; d.rho = 0; d.u = wi; } else if (wi < 32) { d.p = 1; d.rho = (wi - 16) >> 2; d.u = (wi - 16) & 3; } else { d.p = 2; d.rho = wi - 32; d.u = 0; } return true; }
__device__ __forceinline__ void dil_fetch(Frame& F, const DilUnit& d, v4u (&kv)[6], v4u (&vv)[6]) {
    const bf16* Z = (const bf16*)(F.wsp() + WS_Z); const int rs = (d.p == 0) ? 1 : (d.p == 1) ? 4 : 16; const size_t row0 = (size_t)d.b * SEQ; const int m0 = 256 * d.u - 128;
#pragma unroll
    for (int i = 0; i < 6; ++i) { const int c = F.tid + 512 * i, kk = c >> 3, ch = c & 7, mm = m0 + kk; kv[i] = (v4u){0u, 0u, 0u, 0u}; vv[i] = (v4u){0u, 0u, 0u, 0u};
        if (mm >= 0) { const bf16* src = Z + (row0 + (size_t)mm * rs + d.rho) * ZLD + d.h * 64 + ch * 8; kv[i] = *(const v4u*)(src + ZO_DK); vv[i] = *(const v4u*)(src + ZO_DV); } }
}
__device__ __forceinline__ void dil_compute(Frame& F, const DilUnit& d) {
    const int lane = F.lane, w = F.wave, r = lane & 31, hh = lane >> 5; const int b = d.b, h = d.h, p = d.p, rho = d.rho, u = d.u;
    const int rs = (p == 0) ? 1 : (p == 1) ? 4 : 16;
    const bf16* Z = (const bf16*)(F.wsp() + WS_Z); bf16* DO = (bf16*)(F.wsp() + WS_DILO) + (size_t)p * T * 384; float* DL = (float*)(F.wsp() + WS_DILL) + (size_t)p * T * 6;
    LAS unsigned char* lds = F.lds + RING_OFF;
    const size_t row0 = (size_t)b * SEQ;
    const int m0 = 256 * u - 128;
    const int mq = 256 * u + 32 * w + r; const size_t rowq = row0 + (size_t)mq * rs + rho;
    bf16x8v qf[4];
#pragma unroll
    for (int s = 0; s < 4; ++s) qf[s] = *(const bf16x8v*)(Z + rowq * ZLD + ZO_DQ + h * 64 + 16 * s + 8 * hh);
    float m_run = -INFINITY, l_run = 0.f; f32x16 ot[2];
#pragma unroll
    for (int i = 0; i < 16; ++i) { ot[0][i] = 0.f; ot[1][i] = 0.f; }
#define DIL_QK(ST, KT) do { _Pragma("unroll") for (int i = 0; i < 16; ++i) ST[i] = 0.f; \
        _Pragma("unroll") for (int s = 0; s < 4; ++s) { const bf16x8v kf = *(const LAS bf16x8v*)(lds + (32 * (KT) + r) * DIL_P + (16 * s + 8 * hh) * 2); ST = MFMA32(kf, qf[s], ST); } \
        _Pragma("unroll") for (int i = 0; i < 16; ++i) { const int mk = m0 + 32 * (KT) + crow(i, hh); if (mk < 0 || mk > mq || mk < mq - 128) ST[i] = -INFINITY; } } while (0)
    if (m0 + 32 * w + 31 >= 0) { f32x16 st[2]; DIL_QK(st[0], w); DIL_QK(st[1], w + 1); softmax_pv<2>(st, m_run, l_run, ot, lds + DIL_VOFF, DIL_P, 32 * w, lane); }
    else if (m0 + 32 * (w + 1) + 31 >= 0) { f32x16 st[1]; DIL_QK(st[0], w + 1); softmax_pv<1>(st, m_run, l_run, ot, lds + DIL_VOFF, DIL_P, 32 * (w + 1), lane); }
    if (m0 + 32 * (w + 2) + 31 >= 0) { f32x16 st[2]; DIL_QK(st[0], w + 2); DIL_QK(st[1], w + 3); softmax_pv<2>(st, m_run, l_run, ot, lds + DIL_VOFF, DIL_P, 32 * (w + 2), lane); }
    else if (m0 + 32 * (w + 3) + 31 >= 0) { f32x16 st[1]; DIL_QK(st[0], w + 3); softmax_pv<1>(st, m_run, l_run, ot, lds + DIL_VOFF, DIL_P, 32 * (w + 3), lane); }
    { f32x16 st[1]; DIL_QK(st[0], w + 4); softmax_pv<1>(st, m_run, l_run, ot, lds + DIL_VOFF, DIL_P, 32 * (w + 4), lane); }
#undef DIL_QK
    const float lt = xhalf_sum(l_run), inv = 1.0f / lt;
    bf16* op = DO + rowq * 384 + h * 64;
#pragma unroll
    for (int d = 0; d < 2; ++d)
#pragma unroll
        for (int g4 = 0; g4 < 4; ++g4) { v2u wv; wv.x = cvtpk(ot[d][4 * g4] * inv, ot[d][4 * g4 + 1] * inv); wv.y = cvtpk(ot[d][4 * g4 + 2] * inv, ot[d][4 * g4 + 3] * inv);
            *(v2u*)(op + 32 * d + 8 * g4 + 4 * hh) = wv; }
    if (hh == 0) DL[rowq * 6 + h] = m_run + __builtin_amdgcn_logf(lt);
}
__device__ __forceinline__ void phase_dil_mfma(Frame& F) {
    LAS unsigned char* lds = F.lds + RING_OFF; DilUnit cur, nxt; v4u kv[6], vv[6];
    int idx = (int)blockIdx.x; bool have = dil_decode(idx, cur);
    if (have) dil_fetch(F, cur, kv, vv);
    while (have) {
        __syncthreads();
#pragma unroll
        for (int i = 0; i < 6; ++i) { const int c = F.tid + 512 * i, kk = c >> 3, ch = c & 7; *(LAS v4u*)(lds + kk * DIL_P + ch * 16) = kv[i]; *(LAS v4u*)(lds + DIL_VOFF + kk * DIL_P + ch * 16) = vv[i]; }
        __syncthreads();
        idx += F.G; const bool hn = dil_decode(idx, nxt);
        if (hn) dil_fetch(F, nxt, kv, vv);
        dil_compute(F, cur);
        cur = nxt; have = hn;
    }
}
__device__ __forceinline__ void dil_merge_range(Frame& F, int gt, int NT, int lo, int hi);
__device__ __forceinline__ void phase_dil_merge(Frame& F) { dil_merge_range(F, F.vcu * NTHREADS + F.tid, F.G * NTHREADS, 0, T * 48); }
__device__ __forceinline__ void dil_merge_range(Frame& F, int gt, int NT, int lo, int hi) {
    const bf16* DO = (const bf16*)(F.wsp() + WS_DILO); const float* DL = (const float*)(F.wsp() + WS_DILL); bf16* YC = (bf16*)(F.wsp() + WS_YCAT);
    for (int ix = lo + gt; ix < hi; ix += NT) { const int t = ix / 48, c = ix % 48, h = c >> 3;
        const float l0 = DL[(size_t)t * 6 + h], l1 = DL[(size_t)T * 6 + (size_t)t * 6 + h], l2 = DL[(size_t)2 * T * 6 + (size_t)t * 6 + h];
        const float mx = fmaxf(l0, fmaxf(l1, l2)); float w0 = __builtin_amdgcn_exp2f(l0 - mx), w1 = __builtin_amdgcn_exp2f(l1 - mx), w2 = __builtin_amdgcn_exp2f(l2 - mx); const float inv = 1.0f / (w0 + w1 + w2); w0 *= inv; w1 *= inv; w2 *= inv;
        float a[8], bb[8], cc[8]; ld8(DO + (size_t)t * 384 + c * 8, a); ld8(DO + (size_t)T * 384 + (size_t)t * 384 + c * 8, bb); ld8(DO + (size_t)2 * T * 384 + (size_t)t * 384 + c * 8, cc);
        v4u o; o.x = pk2(w0 * a[0] + w1 * bb[0] + w2 * cc[0], w0 * a[1] + w1 * bb[1] + w2 * cc[1]); o.y = pk2(w0 * a[2] + w1 * bb[2] + w2 * cc[2], w0 * a[3] + w1 * bb[3] + w2 * cc[3]);
        o.z = pk2(w0 * a[4] + w1 * bb[4] + w2 * cc[4], w0 * a[5] + w1 * bb[5] + w2 * cc[5]); o.w = pk2(w0 * a[6] + w1 * bb[6] + w2 * cc[6], w0 * a[7] + w1 * bb[7] + w2 * cc[7]);
        *(v4u*)(YC + (size_t)t * D + YO_DIL + c * 8) = o; }
}

__device__ __forceinline__ bf16x8v tr_frag_nat(const LAS unsigned char* tile, int P, int krow0, int colblk, int lane) {
    const int i = lane & 15, q_ = i >> 2, p_ = i & 3, hh = lane >> 5, blk = (lane >> 4) & 1;
    const LAS unsigned char* a = tile + (krow0 + 8 * hh + q_) * P + (32 * colblk + 16 * blk + 4 * p_) * 2;
    const s16x4 lo = trread(a), hi = trread(a + 4 * P);
    return (bf16x8v){lo[0], lo[1], lo[2], lo[3], hi[0], hi[1], hi[2], hi[3]};
}
__device__ __forceinline__ float ret_lg2(int h) { return __builtin_amdgcn_logf(1.0f - __builtin_amdgcn_exp2f(-5.0f - (float)h)); }
constexpr int RET_P = 144, RET_VOFF = 256 * RET_P, RET_SOFF = 2 * 256 * RET_P, RET_SBYTES = 64 * RET_P;
__device__ __forceinline__ void ret_state_unit(Frame& F, int b, int h, int cp) {
    const int lane = F.lane, w = F.wave, tid = F.tid, r = lane & 31, hh = lane >> 5;
    const bf16* Z = (const bf16*)(F.wsp() + WS_Z); float* KVS = (float*)(F.wsp() + WS_KVS);
    LAS unsigned char* lds = F.lds + RING_OFF; const size_t row0 = (size_t)b * SEQ + 256 * cp; const float lg2 = ret_lg2(h);
    __syncthreads();
#pragma unroll
    for (int i = 0; i < 4; ++i) { const int c = tid + 512 * i, kk = c >> 3, ch = c & 7; const bf16* src = Z + (row0 + kk) * ZLD + h * 64 + ch * 8;
        float kf[8]; ld8(src + ZO_RK, kf); const float sc = 0.125f * __builtin_amdgcn_exp2f((float)(127 - (kk & 127)) * lg2);
        v4u kv; kv.x = cvtpk(kf[0] * sc, kf[1] * sc); kv.y = cvtpk(kf[2] * sc, kf[3] * sc); kv.z = cvtpk(kf[4] * sc, kf[5] * sc); kv.w = cvtpk(kf[6] * sc, kf[7] * sc);
        *(LAS v4u*)(lds + kk * RET_P + ch * 16) = kv; *(LAS v4u*)(lds + RET_VOFF + kk * RET_P + ch * 16) = *(const v4u*)(src + ZO_RV); }
    __syncthreads();
    const int ci = w >> 2, dvb = (w >> 1) & 1, dkb = w & 1;
    f32x16 acc;
#pragma unroll
    for (int i = 0; i < 16; ++i) acc[i] = 0.f;
#pragma unroll
    for (int ks = 0; ks < 8; ++ks) { const int k0 = 128 * ci + 16 * ks; acc = MFMA32(tr_frag_nat(lds + RET_VOFF, RET_P, k0, dvb, lane), tr_frag_nat(lds, RET_P, k0, dkb, lane), acc); }
    float* dst = KVS + ((size_t)((b * 4 + h) * 32 + 2 * cp + ci)) * 4096;
#pragma unroll
    for (int i = 0; i < 16; ++i) dst[(32 * dvb + crow(i, hh)) * 64 + 32 * dkb + r] = acc[i];
}
__device__ __forceinline__ void phase_ret_state(Frame& F) {
    for (int idx = (int)blockIdx.x; idx < 32 * 16; idx += F.G) { const int bh = idx >> 4, cp = idx & 15; ret_state_unit(F, bh >> 2, bh & 3, cp); }
}
__device__ __forceinline__ void ret_out_unit(Frame& F, int l, int b, int h, int cp) {
    const int lane = F.lane, w = F.wave, tid = F.tid, r = lane & 31, hh = lane >> 5;
    const bf16* Z = (const bf16*)(F.wsp() + WS_Z); const float* KVS = (const float*)(F.wsp() + WS_KVS); bf16* YC = (bf16*)(F.wsp() + WS_YCAT); const float* gn = F.in(4) + l * 256 + h * 64;
    LAS unsigned char* lds = F.lds + RING_OFF; const size_t row0 = (size_t)b * SEQ + 256 * cp; const float lg2 = ret_lg2(h);
    const int ci = w >> 2, wi = w & 3, c = 2 * cp + ci;
    __syncthreads();
#pragma unroll
    for (int i = 0; i < 4; ++i) { const int cc = tid + 512 * i, kk = cc >> 3, ch = cc & 7; const bf16* src = Z + (row0 + kk) * ZLD + h * 64 + ch * 8;
        *(LAS v4u*)(lds + kk * RET_P + ch * 16) = *(const v4u*)(src + ZO_RK); *(LAS v4u*)(lds + RET_VOFF + kk * RET_P + ch * 16) = *(const v4u*)(src + ZO_RV); }
    {
        const int tl = tid & 255; const float dec = __builtin_amdgcn_exp2f(128.0f * lg2); const float* base = KVS + (size_t)((b * 4 + h) * 32) * 4096 + tl * 4;
        f32x4 a[4];
#pragma unroll
        for (int k = 0; k < 4; ++k) a[k] = (f32x4){0.f, 0.f, 0.f, 0.f};
        for (int m = 0; m < c; ++m) {
#pragma unroll
            for (int k = 0; k < 4; ++k) a[k] = a[k] * dec + *(const f32x4*)(base + (size_t)m * 4096 + 1024 * k); }
#pragma unroll
        for (int k = 0; k < 4; ++k) { const int e = tl * 4 + 1024 * k, dv = e >> 6, dk = e & 63; v2u wv; wv.x = cvtpk(a[k].x, a[k].y); wv.y = cvtpk(a[k].z, a[k].w);
            *(LAS v2u*)(lds + RET_SOFF + ci * RET_SBYTES + dv * RET_P + dk * 2) = wv; }
    }
    const int iq = 32 * wi + r; const size_t rowq = row0 + 128 * ci + iq;
    bf16x8v qf[4];
#pragma unroll
    for (int s = 0; s < 4; ++s) qf[s] = *(const bf16x8v*)(Z + rowq * ZLD + ZO_RQ + h * 64 + 16 * s + 8 * hh);
    __syncthreads();
    f32x16 ot[2], oc[2];
#pragma unroll
    for (int i = 0; i < 16; ++i) { ot[0][i] = 0.f; ot[1][i] = 0.f; oc[0][i] = 0.f; oc[1][i] = 0.f; }
    for (int kt = 0; kt <= wi; ++kt) { const int krow = 128 * ci + 32 * kt;
        f32x16 st;
#pragma unroll
        for (int i = 0; i < 16; ++i) st[i] = 0.f;
#pragma unroll
        for (int s = 0; s < 4; ++s) { const bf16x8v kf = *(const LAS bf16x8v*)(lds + (krow + r) * RET_P + (16 * s + 8 * hh) * 2); st = MFMA32(kf, qf[s], st); }
#pragma unroll
        for (int i = 0; i < 16; ++i) { const int dj = iq - (32 * kt + crow(i, hh)); st[i] = (dj >= 0) ? st[i] * 0.125f * __builtin_amdgcn_exp2f((float)dj * lg2) : 0.f; }
        const bf16x8v p0 = pack8(st, 0), p1 = pack8(st, 1);
#pragma unroll
        for (int d = 0; d < 2; ++d) { ot[d] = MFMA32(vt_frag(lds + RET_VOFF, RET_P, krow, d, lane), p0, ot[d]); ot[d] = MFMA32(vt_frag(lds + RET_VOFF, RET_P, krow + 16, d, lane), p1, ot[d]); }
    }
    const LAS unsigned char* sT = lds + RET_SOFF + ci * RET_SBYTES;
#pragma unroll
    for (int d = 0; d < 2; ++d)
#pragma unroll
        for (int s = 0; s < 4; ++s) { const bf16x8v sf = *(const LAS bf16x8v*)(sT + (32 * d + r) * RET_P + (16 * s + 8 * hh) * 2); oc[d] = MFMA32(sf, qf[s], oc[d]); }
    const float xi = __builtin_amdgcn_exp2f((float)(iq + 1) * lg2);
    float sum = 0.f;
#pragma unroll
    for (int d = 0; d < 2; ++d)
#pragma unroll
        for (int i = 0; i < 16; ++i) { ot[d][i] += oc[d][i] * xi; sum += ot[d][i]; }
    const float mu = xhalf_sum(sum) * (1.0f / 64.0f); float sq = 0.f;
#pragma unroll
    for (int d = 0; d < 2; ++d)
#pragma unroll
        for (int i = 0; i < 16; ++i) { const float dd = ot[d][i] - mu; sq += dd * dd; }
    const float rstd = 1.0f / sqrtf(xhalf_sum(sq) * (1.0f / 64.0f) + LN_EPS);
    const bf16* gp = Z + rowq * ZLD + ZO_RG + h * 64; bf16* yp = YC + rowq * D + YO_RET + h * 64;
#pragma unroll
    for (int d = 0; d < 2; ++d)
#pragma unroll
        for (int g4 = 0; g4 < 4; ++g4) { const int dv = 32 * d + 8 * g4 + 4 * hh; const v2u gw = *(const v2u*)(gp + dv); const f32x4 gg = *(const f32x4*)(gn + dv);
            const float o0 = fsilu(bflo(gw.x)) * ((ot[d][4 * g4] - mu) * rstd * gg.x), o1 = fsilu(bfhi(gw.x)) * ((ot[d][4 * g4 + 1] - mu) * rstd * gg.y), o2 = fsilu(bflo(gw.y)) * ((ot[d][4 * g4 + 2] - mu) * rstd * gg.z), o3 = fsilu(bfhi(gw.y)) * ((ot[d][4 * g4 + 3] - mu) * rstd * gg.w);
            v2u wv; wv.x = cvtpk(o0, o1); wv.y = cvtpk(o2, o3); *(v2u*)(yp + dv) = wv; }
}
__device__ __forceinline__ void phase_ret_out(Frame& F, int l) {
    for (int idx = (int)blockIdx.x; idx < 32 * 16; idx += F.G) { const int bh = idx >> 4, cp = idx & 15; ret_out_unit(F, l, bh >> 2, bh & 3, cp); }
}

constexpr int P4_NMLA = 48 * 8, P4_NRET = 32 * 16, P4_NMRG = 256;
__device__ __forceinline__ void phase_p4(Frame& F, int l, int rep) {
    gu32* head = F.ctl + CW_Q + 64 * (4 * l + rep);
    for (;;) { const int idx = queue_pull(F, head); F.refresh();
        if (idx < P4_NMLA) { const int qb = 7 - idx / 48, bh = idx % 48; mla_unit2(F, bh / 6, bh % 6, qb); }
        else if (idx < P4_NMLA + P4_NRET) { const int j = idx - P4_NMLA, bh = j >> 4, cp = j & 15; ret_out_unit(F, l, bh >> 2, bh & 3, cp); }
        else if (idx < P4_NMLA + P4_NRET + P4_NMRG) { const int j = idx - P4_NMLA - P4_NRET; dil_merge_range(F, F.tid, NTHREADS, j * (T * 48 / P4_NMRG), (j + 1) * (T * 48 / P4_NMRG)); }
        else break; }
}
#ifndef MK_PER_PHASE
#define MK_PER_PHASE 0
#endif
constexpr int NPHASES = 36;
#ifndef PROBE
#define PROBE 0
#endif
#define REP(k) for (int rep_ = 0; rep_ < ((PROBE == (k)) ? 2 : 1); ++rep_)
struct Args { const float* in[23]; float* out; unsigned char* ws; int ph_lo, ph_hi; };
static_assert(sizeof(Args) == 23 * 8 + 8 + 8 + 8, "no padding");

__global__ void __launch_bounds__(NTHREADS, 2) mk_fwd(Args args) {
    extern __shared__ __attribute__((aligned(16))) unsigned char lds[];
    Frame F;
    F.lds = (LAS unsigned char*)lds; F.MISC = (volatile LAS unsigned*)(F.lds + MISC_OFF);
    F.tid = threadIdx.x; F.lane = F.tid & 63; F.wave = __builtin_amdgcn_readfirstlane(F.tid >> 6); F.wave_s = F.wave;
    F.G = gridDim.x; { const int bx = blockIdx.x; F.vcu = (F.G % 8 == 0) ? (bx % 8) * (F.G / 8) + bx / 8 : bx; }
    F.ctl = (gu32*)(args.ws + WS_CTL);
    for (int u = F.tid; u < (LDS_BYTES - LDSCTL_OFF) / 4; u += NTHREADS) ((LAS unsigned*)(F.lds + LDSCTL_OFF))[u] = 0u;
    __syncthreads();
    if (F.tid == 0) { LAS unsigned long long* pt = (LAS unsigned long long*)(F.lds + PTAB_OFF);
#pragma unroll
        for (int i = 0; i < 23; ++i) pt[i] = (unsigned long long)args.in[i];
        pt[23] = (unsigned long long)args.out; pt[24] = (unsigned long long)args.ws; }
    __syncthreads();
    XcdBarrier bar = xcd_barrier_post((unsigned*)(F.ctl + CW_BAR), F.MISC + 8);
    int pc = 0;
#define PH_ON() (args.ph_lo <= pc && pc < args.ph_hi && (F.refresh(), true))
#define PH_END() do { if (args.ph_lo <= pc && pc + 1 < args.ph_hi) xcd_barrier(bar); ++pc; } while (0)
#define WSB(T_, off) ((T_*)(F.wsp() + (off)))
    if (PH_ON()) { phase_mod_tab(F); phase_convert(F, 0); } PH_END();
    if (PH_ON()) { phase_modulate0(F); } PH_END();
    if (PROBE == 20) { for (int i = 0; i < 40; ++i) xcd_barrier(bar); }
    for (int l = 0; l < NL; ++l) {
        const bool moe = (l & 1) != 0; const int li = l >> 1;
        if (PH_ON()) REP(1) { pg8::Gemm g{WSB(bf16, WS_H), WSB(bf16, WS_WIN), D, D, D, 0, 0}; pg8::StaticOrder S; S.init(T, ZLD, F.G, (int)blockIdx.x); pg8::EpiZ E{WSB(bf16, WS_Z), WSB(bf16, WS_KM), WSB(const float, WS_TAB), WSB(float, WS_RSP), ZLD, 0.125f * LOG2E};
            pg8::gemm_phase<pg8::EpiZ, pg8::StaticOrder, true>(F.lds + RING_OFF, g, S, E, F.tid); } PH_END();
        if (PH_ON()) {
            REP(2) { pg8::Gemm g{WSB(bf16, WS_Z) + ZO_CQ, WSB(bf16, WS_WUQ), ZLD, QRANK, QRANK, 0, 0}; pg8::StaticOrder S; S.init(T, 768, F.G, (int)blockIdx.x); pg8::EpiMlaQ E{WSB(bf16, WS_QM), WSB(const float, WS_RSP), WSB(const float, WS_TAB), MLA_QSCALE, 0};
              pg8::gemm_phase<pg8::EpiMlaQ, pg8::StaticOrder, true>(F.lds + RING_OFF, g, S, E, F.tid); }
            REP(2) { pg8::Gemm g{WSB(bf16, WS_Z) + ZO_CKV, WSB(bf16, WS_WUKV), ZLD, KVRANK, KVRANK, 0, 0}; pg8::StaticOrder S; S.init(T, 768, F.G, F.G - 1 - (int)blockIdx.x); pg8::EpiMlaKV E{WSB(bf16, WS_KM), WSB(bf16, WS_VM), WSB(const float, WS_RSP)};
              pg8::gemm_phase<pg8::EpiMlaKV, pg8::StaticOrder, true>(F.lds + RING_OFF, g, S, E, F.tid); }
            REP(3) phase_dil_mfma(F); REP(4) phase_ret_state(F);
        } PH_END();
        if (PH_ON()) { REP(7) phase_p4(F, l, rep_); } PH_END();
        if (PH_ON()) REP(8) { pg8::Gemm g{WSB(bf16, WS_YCAT), WSB(bf16, WS_WOUT), D, D, D, 0, 0}; pg8::StaticOrder S; S.init(T, D, F.G, (int)blockIdx.x); pg8::EpiBf16 E{WSB(bf16, WS_Y), D, D};
            pg8::gemm_phase<pg8::EpiBf16, pg8::StaticOrder, true>(F.lds + RING_OFF, g, S, E, F.tid); } PH_END();
        if (PH_ON()) { if (PROBE == 21) phase_ln<false>(F, l == 0 ? F.in(0) : (const float*)nullptr, WSB(float, WS_END), WSB(const float, WS_MOD) + (size_t)l * NB * 6 * D + 2 * D, F.in(12) + l * D, F.in(13) + l * D, WSB(const float, WS_MOD) + (size_t)l * NB * 6 * D, 3 * D, 4 * D, nullptr, li);
            phase_ln<false>(F, l == 0 ? F.in(0) : (const float*)nullptr, (float*)nullptr, WSB(const float, WS_MOD) + (size_t)l * NB * 6 * D + 2 * D, F.in(12) + l * D, F.in(13) + l * D, WSB(const float, WS_MOD) + (size_t)l * NB * 6 * D, 3 * D, 4 * D, moe ? F.in(19) + (size_t)li * D * NEXP : nullptr, li); } PH_END();

        if (!moe) {
            if (PH_ON()) REP(9) { pg8::Gemm g{WSB(bf16, WS_H), WSB(bf16, WS_WFF), D, D, D, 0, 0}; pg8::StaticOrder S; S.init(T, 2 * DFF, F.G, (int)blockIdx.x); pg8::EpiSwiglu E{WSB(bf16, WS_FF), DFF};
                pg8::gemm_phase<pg8::EpiSwiglu, pg8::StaticOrder, true>(F.lds + RING_OFF, g, S, E, F.tid); } PH_END();
            if (PH_ON()) REP(10) { pg8::Gemm g{WSB(bf16, WS_FF), WSB(const bf16, WS_WFF + WFF_W2_OFF_DENSE), DFF, DFF, DFF, 0, 0}; pg8::StaticOrder S; S.init(T, D, F.G, (int)blockIdx.x); pg8::EpiBf16 E{WSB(bf16, WS_Y), D, D};
                pg8::gemm_phase<pg8::EpiBf16, pg8::StaticOrder, true>(F.lds + RING_OFF, g, S, E, F.tid); } PH_END();
            if (PH_ON()) { if (PROBE == 22) phase_ln<false>(F, (const float*)nullptr, WSB(float, WS_END), WSB(const float, WS_MOD) + (size_t)l * NB * 6 * D + 5 * D, F.in(14) + l * D, F.in(15) + l * D, (l + 1 < NL) ? WSB(const float, WS_MOD) + (size_t)(l + 1) * NB * 6 * D : nullptr, 0, D, nullptr, 0);
                phase_ln<false>(F, (const float*)nullptr, (float*)nullptr, WSB(const float, WS_MOD) + (size_t)l * NB * 6 * D + 5 * D, F.in(14) + l * D, F.in(15) + l * D, (l + 1 < NL) ? WSB(const float, WS_MOD) + (size_t)(l + 1) * NB * 6 * D : nullptr, 0, D, nullptr, 0);  if (l + 1 < NL) { F.refresh(); phase_convert(F, l + 1); } } PH_END();
        } else {
            if (PH_ON()) { phase_moe_assign(F, li); } PH_END();
            if (PH_ON()) REP(11) { pg8::Gemm g{WSB(bf16, WS_Y), WSB(bf16, WS_WFF), D / 2, D / 2, D / 2, 0, (long)2 * DFFE * D / 2}; pg8::GroupedOrder S; S.init(WSB(const int, WS_SEG), 2 * DFFE / 256, F.G, (int)blockIdx.x); pg8::EpiSwiglu8 E{WSB(unsigned char, WS_FF), DFFE, 1.0f / 512.0f};
                pg8::gemm_phase<pg8::EpiSwiglu8, pg8::GroupedOrder, true, 1>(F.lds + RING_OFF, g, S, E, F.tid); } PH_END();
            if (PH_ON()) REP(12) { pg8::Gemm g{WSB(bf16, WS_FF), WSB(const bf16, WS_WFF + WFF_W2_OFF_MOE8), DFFE / 2, DFFE / 2, DFFE / 2, 0, (long)D * DFFE / 2}; pg8::GroupedOrder S; S.init(WSB(const int, WS_SEG), D / 256, F.G, (int)blockIdx.x); pg8::EpiBf16S E{WSB(bf16, WS_Y), D, 1.0f / 256.0f};
                pg8::gemm_phase<pg8::EpiBf16S, pg8::GroupedOrder, true, 1>(F.lds + RING_OFF, g, S, E, F.tid); } PH_END();
            if (PH_ON()) { phase_ln<true>(F, (const float*)nullptr, (l + 1 < NL) ? (float*)nullptr : F.outp(), WSB(const float, WS_MOD) + (size_t)l * NB * 6 * D + 5 * D, F.in(14) + l * D, F.in(15) + l * D, (l + 1 < NL) ? WSB(const float, WS_MOD) + (size_t)(l + 1) * NB * 6 * D : nullptr, 0, D, nullptr, 0);  if (l + 1 < NL) { F.refresh(); phase_convert(F, l + 1); } } PH_END();
        }
    }
#undef PH_ON
#undef PH_END
}

extern "C" void kernel_launch(void* const* d_in, const int* in_sizes, int n_in, void* d_out, int out_size, void* d_ws, size_t ws_size, hipStream_t stream) {
    static int grid = 0;
    if (grid == 0) {
        if (n_in != 23 || out_size != T * D || ws_size < WS_END) { fprintf(stderr, "kernel_launch: unexpected shapes (n_in %d out %d ws %zu)\n", n_in, out_size, ws_size); grid = -1; return; }
        int dev = 0, cus = 0, per_cu = 0;
        if (hipGetDevice(&dev) != hipSuccess || hipDeviceGetAttribute(&cus, hipDeviceAttributeMultiprocessorCount, dev) != hipSuccess) { grid = -1; return; }
        if (hipFuncSetAttribute((const void*)mk_fwd, hipFuncAttributeMaxDynamicSharedMemorySize, LDS_BYTES) != hipSuccess) { fprintf(stderr, "kernel_launch: hipFuncSetAttribute failed\n"); grid = -1; return; }
        if (hipOccupancyMaxActiveBlocksPerMultiprocessor(&per_cu, (const void*)mk_fwd, NTHREADS, LDS_BYTES) != hipSuccess || per_cu < 1) fprintf(stderr, "kernel_launch: occupancy query reports %d\n", per_cu);
        (void)hipGetLastError();
        grid = cus;
    }
    if (grid < 0) return;
    if (hipMemsetAsync((char*)d_ws + WS_CTL, 0, CTL_ZERO_BYTES, stream) != hipSuccess) return;
    Args a{};
    for (int i = 0; i < 23; ++i) a.in[i] = (const float*)d_in[i];
    a.out = (float*)d_out; a.ws = (unsigned char*)d_ws;
#if MK_PER_PHASE
    for (int p = 0; p < NPHASES; ++p) { a.ph_lo = p; a.ph_hi = p + 1; hipLaunchKernelGGL(mk_fwd, dim3(grid), dim3(NTHREADS), LDS_BYTES, stream, a); }
#else
    a.ph_lo = 0; a.ph_hi = NPHASES; hipLaunchKernelGGL(mk_fwd, dim3(grid), dim3(NTHREADS), LDS_BYTES, stream, a);
#endif
}
```

```cpp
#include <hip/hip_runtime.h>
#include <cstdio>
#include <cstdint>

namespace pg8 {
#define PG8_LAS __attribute__((address_space(3)))
typedef unsigned short bf16_t;
typedef short bf16x8 __attribute__((ext_vector_type(8)));
typedef float f32x4 __attribute__((ext_vector_type(4)));
typedef unsigned u32x4 __attribute__((ext_vector_type(4)));
typedef unsigned u32x2 __attribute__((ext_vector_type(2)));
typedef int i32x4 __attribute__((ext_vector_type(4)));
typedef int i32x8 __attribute__((ext_vector_type(8)));
constexpr int BM = 256, BK = 64, HALF = 128, HTB = HALF * BK * 2, STAGE_BYTES = 8 * HTB, NXCD = 8, WGM = 8;

__host__ __device__ __forceinline__ int lds_byte(int r, int c) { const int st = (r >> 4) * 2 + (c >> 5), rr = r & 15, cc = c & 31, ob = rr * 64 + cc * 2; return st * 1024 + (ob ^ (((ob >> 9) & 1) << 5)); }
__host__ __device__ __forceinline__ void stage_rc(int b, int& R, int& C) { const int st = b / 1024, sb = b % 1024, swz = sb ^ (((sb >> 9) & 1) << 5); R = (st >> 1) * 16 + swz / 64; C = (st & 1) * 32 + (swz % 64) / 2; }
__host__ __device__ __forceinline__ int perm32(int rho) { const int n = rho >> 4, i = rho & 15; return 8 * (i >> 2) + 4 * n + (i & 3); }

struct Unit { int pm, pn, g; };
struct Gemm { const bf16_t* A; const bf16_t* Bt; int lda, ldb, K; int pad; long gstride; };

struct StaticOrder {
    int nM, nN, nwg, G, c;
    __device__ void init(int M, int N, int G_, int c_) { nM = M / BM; nN = N / BM; nwg = nM * nN; G = G_; c = c_; }
    __device__ bool next(int i, Unit& u) const {
        const long L = (long)i * G + c; if (L >= nwg) return false;
        int wgid = (int)L; { const int q = nwg / NXCD, r = nwg % NXCD, xcd = wgid % NXCD, off = wgid / NXCD; wgid = (xcd < r ? xcd * (q + 1) : r * (q + 1) + (xcd - r) * q) + off; }
        const int nig = WGM * nN, gid = wgid / nig, fm = gid * WGM, gsz = (nM - fm) < WGM ? (nM - fm) : WGM;
        u.pm = fm + ((wgid % nig) % gsz); u.pn = (wgid % nig) / gsz; u.g = 0; return true;
    }
};
struct GroupedOrder {
    int tp[9]; int nN, nwg, G, c;
    __device__ void init(const int* seg, int nN_, int G_, int c_) {
#pragma unroll
        for (int k = 0; k < 9; ++k) tp[k] = __builtin_amdgcn_readfirstlane(seg[k]) / BM;
        nN = nN_; nwg = tp[8] * nN; G = G_; c = c_; }
    __device__ bool next(int i, Unit& u) const {
        const long L = (long)i * G + c; if (L >= nwg) return false;
        const int wgid = (int)L, nM = tp[8];
        const int nig = WGM * nN, gid = wgid / nig, fm = gid * WGM, gsz = (nM - fm) < WGM ? (nM - fm) : WGM;
        u.pm = fm + ((wgid % nig) % gsz); u.pn = (wgid % nig) / gsz; int e = 0;
#pragma unroll
        for (int k = 1; k < 8; ++k) e += (u.pm >= tp[k]) ? 1 : 0;
        u.g = e; return true;
    }
};

__device__ __forceinline__ unsigned cvt_pk_bf16(float lo, float hi) { unsigned r; asm volatile("v_cvt_pk_bf16_f32 %0, %1, %2" : "=v"(r) : "v"(lo), "v"(hi)); return r; }

struct EpiBf16 {
    static constexpr bool PERM = true;
    bf16_t* O; int ldc; int ncols;
    __device__ __forceinline__ void operator()(const f32x4 (&acc)[2][2][4][2], const Unit& u, int wr, int wc, int fr, int fq) const {
        const int row0 = u.pm * BM + wr * 64 + fr; const int col0 = u.pn * BM + wc * 32 + 8 * fq;
#pragma unroll
        for (int ai = 0; ai < 2; ++ai)
#pragma unroll
            for (int m = 0; m < 4; ++m) { bf16_t* rowp = O + (size_t)(row0 + ai * HALF + m * 16) * ldc + col0;
#pragma unroll
                for (int bj = 0; bj < 2; ++bj) { if (col0 + bj * HALF >= ncols) continue; const f32x4 v0 = acc[ai][bj][m][0], v1 = acc[ai][bj][m][1];
                    u32x4 w; w.x = cvt_pk_bf16(v0[0], v0[1]); w.y = cvt_pk_bf16(v0[2], v0[3]); w.z = cvt_pk_bf16(v1[0], v1[1]); w.w = cvt_pk_bf16(v1[2], v1[3]);
                    *(u32x4*)(rowp + bj * HALF) = w; } }
    }
};
struct EpiBf16S {
    static constexpr bool PERM = true;
    bf16_t* O; int ldc; float scale;
    __device__ __forceinline__ void operator()(const f32x4 (&acc)[2][2][4][2], const Unit& u, int wr, int wc, int fr, int fq) const {
        const int row0 = u.pm * BM + wr * 64 + fr; const int col0 = u.pn * BM + wc * 32 + 8 * fq;
#pragma unroll
        for (int ai = 0; ai < 2; ++ai)
#pragma unroll
            for (int m = 0; m < 4; ++m) { bf16_t* rowp = O + (size_t)(row0 + ai * HALF + m * 16) * ldc + col0;
#pragma unroll
                for (int bj = 0; bj < 2; ++bj) { const f32x4 v0 = acc[ai][bj][m][0] * scale, v1 = acc[ai][bj][m][1] * scale;
                    u32x4 w; w.x = cvt_pk_bf16(v0[0], v0[1]); w.y = cvt_pk_bf16(v0[2], v0[3]); w.z = cvt_pk_bf16(v1[0], v1[1]); w.w = cvt_pk_bf16(v1[2], v1[3]);
                    *(u32x4*)(rowp + bj * HALF) = w; } }
    }
};
struct EpiSwiglu {
    static constexpr bool PERM = false;
    bf16_t* O; int ldc;
    __device__ __forceinline__ void operator()(const f32x4 (&acc)[2][2][4][2], const Unit& u, int wr, int wc, int fr, int fq) const {
        const int row0 = u.pm * BM + wr * 64 + fr; const int col0 = u.pn * 128 + wc * 16 + 4 * fq;
#pragma unroll
        for (int ai = 0; ai < 2; ++ai)
#pragma unroll
            for (int m = 0; m < 4; ++m) { bf16_t* rowp = O + (size_t)(row0 + ai * HALF + m * 16) * ldc + col0;
#pragma unroll
                for (int bj = 0; bj < 2; ++bj) { const f32x4 a1 = acc[ai][bj][m][0], a3 = acc[ai][bj][m][1]; float o[4];
#pragma unroll
                    for (int j = 0; j < 4; ++j) o[j] = a1[j] * __builtin_amdgcn_rcpf(1.0f + __builtin_amdgcn_exp2f(-1.4426950408889634f * a1[j])) * a3[j];
                    u32x2 w; w.x = cvt_pk_bf16(o[0], o[1]); w.y = cvt_pk_bf16(o[2], o[3]); *(u32x2*)(rowp + bj * 64) = w; } }
    }
};
__device__ __forceinline__ unsigned pack4_fp8(float a, float b, float c, float d) { int p = 0; p = __builtin_amdgcn_cvt_pk_fp8_f32(a, b, p, false); p = __builtin_amdgcn_cvt_pk_fp8_f32(c, d, p, true); return (unsigned)p; }
struct EpiSwiglu8 {
    static constexpr bool PERM = false;
    unsigned char* O; int ldc; float scale;
    __device__ __forceinline__ void operator()(const f32x4 (&acc)[2][2][4][2], const Unit& u, int wr, int wc, int fr, int fq) const {
        const int row0 = u.pm * BM + wr * 64 + fr; const int col0 = u.pn * 128 + wc * 16 + 4 * fq;
#pragma unroll
        for (int ai = 0; ai < 2; ++ai)
#pragma unroll
            for (int m = 0; m < 4; ++m) { unsigned char* rowp = O + (size_t)(row0 + ai * HALF + m * 16) * ldc + col0;
#pragma unroll
                for (int bj = 0; bj < 2; ++bj) { const f32x4 a1 = acc[ai][bj][m][0] * scale, a3 = acc[ai][bj][m][1] * scale; float o[4];
#pragma unroll
                    for (int j = 0; j < 4; ++j) { const float v = a1[j] * __builtin_amdgcn_rcpf(1.0f + __builtin_amdgcn_exp2f(-1.4426950408889634f * a1[j])) * a3[j] * 4.0f; o[j] = __builtin_amdgcn_fmed3f(v, -448.0f, 448.0f); }
                    *(unsigned*)(rowp + bj * 64) = pack4_fp8(o[0], o[1], o[2], o[3]); } }
    }
};

__device__ __forceinline__ float swz_xor16(float v) { return __builtin_bit_cast(float, __builtin_amdgcn_ds_swizzle(__builtin_bit_cast(int, v), 0x401F)); }
__device__ __forceinline__ float other_half(float v) { auto rr = __builtin_amdgcn_permlane32_swap(__builtin_bit_cast(unsigned, v), __builtin_bit_cast(unsigned, v), false, false); return __builtin_bit_cast(float, rr[0]) + __builtin_bit_cast(float, rr[1]); }

__host__ __device__ __forceinline__ int zmap(int nl) {
    const int tile = nl >> 8, w = nl & 255;
    if (tile == 0 || tile == 1 || (tile >= 4 && tile <= 6)) { const int hb = w >> 6, il = w & 63, nn = il >> 5, rem = il & 31, a = rem >> 4, i = rem & 15; return (tile << 8) + hb * 64 + 32 * a + 16 * nn + i; }
    if (tile == 11) return nl;
    const int g32 = w >> 5, lg = w & 31, n = (lg >> 2) & 1, i = 4 * (lg >> 3) + (lg & 3); return (tile << 8) + g32 * 32 + 16 * n + i;
}
struct EpiZ {
    static constexpr bool PERM = false;
    bf16_t* Z; bf16_t* Km; const float* tab; float* rsp; int zld; float qscale;
    __device__ __forceinline__ void operator()(const f32x4 (&acc)[2][2][4][2], const Unit& u, int wr, int wc, int fr, int fq) const {
        const int pn = u.pn, row0 = u.pm * BM + wr * 64 + fr;
        if (pn <= 1 || (pn >= 4 && pn <= 6)) {
#pragma unroll
            for (int bj = 0; bj < 2; ++bj) { const int headbase = pn * BM + bj * HALF + (wc >> 1) * 64, il = 16 * (wc & 1) + 4 * fq; const float qs = (headbase >= 1024 && headbase < 1408) ? qscale : 1.0f;
#pragma unroll
                for (int ai = 0; ai < 2; ++ai)
#pragma unroll
                    for (int m = 0; m < 4; ++m) { const int t = row0 + ai * HALF + m * 16; const f32x4 cs = *(const f32x4*)(tab + (size_t)t * 96 + il), sn = *(const f32x4*)(tab + (size_t)t * 96 + 32 + il);
                        const f32x4 x1 = acc[ai][bj][m][0], x2 = acc[ai][bj][m][1]; const f32x4 o1 = (x1 * cs - x2 * sn) * qs, o2 = (x2 * cs + x1 * sn) * qs;
                        bf16_t* p = Z + (size_t)t * zld + headbase + il; u32x2 w; w.x = cvt_pk_bf16(o1[0], o1[1]); w.y = cvt_pk_bf16(o1[2], o1[3]); *(u32x2*)p = w; w.x = cvt_pk_bf16(o2[0], o2[1]); w.y = cvt_pk_bf16(o2[2], o2[3]); *(u32x2*)(p + 32) = w; } }
        } else if (pn == 11) {
            if (wc == 0) {
#pragma unroll
                for (int ai = 0; ai < 2; ++ai)
#pragma unroll
                    for (int m = 0; m < 4; ++m) { const int t = row0 + ai * HALF + m * 16; const f32x4 cs = *(const f32x4*)(tab + (size_t)t * 96 + 64 + 4 * fq), sn = *(const f32x4*)(tab + (size_t)t * 96 + 80 + 4 * fq);
                        const f32x4 x1 = acc[ai][0][m][0], x2 = acc[ai][0][m][1]; const f32x4 o1 = x1 * cs - x2 * sn, o2 = x2 * cs + x1 * sn;
                        u32x2 w1, w2; w1.x = cvt_pk_bf16(o1[0], o1[1]); w1.y = cvt_pk_bf16(o1[2], o1[3]); w2.x = cvt_pk_bf16(o2[0], o2[1]); w2.y = cvt_pk_bf16(o2[2], o2[3]);
#pragma unroll
                        for (int h = 0; h < 6; ++h) { bf16_t* p = Km + (size_t)t * 576 + h * 96 + 64 + 4 * fq; *(u32x2*)p = w1; *(u32x2*)(p + 16) = w2; } } }
        } else {
            const int slot = (pn == 8) ? 0 : (pn == 9) ? 1 : 2; const bool stat = pn >= 8;
#pragma unroll
            for (int ai = 0; ai < 2; ++ai)
#pragma unroll
                for (int m = 0; m < 4; ++m) { const int t = row0 + ai * HALF + m * 16; bf16_t* rowp = Z + (size_t)t * zld + pn * BM + wc * 32 + 8 * fq; float ss = 0.f;
#pragma unroll
                    for (int bj = 0; bj < 2; ++bj) { const f32x4 v0 = acc[ai][bj][m][0], v1 = acc[ai][bj][m][1];
                        u32x4 w; w.x = cvt_pk_bf16(v0[0], v0[1]); w.y = cvt_pk_bf16(v0[2], v0[3]); w.z = cvt_pk_bf16(v1[0], v1[1]); w.w = cvt_pk_bf16(v1[2], v1[3]); *(u32x4*)(rowp + bj * HALF) = w;
                        if (stat && (pn != 8 || bj == 1)) ss += (v0[0] * v0[0] + v0[1] * v0[1]) + (v0[2] * v0[2] + v0[3] * v0[3]) + (v1[0] * v1[0] + v1[1] * v1[1]) + (v1[2] * v1[2] + v1[3] * v1[3]); }
                    if (stat) { ss += swz_xor16(ss); ss = other_half(ss); if (fq == 0) rsp[(size_t)t * 16 + slot * 4 + wc] = ss; } }
        }
    }
};
struct EpiMlaQ {
    static constexpr bool PERM = false;
    bf16_t* Q; const float* rs; const float* tab; float qscale; int pad;
    __device__ __forceinline__ void operator()(const f32x4 (&acc)[2][2][4][2], const Unit& u, int wr, int wc, int fr, int fq) const {
        const int row0 = u.pm * BM + wr * 64 + fr;
#pragma unroll
        for (int bj = 0; bj < 2; ++bj) { const int c0 = u.pn * BM + bj * HALF + wc * 32; if (c0 >= 576) continue; const bool rope = (c0 % 96) == 64;
#pragma unroll
            for (int ai = 0; ai < 2; ++ai)
#pragma unroll
                for (int m = 0; m < 4; ++m) { const int t = row0 + ai * HALF + m * 16; const f32x4 pa = *(const f32x4*)(rs + (size_t)t * 16), pb = *(const f32x4*)(rs + (size_t)t * 16 + 4); const float sc = qscale / sqrtf(((pa[0] + pa[1]) + (pa[2] + pa[3]) + (pb[0] + pb[1]) + (pb[2] + pb[3])) * (1.0f / 384.0f) + 1e-6f); f32x4 v0 = acc[ai][bj][m][0] * sc, v1 = acc[ai][bj][m][1] * sc;
                    if (rope) { const f32x4 cs = *(const f32x4*)(tab + (size_t)t * 96 + 64 + 4 * fq), sn = *(const f32x4*)(tab + (size_t)t * 96 + 80 + 4 * fq); const f32x4 o0 = v0 * cs - v1 * sn, o1 = v1 * cs + v0 * sn; v0 = o0; v1 = o1; }
                    bf16_t* p = Q + (size_t)t * 576 + c0 + 4 * fq; u32x2 w; w.x = cvt_pk_bf16(v0[0], v0[1]); w.y = cvt_pk_bf16(v0[2], v0[3]); *(u32x2*)p = w; w.x = cvt_pk_bf16(v1[0], v1[1]); w.y = cvt_pk_bf16(v1[2], v1[3]); *(u32x2*)(p + 16) = w; } }
    }
};
struct EpiMlaKV {
    static constexpr bool PERM = true;
    bf16_t* Km; bf16_t* Vm; const float* rs;
    __device__ __forceinline__ void operator()(const f32x4 (&acc)[2][2][4][2], const Unit& u, int wr, int wc, int fr, int fq) const {
        const int row0 = u.pm * BM + wr * 64 + fr;
#pragma unroll
        for (int bj = 0; bj < 2; ++bj) { const int c8 = u.pn * BM + bj * HALF + wc * 32 + 8 * fq; const int head = c8 >> 7, off = c8 & 127;
#pragma unroll
            for (int ai = 0; ai < 2; ++ai)
#pragma unroll
                for (int m = 0; m < 4; ++m) { const int t = row0 + ai * HALF + m * 16; const f32x4 pc = *(const f32x4*)(rs + (size_t)t * 16 + 8); const float sc = 1.0f / sqrtf(((pc[0] + pc[1]) + (pc[2] + pc[3])) * (1.0f / 256.0f) + 1e-6f); const f32x4 v0 = acc[ai][bj][m][0] * sc, v1 = acc[ai][bj][m][1] * sc;
                    bf16_t* p = (off < 64) ? Km + (size_t)t * 576 + head * 96 + off : Vm + (size_t)t * 384 + head * 64 + (off - 64);
                    u32x4 w; w.x = cvt_pk_bf16(v0[0], v0[1]); w.y = cvt_pk_bf16(v0[2], v0[3]); w.z = cvt_pk_bf16(v1[0], v1[1]); w.w = cvt_pk_bf16(v1[2], v1[3]); *(u32x4*)p = w; } }
    }
};

template <class Epi, class Sched, bool ALIGN_EPI, int FP8 = 0  >
__device__ __forceinline__ void gemm_phase(PG8_LAS unsigned char* lds, const Gemm g, const Sched& S, const Epi& E, const int tid) {
    const int wid = __builtin_amdgcn_readfirstlane(tid >> 6), lane = tid & 63, wr = wid >> 2, wc = wid & 3, fr = lane & 15, fq = lane >> 4;
    const int K = g.K, nt = K / BK;
    unsigned voffA[2], voffB[2];
#pragma unroll
    for (int i = 0; i < 2; ++i) { int R, C; stage_rc(tid * 16 + i * 8192, R, C); const int Rb = Epi::PERM ? ((R & ~31) + perm32(R & 31)) : R;
        voffA[i] = (unsigned)(R * g.lda + C) * 2u; voffB[i] = (unsigned)(Rb * g.ldb + C) * 2u; }
    const size_t kstep = (size_t)(BK * 2);
    const size_t hstepA = (size_t)HALF * g.lda * 2, hstepB = (size_t)HALF * g.ldb * 2;
    const size_t tstepA = 2 * hstepA, tstepB = 2 * hstepB;
    const unsigned ldsw = (unsigned)wid * 1024u;
    const int aoff = lds_byte(wr * 64 + fr, fq * 8), boff = lds_byte(wc * 32 + fr, fq * 8);
#define PG8_SA(b, h) (((b) * 2 + (h)) * HTB)
#define PG8_SB(b, h) ((4 + (b) * 2 + (h)) * HTB)
#define PG8_STAGE(bufoff, gbase, voff) do { _Pragma("unroll") for (int _i = 0; _i < 2; ++_i) \
        __builtin_amdgcn_global_load_lds((const unsigned*)((const char*)(gbase) + (voff)[_i]), (PG8_LAS unsigned*)(lds + (bufoff) + ldsw + _i * 8192), 16, 0, 0); } while (0)
#define PG8_LD8(addr) __builtin_shufflevector(*(const PG8_LAS i32x4*)(addr), *(const PG8_LAS i32x4*)((addr) + 1024), 0, 1, 2, 3, 4, 5, 6, 7)
#define PG8_LDA(dst, b, h) do { _Pragma("unroll") for (int m = 0; m < 4; ++m) dst[m] = PG8_LD8(lds + PG8_SA(b, h) + aoff + m * 2048); } while (0)
#define PG8_LDB(dst, b, h) do { _Pragma("unroll") for (int n = 0; n < 2; ++n) dst[n] = PG8_LD8(lds + PG8_SB(b, h) + boff + n * 2048); } while (0)
#define PG8_LO(x) __builtin_bit_cast(bf16x8, __builtin_shufflevector((x), (x), 0, 1, 2, 3))
#define PG8_HI(x) __builtin_bit_cast(bf16x8, __builtin_shufflevector((x), (x), 4, 5, 6, 7))
#define PG8_MMA(ai, bj, At, Bt) do { __builtin_amdgcn_s_setprio(1); _Pragma("unroll") for (int m = 0; m < 4; ++m) _Pragma("unroll") for (int n = 0; n < 2; ++n) { \
        if constexpr (FP8 != 0) asm volatile("v_mfma_f32_16x16x128_f8f6f4 %0, %1, %2, %0" : "+v"(acc[ai][bj][m][n]) : "v"(Bt[n]), "v"(At[m])); \
        else { acc[ai][bj][m][n] = __builtin_amdgcn_mfma_f32_16x16x32_bf16(PG8_LO(Bt[n]), PG8_LO(At[m]), acc[ai][bj][m][n], 0, 0, 0); acc[ai][bj][m][n] = __builtin_amdgcn_mfma_f32_16x16x32_bf16(PG8_HI(Bt[n]), PG8_HI(At[m]), acc[ai][bj][m][n], 0, 0, 0); } } __builtin_amdgcn_s_setprio(0); } while (0)
#define PG8_WAIT_V(n) asm volatile("s_waitcnt vmcnt(" #n ")" ::: "memory")
#define PG8_WAIT_L(n) asm volatile("s_waitcnt lgkmcnt(" #n ")" ::: "memory")
#define PG8_BAR __builtin_amdgcn_s_barrier()
#define PG8_SCHED __builtin_amdgcn_sched_barrier(0)
    Unit cur, nxt; int ui = 0;
    if (!S.next(0, cur)) return;
    f32x4 acc[2][2][4][2];
#pragma unroll
    for (int a = 0; a < 2; ++a)
#pragma unroll
        for (int b = 0; b < 2; ++b)
#pragma unroll
            for (int m = 0; m < 4; ++m)
#pragma unroll
                for (int n = 0; n < 2; ++n) acc[a][b][m][n] = (f32x4){0.f, 0.f, 0.f, 0.f};
    i32x8 At[4], B0[2], B1[2];
    const char* cA = (const char*)g.A + (size_t)cur.pm * tstepA; const char* cB = (const char*)(g.Bt + (size_t)cur.g * g.gstride) + (size_t)cur.pn * tstepB;
    PG8_STAGE(PG8_SB(0, 0), cB, voffB); PG8_STAGE(PG8_SB(0, 1), cB + hstepB, voffB); PG8_STAGE(PG8_SA(0, 0), cA, voffA); PG8_STAGE(PG8_SA(0, 1), cA + hstepA, voffA);
    if (wr == 1) PG8_BAR;
    PG8_WAIT_V(2); PG8_BAR;
    PG8_STAGE(PG8_SB(1, 0), cB + kstep, voffB); PG8_STAGE(PG8_SA(1, 0), cA + kstep, voffA); PG8_STAGE(PG8_SB(1, 1), cB + hstepB + kstep, voffB);
    PG8_WAIT_V(6); PG8_BAR;
    for (;;) {
        const bool has_next = S.next(ui + 1, nxt);
        const char* nA = has_next ? (const char*)g.A + (size_t)nxt.pm * tstepA : cA; const char* nB = has_next ? (const char*)(g.Bt + (size_t)nxt.g * g.gstride) + (size_t)nxt.pn * tstepB : cB;
#pragma nounroll
        for (int t = 0; t < nt; t += 2) {
            const bool last = (t == nt - 2);
            const char* a1 = cA + (size_t)(t + 1) * kstep;
            const char* a2 = last ? nA : cA + (size_t)(t + 2) * kstep; const char* b2 = last ? nB : cB + (size_t)(t + 2) * kstep;
            const char* a3 = a2 + kstep; const char* b3 = b2 + kstep;
            PG8_LDB(B0, 0, 0); PG8_LDB(B1, 0, 1); PG8_SCHED; PG8_LDA(At, 0, 0); PG8_STAGE(PG8_SA(1, 1), a1 + hstepA, voffA);
            PG8_WAIT_V(8); PG8_WAIT_L(0); PG8_BAR; PG8_MMA(0, 0, At, B0); PG8_MMA(0, 1, At, B1); PG8_BAR; PG8_SCHED;
            PG8_LDA(At, 0, 1); PG8_STAGE(PG8_SB(0, 0), b2, voffB); PG8_STAGE(PG8_SB(0, 1), b2 + hstepB, voffB); PG8_STAGE(PG8_SA(0, 0), a2, voffA);
            PG8_WAIT_V(8); PG8_WAIT_L(0); PG8_BAR; PG8_MMA(1, 0, At, B0); PG8_MMA(1, 1, At, B1); PG8_BAR; PG8_SCHED;
            PG8_LDB(B0, 1, 0); PG8_LDB(B1, 1, 1); PG8_SCHED; PG8_LDA(At, 1, 0); PG8_STAGE(PG8_SA(0, 1), a2 + hstepA, voffA);
            PG8_WAIT_V(8); PG8_WAIT_L(0); PG8_BAR; PG8_MMA(0, 0, At, B0); PG8_MMA(0, 1, At, B1); PG8_BAR; PG8_SCHED;
            PG8_LDA(At, 1, 1); PG8_STAGE(PG8_SB(1, 0), b3, voffB); PG8_STAGE(PG8_SB(1, 1), b3 + hstepB, voffB); PG8_STAGE(PG8_SA(1, 0), a3, voffA);
            PG8_WAIT_V(8); PG8_WAIT_L(0); PG8_BAR; PG8_MMA(1, 0, At, B0); PG8_MMA(1, 1, At, B1); PG8_BAR; PG8_SCHED;
        }
        if constexpr (ALIGN_EPI) { if (wr == 0) PG8_BAR; }
        if constexpr (FP8 != 0) asm volatile("s_nop 15\n\ts_nop 15" ::: "memory");
        E(acc, cur, wr, wc, fr, fq);
        if (!has_next) break;
#pragma unroll
        for (int a = 0; a < 2; ++a)
#pragma unroll
            for (int b = 0; b < 2; ++b)
#pragma unroll
                for (int m = 0; m < 4; ++m)
#pragma unroll
                    for (int n = 0; n < 2; ++n) acc[a][b][m][n] = (f32x4){0.f, 0.f, 0.f, 0.f};
        cur = nxt; cA = nA; cB = nB; ++ui;
        if constexpr (ALIGN_EPI) { if (wr == 1) PG8_BAR; }
    }
    PG8_WAIT_V(0);
    if constexpr (!ALIGN_EPI) { if (wr == 0) PG8_BAR; }
    PG8_BAR;
#undef PG8_SA
#undef PG8_SB
#undef PG8_STAGE
#undef PG8_LDA
#undef PG8_LDB
#undef PG8_MMA
#undef PG8_LD8
#undef PG8_LO
#undef PG8_HI
#undef PG8_WAIT_V
#undef PG8_WAIT_L
#undef PG8_BAR
#undef PG8_SCHED
}
}
constexpr int NWAVES = 8, NTHREADS = 512;
constexpr int NB = 8, SEQ = 4096, T = NB * SEQ, NL = 4, D = 1024, NEXP = 8;
constexpr int D_IN = 2848, ZLD = 3072;
constexpr int ZO_RQ = 0, ZO_RK = 256, ZO_RV = 512, ZO_RG = 768, ZO_DQ = 1024, ZO_DK = 1408, ZO_DV = 1792, ZO_CQ = 2176, ZO_CKV = 2560, ZO_KR = 2816;
constexpr int QRANK = 384, KVRANK = 256, QLD = 576, KLD = 576, VLD = 384;
constexpr int YO_RET = 0, YO_DIL = 256, YO_MLA = 640;
constexpr int DFF = 2816, DFFE = 3584;
constexpr float LN_EPS = 1e-5f, RMS_EPS = 1e-6f, DN_ALPHA = 1.6817928305074290f;
constexpr float LOG2E = 1.4426950408889634f;
constexpr float MLA_QSCALE = 0.10206207261596577f * LOG2E;
constexpr int MAXSLOT = 2 * T + NEXP * 256;

constexpr size_t MiB = 1u << 20;
constexpr size_t WS_CTL = 0, CTL_ZERO_BYTES = 1 * MiB;
constexpr size_t WS_MOD = 1 * MiB;
constexpr size_t WS_RS = 2 * MiB, WS_TOPI = WS_RS + 256 * 1024, WS_GATE = WS_TOPI + 256 * 1024, WS_TSLOT = WS_GATE + 256 * 1024, WS_SEG = WS_TSLOT + 256 * 1024;
constexpr size_t WS_TAB = 4 * MiB;
constexpr size_t WS_WIN = 16 * MiB, WS_WUQ = 22 * MiB, WS_WUKV = 23 * MiB, WS_WOUT = 24 * MiB, WS_WFF = 26 * MiB;
constexpr size_t WFF_W2_OFF_DENSE = (size_t)2 * DFF * D * 2, WFF_W2_OFF_MOE8 = (size_t)NEXP * 2 * DFFE * D;
constexpr size_t WS_H = 194 * MiB;
constexpr size_t WS_A = 258 * MiB;
constexpr size_t WS_Z = WS_A, WS_QM = WS_A + 192 * MiB, WS_KM = WS_A + 228 * MiB, WS_VM = WS_A + 264 * MiB, WS_KVS = WS_A + 288 * MiB, WS_DILO = WS_A + 304 * MiB, WS_DILL = WS_A + 376 * MiB, WS_YCAT = WS_A + 380 * MiB;
constexpr size_t WS_FF = WS_A;
constexpr size_t WS_Y = 720 * MiB;
constexpr size_t WS_XB = 852 * MiB;
constexpr size_t WS_RSP = 916 * MiB;
constexpr size_t WS_END = 918 * MiB;
static_assert((size_t)MAXSLOT * DFFE * 2 <= 462 * MiB && (size_t)MAXSLOT * D * 2 <= 132 * MiB && (size_t)T * ZLD * 2 == 192 * MiB, "ws map");
constexpr int CW_TMO = 0, CW_CODE = 1, CW_BAR = 4096, CW_CNT = 8192  , CW_CUR = 8448  , CW_Q = 8704  ;

constexpr int RING_OFF = 0, RING_BYTES = 131072;
constexpr int LDSCTL_OFF = RING_BYTES, MISC_OFF = LDSCTL_OFF + 320;
constexpr int LDS_BYTES = 147456;
constexpr int PTAB_OFF = LDSCTL_OFF + 512;

#define GAS __attribute__((address_space(1)))
#define LAS __attribute__((address_space(3)))
typedef unsigned short bf16;
typedef unsigned v4u __attribute__((ext_vector_type(4)));
typedef unsigned v2u __attribute__((ext_vector_type(2)));
typedef float f32x4 __attribute__((ext_vector_type(4)));
typedef GAS unsigned gu32;
#define RLX_AGENT __ATOMIC_RELAXED, __HIP_MEMORY_SCOPE_AGENT
#define LDS_WAIT() asm volatile("s_waitcnt lgkmcnt(0)" ::: "memory")
#define VM_WAIT() asm volatile("s_waitcnt vmcnt(0)" ::: "memory")
__device__ __forceinline__ unsigned f2bf(float f) { unsigned u = __builtin_bit_cast(unsigned, f); return (u + 0x7fffu + ((u >> 16) & 1u)) >> 16; }
__device__ __forceinline__ unsigned pk2(float lo, float hi) { return f2bf(lo) | (f2bf(hi) << 16); }
__device__ __forceinline__ float bf2f(unsigned short b) { return __builtin_bit_cast(float, (unsigned)b << 16); }
__device__ __forceinline__ float bflo(unsigned w) { return __builtin_bit_cast(float, w << 16); }
__device__ __forceinline__ float bfhi(unsigned w) { return __builtin_bit_cast(float, w & 0xffff0000u); }
__device__ __forceinline__ void ld8(const bf16* p, float* o) { const v4u w = *(const v4u*)p; o[0] = bflo(w.x); o[1] = bfhi(w.x); o[2] = bflo(w.y); o[3] = bfhi(w.y); o[4] = bflo(w.z); o[5] = bfhi(w.z); o[6] = bflo(w.w); o[7] = bfhi(w.w); }
__device__ __forceinline__ float fsilu(float x) { return x * __builtin_amdgcn_rcpf(1.0f + __builtin_amdgcn_exp2f(-LOG2E * x)); }

#define XB_TMO      128
#define XB_XCNT(j)  (256  + 64 * (j))
#define XB_XSUB(j)  (1280 + 64 * (j))
#define XB_XGEN(j)  (2304 + 64 * (j))
#define XB_TOP      3328
#define XB_TOPGEN   3392
#define XCD_BAR_WORDS 3456
#define XB_SPIN_CAP (1u << 18)
__device__ __forceinline__ unsigned xb_ld(unsigned* p)              { return __hip_atomic_load(p, __ATOMIC_RELAXED, __HIP_MEMORY_SCOPE_AGENT); }
__device__ __forceinline__ unsigned xb_add(unsigned* p, unsigned v) { return __hip_atomic_fetch_add(p, v, __ATOMIC_RELAXED, __HIP_MEMORY_SCOPE_AGENT); }
__device__ __forceinline__ unsigned xb_xcc_id() { return (unsigned)__builtin_amdgcn_s_getreg((3 << 11) | 20) & 0xFu; }
#define XB_SPIN(cond, bar) do { unsigned _sp = 0; while (cond) { __builtin_amdgcn_s_sleep(1); \
    if ((++_sp & 255u) == 0u) { if (xb_ld(&(bar)[XB_TMO])) break; if (_sp > XB_SPIN_CAP) { atomicAdd(&(bar)[XB_TMO], 1u); break; } } } } while (0)
struct XcdBarrier { unsigned* bar; unsigned x; volatile LAS unsigned* st; };
__device__ __forceinline__ XcdBarrier xcd_barrier_post(unsigned* bar, volatile LAS unsigned* st) {
    XcdBarrier b; b.bar = bar; b.x = xb_xcc_id(); b.st = st;
    if (threadIdx.x == 0) (void)xb_add(&bar[XB_XCNT(b.x)], 1u);
    return b;
}
__device__ __forceinline__ void xcd_barrier_complete(unsigned* bar, unsigned x, unsigned& nloc, unsigned& nx) {
    const unsigned G = gridDim.x * gridDim.y * gridDim.z;
    unsigned sum, cnt, mine, sp = 0u;
    for (;;) {
        sum = 0u; cnt = 0u; mine = 0u;
#pragma unroll
        for (unsigned j = 0; j < 16; ++j) { const unsigned c = xb_ld(&bar[XB_XCNT(j)]); sum += c; cnt += (c > 0u) ? 1u : 0u; mine = (j == x) ? c : mine; }
        if (sum == G) break;
        __builtin_amdgcn_s_sleep(1);
        if ((++sp & 255u) == 0u) { if (xb_ld(&bar[XB_TMO])) break; if (sp > XB_SPIN_CAP) { atomicAdd(&bar[XB_TMO], 1u); break; } }
    }
    nloc = mine > 0u ? mine : 1u; nx = cnt > 0u ? cnt : 1u;
}
__device__ __forceinline__ void xcd_barrier(const XcdBarrier& b) {
    asm volatile("s_waitcnt vmcnt(0)" ::: "memory");
    __syncthreads();
    if (threadIdx.x == 0) {
        unsigned* bar = b.bar; asm volatile("" : "+s"(bar));
        __builtin_amdgcn_s_waitcnt(0);
        unsigned nloc = b.st[0], nx = b.st[1];
        if (nloc == 0u) { xcd_barrier_complete(bar, b.x, nloc, nx); b.st[0] = nloc; b.st[1] = nx; }
        const unsigned old = xb_add(&bar[XB_XSUB(b.x)], 1u);
        const unsigned gen = old / nloc;
        if (old + 1u == (gen + 1u) * nloc) {
            __builtin_amdgcn_fence(__ATOMIC_RELEASE, "agent");
            asm volatile("s_waitcnt vmcnt(0)" ::: "memory");
            const unsigned og = xb_add(&bar[XB_TOP], 1u);
            const unsigned tg = og / nx;
            if (og + 1u == (tg + 1u) * nx) xb_add(&bar[XB_TOPGEN], 1u);
            else XB_SPIN(xb_ld(&bar[XB_TOPGEN]) == tg, bar);
            __builtin_amdgcn_fence(__ATOMIC_ACQUIRE, "agent");
            xb_add(&bar[XB_XGEN(b.x)], 1u);
            asm volatile("s_waitcnt vmcnt(0)" ::: "memory");
        } else {
            XB_SPIN(xb_ld(&bar[XB_XGEN(b.x)]) == gen, bar);
            __builtin_amdgcn_fence(__ATOMIC_ACQUIRE, "agent");
            asm volatile("s_waitcnt vmcnt(0)" ::: "memory");
        }
    }
    __syncthreads();
}

struct Frame {
    LAS unsigned char* lds; volatile LAS unsigned* MISC; gu32* ctl;
    int tid, lane, wave, vcu, G;
    __device__ __forceinline__ unsigned long long ptab(int i) const { const volatile LAS unsigned* p = (const volatile LAS unsigned*)(lds + PTAB_OFF) + 2 * i; const unsigned lo = p[0], hi = p[1];
        return ((unsigned long long)(unsigned)__builtin_amdgcn_readfirstlane((int)hi) << 32) | (unsigned)__builtin_amdgcn_readfirstlane((int)lo); }
    int wave_s;
    __device__ __forceinline__ void refresh() { int w = wave_s; asm volatile("" : "+s"(w)); const unsigned z0 = MISC[30];     int ln = (int)__builtin_amdgcn_mbcnt_hi(~0u, __builtin_amdgcn_mbcnt_lo(~0u, z0)); asm volatile("" : "+v"(ln)); wave = w; lane = ln; tid = w * 64 + ln;
        unsigned long long c = ptab(24); ctl = (gu32*)c; }
    __device__ __forceinline__ const float* in(int i) const { return (const float*)ptab(i); }
    __device__ __forceinline__ float* outp() const { return (float*)ptab(23); }
    __device__ __forceinline__ unsigned char* wsp() const { return (unsigned char*)ptab(24); }
};
__constant__ double INVT[48] = {
0.15915494309189535, 0.11934937021124886, 0.089499401608891013, 0.067115083005227255, 0.050329212104487035, 0.037741584717419771, 0.028302195830623399, 0.02122365276477766, 0.015915494309189534, 0.011934937021124886, 0.0089499401608891024, 0.0067115083005227253, 0.0050329212104487037, 0.0037741584717419772, 0.0028302195830623399, 0.0021223652764777662, 0.0015915494309189536, 0.0011934937021124885, 0.00089499401608891024, 0.0006711508300522726, 0.00050329212104487033, 0.00037741584717419774, 0.00028302195830623395, 0.00021223652764777661, 0.00015915494309189535, 0.00011934937021124886, 8.9499401608891018e-05, 6.7115083005227254e-05, 5.0329212104487035e-05, 3.7741584717419777e-05, 2.8302195830623396e-05, 2.1223652764777659e-05, 0.15915494309189535, 0.089499401608891013, 0.050329212104487035, 0.028302195830623399, 0.015915494309189534, 0.0089499401608891024, 0.0050329212104487037, 0.0028302195830623399, 0.0015915494309189536, 0.00089499401608891024, 0.00050329212104487033, 0.00028302195830623395, 0.00015915494309189535, 8.9499401608891018e-05, 5.0329212104487035e-05, 2.8302195830623396e-05};

#define dpp_f(v, ctrl) __builtin_bit_cast(float, __builtin_amdgcn_update_dpp(0, __builtin_bit_cast(int, (v)), (ctrl), 0xf, 0xf, false))
__device__ __forceinline__ float wave_sum_dpp(float v) {
    v += dpp_f(v, 0xB1); v += dpp_f(v, 0x4E); v += dpp_f(v, 0x141); v += dpp_f(v, 0x140);
    const int iv = __builtin_bit_cast(int, v);
    return (__builtin_bit_cast(float, __builtin_amdgcn_readlane(iv, 0)) + __builtin_bit_cast(float, __builtin_amdgcn_readlane(iv, 16))) + (__builtin_bit_cast(float, __builtin_amdgcn_readlane(iv, 32)) + __builtin_bit_cast(float, __builtin_amdgcn_readlane(iv, 48)));
}
__device__ __forceinline__ float shx(float v, int o, int lane) { return __builtin_bit_cast(float, __builtin_amdgcn_ds_bpermute((lane ^ o) << 2, __builtin_bit_cast(int, v))); }
__device__ __forceinline__ void transpose_item(const float* W, int K, int N, bf16* WT, int mode, const float* kscale, LAS float* scr, int item, int lane, bool fp8 = false) {
    const int nblk = N / 32, kb = item / nblk, nb = item % nblk, k0 = 64 * kb, n0 = 32 * nb;
    float tv[32];
#pragma unroll
    for (int i = 0; i < 32; ++i) tv[i] = __builtin_nontemporal_load(W + (size_t)(k0 + 2 * i + (lane >> 5)) * N + n0 + (lane & 31));
#pragma unroll
    for (int i = 0; i < 32; ++i) { const int kk = 2 * i + (lane >> 5); float v = tv[i]; if (kscale) v *= kscale[k0 + kk]; scr[kk * 33 + (lane & 31)] = v; }
    LDS_WAIT(); asm volatile("" ::: "memory");
    const int c = lane & 7;
#pragma unroll
    for (int j = 0; j < 4; ++j) { const int n = (lane >> 3) + 8 * j; const LAS float* s = scr + (8 * c) * 33 + n;
        v4u o; o.x = pk2(s[0 * 33], s[1 * 33]); o.y = pk2(s[2 * 33], s[3 * 33]); o.z = pk2(s[4 * 33], s[5 * 33]); o.w = pk2(s[6 * 33], s[7 * 33]);
        const int nn = n0 + n; const int row = (mode == 0) ? nn : (mode == 3) ? pg8::zmap(nn) : (32 * (nn >> 4) + (nn & 15) + (mode == 2 ? 16 : 0));
        if (fp8) { v2u o8; o8.x = pg8::pack4_fp8(s[0 * 33] * 64.f, s[1 * 33] * 64.f, s[2 * 33] * 64.f, s[3 * 33] * 64.f); o8.y = pg8::pack4_fp8(s[4 * 33] * 64.f, s[5 * 33] * 64.f, s[6 * 33] * 64.f, s[7 * 33] * 64.f);
            *(GAS v2u*)((unsigned char*)WT + (size_t)row * K + k0 + 8 * c) = o8; }
        else *(GAS v4u*)(WT + (size_t)row * K + k0 + 8 * c) = o; }
    LDS_WAIT(); asm volatile("" ::: "memory");
}
__device__ __forceinline__ void phase_convert(Frame& F, int l) {
    LAS float* scr = (LAS float*)(F.lds + RING_OFF + F.wave * 16384);
    const int gw = F.vcu * NWAVES + F.wave, NGW = F.G * NWAVES;
    bf16* WIN = (bf16*)(F.wsp() + WS_WIN); bf16* WUQ = (bf16*)(F.wsp() + WS_WUQ); bf16* WUKV = (bf16*)(F.wsp() + WS_WUKV); bf16* WOUT = (bf16*)(F.wsp() + WS_WOUT); bf16* WFF = (bf16*)(F.wsp() + WS_WFF);
    constexpr int I_IN = 16 * 89, I_UQ = 6 * 18, I_UKV = 4 * 24, I_OUT = 16 * 32, I_D1 = 16 * 88, I_D2 = 44 * 32, I_M1 = 16 * 112, I_M2 = 56 * 32;
    const bool moe = (l & 1) != 0; const int li = l >> 1;
    const int nff = moe ? NEXP * (2 * I_M1 + I_M2) : (2 * I_D1 + I_D2);
    const int nitems = I_IN + I_UQ + I_UKV + I_OUT + nff;
    for (int it = gw; it < nitems; it += NGW) {
        int r = it; const float* W; int K, N, mode = 0; bf16* WT; const float* ks = nullptr; bool f8 = false;
        if (r < I_IN) { W = F.in(3) + (size_t)l * D * D_IN; K = D; N = D_IN; WT = WIN; mode = 3; }
        else if ((r -= I_IN) < I_UQ) { W = F.in(7) + (size_t)l * QRANK * 576; K = QRANK; N = 576; WT = WUQ; ks = F.in(5) + l * QRANK; }
        else if ((r -= I_UQ) < I_UKV) { W = F.in(8) + (size_t)l * KVRANK * 768; K = KVRANK; N = 768; WT = WUKV; ks = F.in(6) + l * KVRANK; }
        else if ((r -= I_UKV) < I_OUT) { W = F.in(9) + (size_t)l * D * D; K = D; N = D; WT = WOUT; }
        else { r -= I_OUT;
            if (!moe) {
                if (r < I_D1) { W = F.in(16) + (size_t)li * D * DFF; K = D; N = DFF; WT = WFF; mode = 1; }
                else if ((r -= I_D1) < I_D1) { W = F.in(17) + (size_t)li * D * DFF; K = D; N = DFF; WT = WFF; mode = 2; }
                else { r -= I_D1; W = F.in(18) + (size_t)li * DFF * D; K = DFF; N = D; WT = (bf16*)((unsigned char*)WFF + WFF_W2_OFF_DENSE); }
            } else { const int per = 2 * I_M1 + I_M2; const int e = r / per; r -= e * per; f8 = true;
                if (r < I_M1) { W = F.in(20) + ((size_t)li * NEXP + e) * D * DFFE; K = D; N = DFFE; WT = (bf16*)((unsigned char*)WFF + (size_t)e * 2 * DFFE * D); mode = 1; }
                else if ((r -= I_M1) < I_M1) { W = F.in(21) + ((size_t)li * NEXP + e) * D * DFFE; K = D; N = DFFE; WT = (bf16*)((unsigned char*)WFF + (size_t)e * 2 * DFFE * D); mode = 2; }
                else { r -= I_M1; W = F.in(22) + ((size_t)li * NEXP + e) * DFFE * D; K = DFFE; N = D; WT = (bf16*)((unsigned char*)WFF + WFF_W2_OFF_MOE8 + (size_t)e * D * DFFE); }
            } }
        transpose_item(W, K, N, WT, mode, ks, scr, r, F.lane, f8);
    }
    const int gt = F.vcu * NTHREADS + F.tid, NT = F.G * NTHREADS;
    { GAS v4u* p = (GAS v4u*)(WIN + (size_t)D_IN * D); const int n = (ZLD - D_IN) * D / 8; unsigned zz = 0u; asm volatile("" : "+v"(zz)); for (int i = gt; i < n; i += NT) p[i] = (v4u){zz, zz, zz, zz}; }
    { GAS v4u* p = (GAS v4u*)(WUQ + (size_t)576 * QRANK); const int n = (768 - 576) * QRANK / 8; unsigned zz = 0u; asm volatile("" : "+v"(zz)); for (int i = gt; i < n; i += NT) p[i] = (v4u){zz, zz, zz, zz}; }
}
__device__ __forceinline__ void phase_mod_tab(Frame& F) {
    const int gt = F.vcu * NTHREADS + F.tid, NT = F.G * NTHREADS;
    float* MOD = (float*)(F.wsp() + WS_MOD); float* TAB = (float*)(F.wsp() + WS_TAB);
    const float* c = F.in(1); const float* w_ada = F.in(10); const float* b_ada = F.in(11); const int* pos = (const int*)F.in(2);
    LAS float* cs = (LAS float*)(F.lds + RING_OFF);
    for (int i = F.tid; i < NB * D; i += NTHREADS) cs[i] = fsilu(c[i]);
    __syncthreads();
    for (int ix = gt; ix < NL * NB * 6 * D; ix += NT) { const int j = ix % (6 * D), b = (ix / (6 * D)) % NB, l = ix / (6 * D * NB);
        const float* w = w_ada + (size_t)l * D * 6 * D + j; float a0 = b_ada[(size_t)l * 6 * D + j], a1 = 0.f, a2 = 0.f, a3 = 0.f; const LAS float* cb = cs + b * D;
#pragma unroll 4
        for (int k = 0; k < D; k += 4) { a0 += cb[k] * w[(size_t)k * 6 * D]; a1 += cb[k + 1] * w[(size_t)(k + 1) * 6 * D]; a2 += cb[k + 2] * w[(size_t)(k + 2) * 6 * D]; a3 += cb[k + 3] * w[(size_t)(k + 3) * 6 * D]; }
        MOD[ix] = (a0 + a1) + (a2 + a3); }
    __syncthreads();
    for (int ix = gt; ix < T * 48; ix += NT) { const int t = ix / 48, i = ix % 48; const double x = (double)pos[t] * INVT[i]; const float fr = (float)(x - floor(x));
        const float s = __builtin_amdgcn_sinf(fr), cc = __builtin_amdgcn_cosf(fr); float* r = TAB + (size_t)t * 96;
        if (i < 32) { r[i] = cc; r[32 + i] = s; } else { r[64 + (i - 32)] = cc; r[80 + (i - 32)] = s; } }
}
__device__ __forceinline__ void phase_modulate0(Frame& F) {
    const int gt = F.vcu * NTHREADS + F.tid, NT = F.G * NTHREADS; const float* MOD = (const float*)(F.wsp() + WS_MOD); bf16* H = (bf16*)(F.wsp() + WS_H); const float* x = F.in(0);
    for (int ix = gt; ix < T * D / 4; ix += NT) { const int t = ix / (D / 4), d = (ix % (D / 4)) * 4, b = t / SEQ; const float* m = MOD + (size_t)b * 6 * D;
        const f32x4 xv = *(const f32x4*)(x + (size_t)ix * 4), sh = *(const f32x4*)(m + d), sc = *(const f32x4*)(m + D + d); const f32x4 h = xv * (1.0f + sc) + sh;
        v2u w; w.x = pk2(h.x, h.y); w.y = pk2(h.z, h.w); *(v2u*)(H + (size_t)ix * 4) = w; }
}
__device__ __forceinline__ void rope8(const v4u a, const v4u b, const float* cs, const float* sn, float qs, v4u& oa, v4u& ob) {
    const f32x4 c0 = *(const f32x4*)cs, c1 = *(const f32x4*)(cs + 4), s0 = *(const f32x4*)sn, s1 = *(const f32x4*)(sn + 4);
    const float x1[8] = {bflo(a.x), bfhi(a.x), bflo(a.y), bfhi(a.y), bflo(a.z), bfhi(a.z), bflo(a.w), bfhi(a.w)}, x2[8] = {bflo(b.x), bfhi(b.x), bflo(b.y), bfhi(b.y), bflo(b.z), bfhi(b.z), bflo(b.w), bfhi(b.w)};
    const float c[8] = {c0.x, c0.y, c0.z, c0.w, c1.x, c1.y, c1.z, c1.w}, s[8] = {s0.x, s0.y, s0.z, s0.w, s1.x, s1.y, s1.z, s1.w}; float o1[8], o2[8];
#pragma unroll
    for (int i = 0; i < 8; ++i) { o1[i] = (x1[i] * c[i] - x2[i] * s[i]) * qs; o2[i] = (x2[i] * c[i] + x1[i] * s[i]) * qs; }
    oa.x = pk2(o1[0], o1[1]); oa.y = pk2(o1[2], o1[3]); oa.z = pk2(o1[4], o1[5]); oa.w = pk2(o1[6], o1[7]); ob.x = pk2(o2[0], o2[1]); ob.y = pk2(o2[2], o2[3]); ob.z = pk2(o2[4], o2[5]); ob.w = pk2(o2[6], o2[7]);
}
__device__ __forceinline__ float sumsq8(const v4u a) { const float x[8] = {bflo(a.x), bfhi(a.x), bflo(a.y), bfhi(a.y), bflo(a.z), bfhi(a.z), bflo(a.w), bfhi(a.w)}; float s = 0.f;
#pragma unroll
    for (int i = 0; i < 8; ++i) s += x[i] * x[i];
    return s; }
__device__ __forceinline__ void phase_rope_stats(Frame& F) {
    const int gw = F.vcu * NWAVES + F.wave, NGW = F.G * NWAVES, lane = F.lane;
    bf16* Z = (bf16*)(F.wsp() + WS_Z); bf16* KM = (bf16*)(F.wsp() + WS_KM); const float* TAB = (const float*)(F.wsp() + WS_TAB); float* RS = (float*)(F.wsp() + WS_RS);
    const int cc = lane & 3, hdA = lane >> 2, hdB = 16 + (lane >> 2);
    const int baseA = (hdA < 4) ? ZO_RQ + hdA * 64 : (hdA < 8) ? ZO_RK + (hdA - 4) * 64 : (hdA < 14) ? ZO_DQ + (hdA - 8) * 64 : ZO_DK + (hdA - 14) * 64;
    const int baseB = ZO_DK + (hdB - 14) * 64;
    const float qsA = (hdA >= 8 && hdA < 14) ? 0.125f * LOG2E : 1.0f;
    for (int t = gw; t < T; t += NGW) { bf16* zr = Z + (size_t)t * ZLD; const float* tb = TAB + (size_t)t * 96;
        const v4u a1 = *(const v4u*)(zr + baseA + 8 * cc), a2 = *(const v4u*)(zr + baseA + 32 + 8 * cc);
        v4u b1 = (v4u){0u, 0u, 0u, 0u}, b2 = b1, k1 = b1, k2 = b1, q1 = b1, q2 = b1;
        if (lane < 16) { b1 = *(const v4u*)(zr + baseB + 8 * cc); b2 = *(const v4u*)(zr + baseB + 32 + 8 * cc); }
        else if (lane < 18) { k1 = *(const v4u*)(zr + ZO_KR + 8 * (lane - 16)); k2 = *(const v4u*)(zr + ZO_KR + 16 + 8 * (lane - 16)); }
        if (lane < 48) q1 = *(const v4u*)(zr + ZO_CQ + 8 * lane);
        if (lane < 32) q2 = *(const v4u*)(zr + ZO_CKV + 8 * lane);
        v4u oa, ob; rope8(a1, a2, tb + 8 * cc, tb + 32 + 8 * cc, qsA, oa, ob); *(v4u*)(zr + baseA + 8 * cc) = oa; *(v4u*)(zr + baseA + 32 + 8 * cc) = ob;
        if (lane < 16) { rope8(b1, b2, tb + 8 * cc, tb + 32 + 8 * cc, 1.0f, oa, ob); *(v4u*)(zr + baseB + 8 * cc) = oa; *(v4u*)(zr + baseB + 32 + 8 * cc) = ob; }
        else if (lane < 18) { const int j = lane - 16; rope8(k1, k2, tb + 64 + 8 * j, tb + 80 + 8 * j, 1.0f, oa, ob);
#pragma unroll
            for (int h = 0; h < 6; ++h) { *(v4u*)(KM + (size_t)t * KLD + h * 96 + 64 + 8 * j) = oa; *(v4u*)(KM + (size_t)t * KLD + h * 96 + 80 + 8 * j) = ob; } }
        float s1 = (lane < 48) ? sumsq8(q1) : 0.f, s2 = (lane < 32) ? sumsq8(q2) : 0.f;
        s1 = wave_sum_dpp(s1); s2 = wave_sum_dpp(s2);
        if (lane == 0) { RS[t * 2] = 1.0f / sqrtf(s1 * (1.0f / QRANK) + RMS_EPS); RS[t * 2 + 1] = 1.0f / sqrtf(s2 * (1.0f / KVRANK) + RMS_EPS); } }
}
__device__ __forceinline__ void phase_ret_simple(Frame& F, int l) {
    const int gt = F.vcu * NTHREADS + F.tid, NT = F.G * NTHREADS; const bf16* Z = (const bf16*)(F.wsp() + WS_Z); bf16* YC = (bf16*)(F.wsp() + WS_YCAT); const float* gn = F.in(4) + l * 256;
    for (int ix = gt; ix < NB * 4 * SEQ; ix += NT) { const int t = ix % SEQ, h = (ix / SEQ) % 4, b = ix / (SEQ * 4);
        const float lg2 = __builtin_amdgcn_logf(1.0f - __builtin_amdgcn_exp2f(-5.0f - (float)h));
        const bf16* zb = Z + (size_t)b * SEQ * ZLD; float q[64], o[64];
#pragma unroll
        for (int d = 0; d < 64; d += 8) ld8(zb + (size_t)t * ZLD + ZO_RQ + h * 64 + d, q + d);
#pragma unroll
        for (int d = 0; d < 64; ++d) { q[d] *= 0.125f; o[d] = 0.f; }
        for (int j = 0; j <= t; ++j) { const bf16* kp = zb + (size_t)j * ZLD + ZO_RK + h * 64; const bf16* vp = zb + (size_t)j * ZLD + ZO_RV + h * 64; float s = 0.f;
#pragma unroll
            for (int d = 0; d < 64; d += 8) { float kk[8]; ld8(kp + d, kk);
#pragma unroll
                for (int e = 0; e < 8; ++e) s += q[d + e] * kk[e]; }
            s *= __builtin_amdgcn_exp2f((float)(t - j) * lg2);
#pragma unroll
            for (int d = 0; d < 64; d += 8) { float vv[8]; ld8(vp + d, vv);
#pragma unroll
                for (int e = 0; e < 8; ++e) o[d + e] += s * vv[e]; } }
        float mu = 0.f;
#pragma unroll
        for (int d = 0; d < 64; ++d) mu += o[d];
        mu *= (1.0f / 64.0f); float var = 0.f;
#pragma unroll
        for (int d = 0; d < 64; ++d) { const float dd = o[d] - mu; var += dd * dd; }
        const float rs = 1.0f / sqrtf(var * (1.0f / 64.0f) + LN_EPS);
        const bf16* gp = zb + (size_t)t * ZLD + ZO_RG + h * 64; bf16* yp = YC + ((size_t)b * SEQ + t) * D + YO_RET + h * 64;
#pragma unroll
        for (int d = 0; d < 64; d += 8) { float gg[8]; ld8(gp + d, gg); v4u w; float r[8];
#pragma unroll
            for (int e = 0; e < 8; ++e) r[e] = fsilu(gg[e]) * ((o[d + e] - mu) * rs * gn[h * 64 + d + e]);
            w.x = pk2(r[0], r[1]); w.y = pk2(r[2], r[3]); w.z = pk2(r[4], r[5]); w.w = pk2(r[6], r[7]); *(v4u*)(yp + d) = w; } }
}
__device__ __forceinline__ void phase_dil_simple(Frame& F) {
    const int gt = F.vcu * NTHREADS + F.tid, NT = F.G * NTHREADS; const bf16* Z = (const bf16*)(F.wsp() + WS_Z); bf16* YC = (bf16*)(F.wsp() + WS_YCAT);
    for (int ix = gt; ix < NB * 6 * SEQ; ix += NT) { const int t = ix % SEQ, h = (ix / SEQ) % 6, b = ix / (SEQ * 6);
        const bf16* zb = Z + (size_t)b * SEQ * ZLD; float q[64], o[64];
#pragma unroll
        for (int d = 0; d < 64; d += 8) ld8(zb + (size_t)t * ZLD + ZO_DQ + h * 64 + d, q + d);
#pragma unroll
        for (int d = 0; d < 64; ++d) { q[d] *= 0.125f * LOG2E; o[d] = 0.f; }
        float m = -INFINITY, lsum = 0.f;
        for (int p = 0; p < 3; ++p) { const int r = (p == 0) ? 1 : (p == 1) ? 4 : 16;
            for (int j = 0; j <= 128; ++j) { const int kpos = t - j * r; if (kpos < 0) break;
                const bf16* kp = zb + (size_t)kpos * ZLD + ZO_DK + h * 64; const bf16* vp = zb + (size_t)kpos * ZLD + ZO_DV + h * 64; float s = 0.f;
#pragma unroll
                for (int d = 0; d < 64; d += 8) { float kk[8]; ld8(kp + d, kk);
#pragma unroll
                    for (int e = 0; e < 8; ++e) s += q[d + e] * kk[e]; }
                const float mn = fmaxf(m, s), corr = __builtin_amdgcn_exp2f(m - mn), pe = __builtin_amdgcn_exp2f(s - mn); lsum = lsum * corr + pe; m = mn;
#pragma unroll
                for (int d = 0; d < 64; d += 8) { float vv[8]; ld8(vp + d, vv);
#pragma unroll
                    for (int e = 0; e < 8; ++e) o[d + e] = o[d + e] * corr + pe * vv[e]; } } }
        const float il = 1.0f / lsum; bf16* yp = YC + ((size_t)b * SEQ + t) * D + YO_DIL + h * 64;
#pragma unroll
        for (int d = 0; d < 64; d += 8) { v4u w; w.x = pk2(o[d] * il, o[d + 1] * il); w.y = pk2(o[d + 2] * il, o[d + 3] * il); w.z = pk2(o[d + 4] * il, o[d + 5] * il); w.w = pk2(o[d + 6] * il, o[d + 7] * il); *(v4u*)(yp + d) = w; } }
}
__device__ __forceinline__ void phase_mla_simple(Frame& F) {
    const int gt = F.vcu * NTHREADS + F.tid, NT = F.G * NTHREADS; const bf16* QM = (const bf16*)(F.wsp() + WS_QM); const bf16* KM = (const bf16*)(F.wsp() + WS_KM); const bf16* VM = (const bf16*)(F.wsp() + WS_VM); bf16* YC = (bf16*)(F.wsp() + WS_YCAT);
    for (int ix = gt; ix < NB * 6 * SEQ; ix += NT) { const int t = ix % SEQ, h = (ix / SEQ) % 6, b = ix / (SEQ * 6); const size_t r0 = (size_t)b * SEQ;
        float q[96], o[64];
#pragma unroll
        for (int d = 0; d < 96; d += 8) ld8(QM + (r0 + t) * QLD + h * 96 + d, q + d);
#pragma unroll
        for (int d = 0; d < 64; ++d) o[d] = 0.f;
        float m = -INFINITY, lsum = 0.f;
        for (int j = 0; j <= t; ++j) { const bf16* kp = KM + (r0 + j) * KLD + h * 96; const bf16* vp = VM + (r0 + j) * VLD + h * 64; float s = 0.f;
#pragma unroll
            for (int d = 0; d < 96; d += 8) { float kk[8]; ld8(kp + d, kk);
#pragma unroll
                for (int e = 0; e < 8; ++e) s += q[d + e] * kk[e]; }
            const float mn = fmaxf(m, s), corr = __builtin_amdgcn_exp2f(m - mn), pe = __builtin_amdgcn_exp2f(s - mn); lsum = lsum * corr + pe; m = mn;
#pragma unroll
            for (int d = 0; d < 64; d += 8) { float vv[8]; ld8(vp + d, vv);
#pragma unroll
                for (int e = 0; e < 8; ++e) o[d + e] = o[d + e] * corr + pe * vv[e]; } }
        const float il = 1.0f / lsum; bf16* yp = YC + (r0 + t) * D + YO_MLA + h * 64;
#pragma unroll
        for (int d = 0; d < 64; d += 8) { v4u w; w.x = pk2(o[d] * il, o[d + 1] * il); w.y = pk2(o[d + 2] * il, o[d + 3] * il); w.z = pk2(o[d + 4] * il, o[d + 5] * il); w.w = pk2(o[d + 6] * il, o[d + 7] * il); *(v4u*)(yp + d) = w; } }
}
template <bool MOE_Y>
__device__ __forceinline__ void phase_ln(Frame& F, const float* xin  , float* xout  , const float* gmod  , const float* lng, const float* lnb,
                                         const float* hm  , int sh_off, int sc_off, const float* wr  , int li) {
    const int gw = F.vcu * NWAVES + F.wave, NGW = F.G * NWAVES, lane = F.lane;
    bf16* XB = (bf16*)(F.wsp() + WS_XB); const bf16* Y = (const bf16*)(F.wsp() + WS_Y); bf16* H = (bf16*)(F.wsp() + WS_H); int* TOPI = (int*)(F.wsp() + WS_TOPI); float* GATE = (float*)(F.wsp() + WS_GATE); const int* TSLOT = (const int*)(F.wsp() + WS_TSLOT);
    volatile LAS unsigned* lcnt = F.MISC + 16;
    if (wr) { if (F.tid < 8) lcnt[F.tid] = 0u; __syncthreads(); }
    f32x4 cg[4], cb[4];
#pragma unroll
    for (int j = 0; j < 4; ++j) { cg[j] = *(const f32x4*)(lng + 4 * lane + 256 * j); cb[j] = *(const f32x4*)(lnb + 4 * lane + 256 * j); }
    f32x4 nx[2][4]; v2u nxb[2][4], ny0[2][4], ny1[2][4]; float ng0[2] = {0.f, 0.f}, ng1[2] = {0.f, 0.f};
#define LN_LOAD(R_, t_) do { const int t__ = (t_); const bf16 *y0_, *y1_ = nullptr; if (MOE_Y) { ng0[R_] = GATE[t__ * 2]; ng1[R_] = GATE[t__ * 2 + 1]; y0_ = Y + (size_t)TSLOT[t__ * 2] * D; y1_ = Y + (size_t)TSLOT[t__ * 2 + 1] * D; } else y0_ = Y + (size_t)t__ * D; \
        _Pragma("unroll") for (int j = 0; j < 4; ++j) { const int d = 4 * lane + 256 * j; if (xin) nx[R_][j] = *(const f32x4*)(xin + (size_t)t__ * D + d); else nxb[R_][j] = *(const v2u*)(XB + (size_t)t__ * D + d); ny0[R_][j] = *(const v2u*)(y0_ + d); if (MOE_Y) ny1[R_][j] = *(const v2u*)(y1_ + d); } } while (0)
    int t = gw; if (t < T) LN_LOAD(0, t); if (t + NGW < T) LN_LOAD(1, t + NGW);
    for (; t < T; t += 2 * NGW) {
        f32x4 v[2][4]; float s1[2] = {0.f, 0.f}, s2[2] = {0.f, 0.f};
#pragma unroll
        for (int R = 0; R < 2; ++R) { const int tr = t + R * NGW; if (tr >= T) continue; const int b = tr / SEQ; const float* g = gmod + (size_t)b * 6 * D;
#pragma unroll
            for (int j = 0; j < 4; ++j) { const int d = 4 * lane + 256 * j; const f32x4 gv = *(const f32x4*)(g + d);
                f32x4 yv = (f32x4){bflo(ny0[R][j].x), bfhi(ny0[R][j].x), bflo(ny0[R][j].y), bfhi(ny0[R][j].y)};
                if (MOE_Y) yv = yv * ng0[R] + (f32x4){bflo(ny1[R][j].x), bfhi(ny1[R][j].x), bflo(ny1[R][j].y), bfhi(ny1[R][j].y)} * ng1[R];
                const f32x4 xv = xin ? nx[R][j] : (f32x4){bflo(nxb[R][j].x), bfhi(nxb[R][j].x), bflo(nxb[R][j].y), bfhi(nxb[R][j].y)};
                v[R][j] = xv * DN_ALPHA + (1.0f + gv) * yv; s1[R] += (v[R][j].x + v[R][j].y) + (v[R][j].z + v[R][j].w); s2[R] += (v[R][j].x * v[R][j].x + v[R][j].y * v[R][j].y) + (v[R][j].z * v[R][j].z + v[R][j].w * v[R][j].w); } }
        if (t + 2 * NGW < T) LN_LOAD(0, t + 2 * NGW); if (t + 3 * NGW < T) LN_LOAD(1, t + 3 * NGW);
#pragma unroll
        for (int R = 0; R < 2; ++R) { const int tr = t + R * NGW; if (tr >= T) continue; const int b = tr / SEQ;
            const float sa = wave_sum_dpp(s1[R]), sb = wave_sum_dpp(s2[R]);
            const float mean = sa * (1.f / D); const float rstd = 1.f / sqrtf(fmaxf(sb * (1.f / D) - mean * mean, 0.f) + LN_EPS);
            float lg[8];
#pragma unroll
            for (int e = 0; e < 8; ++e) lg[e] = 0.f;
#pragma unroll
            for (int j = 0; j < 4; ++j) { const int d = 4 * lane + 256 * j; const f32x4 xn = (v[R][j] - mean) * rstd * cg[j] + cb[j];
                if (xout) *(f32x4*)(xout + (size_t)tr * D + d) = xn; else { v2u wx; wx.x = pk2(xn.x, xn.y); wx.y = pk2(xn.z, xn.w); *(v2u*)(XB + (size_t)tr * D + d) = wx; }
                if (hm) { const float* m = hm + (size_t)b * 6 * D; const f32x4 hv = xn * (1.0f + *(const f32x4*)(m + sc_off + d)) + *(const f32x4*)(m + sh_off + d);
                    v2u w; w.x = pk2(hv.x, hv.y); w.y = pk2(hv.z, hv.w); *(v2u*)(H + (size_t)tr * D + d) = w;
                    if (wr) {
#pragma unroll
                        for (int i = 0; i < 4; ++i) { const f32x4 wa = *(const f32x4*)(wr + (size_t)(d + i) * 8), wb = *(const f32x4*)(wr + (size_t)(d + i) * 8 + 4); const float hh = hv[i];
                            lg[0] += hh * wa.x; lg[1] += hh * wa.y; lg[2] += hh * wa.z; lg[3] += hh * wa.w; lg[4] += hh * wb.x; lg[5] += hh * wb.y; lg[6] += hh * wb.z; lg[7] += hh * wb.w; } } } }
            if (wr) {
#pragma unroll
                for (int e = 0; e < 8; ++e) lg[e] = wave_sum_dpp(lg[e]);
                if (lane == 0) { int i0 = 0; float v0 = lg[0];
#pragma unroll
                    for (int e = 1; e < 8; ++e) if (lg[e] > v0) { v0 = lg[e]; i0 = e; }
                    int i1 = 0; float v1 = -INFINITY;
#pragma unroll
                    for (int e = 0; e < 8; ++e) if (e != i0 && lg[e] > v1) { v1 = lg[e]; i1 = e; }
                    const float ga = 1.0f / (1.0f + __expf(v1 - v0)); TOPI[tr * 2] = i0; TOPI[tr * 2 + 1] = i1; GATE[tr * 2] = ga; GATE[tr * 2 + 1] = 1.0f - ga;
                    __hip_atomic_fetch_add((LAS unsigned*)(lcnt + i0), 1u, __ATOMIC_RELAXED, __HIP_MEMORY_SCOPE_WORKGROUP); __hip_atomic_fetch_add((LAS unsigned*)(lcnt + i1), 1u, __ATOMIC_RELAXED, __HIP_MEMORY_SCOPE_WORKGROUP); } } }
    }
#undef LN_LOAD
    if (wr) { __syncthreads(); if (F.tid < 8) __hip_atomic_fetch_add(F.ctl + CW_CNT + 64 * li + F.tid, lcnt[F.tid], RLX_AGENT); }
}
__device__ __forceinline__ void phase_moe_assign(Frame& F, int li) {
    const int gw = F.vcu * NWAVES + F.wave, NGW = F.G * NWAVES, lane = F.lane;
    const int* TOPI = (const int*)(F.wsp() + WS_TOPI); int* TSLOT = (int*)(F.wsp() + WS_TSLOT); int* SEG = (int*)(F.wsp() + WS_SEG); const bf16* H = (const bf16*)(F.wsp() + WS_H); bf16* HS = (bf16*)(F.wsp() + WS_Y);
    int seg[9]; { int acc = 0;
#pragma unroll
        for (int e = 0; e < 8; ++e) { seg[e] = acc; const int c = (int)__hip_atomic_load(F.ctl + CW_CNT + 64 * li + e, RLX_AGENT); acc += (c + 255) & ~255; } seg[8] = acc; }
    if (gw == 0 && lane < 9) { int v = seg[0];
#pragma unroll
        for (int k = 1; k < 9; ++k) v = (lane == k) ? seg[k] : v;
        SEG[lane] = v; }
    volatile LAS unsigned* wcnt = (volatile LAS unsigned*)(F.lds + RING_OFF);
    for (int blk0 = F.vcu * NWAVES; blk0 < T / 16; blk0 += F.G * NWAVES) { const int blk = blk0 + F.wave; const int t = blk * 16 + (lane & 15); const bool act = lane < 16; const int e0 = act ? TOPI[t * 2] : -1, e1 = act ? TOPI[t * 2 + 1] : -1; int s0 = 0, s1 = 0;
        const unsigned long long lt = (1ull << lane) - 1ull; unsigned long long m0[8], m1[8];
#pragma unroll
        for (int e = 0; e < 8; ++e) { m0[e] = __ballot(e0 == e); m1[e] = __ballot(e1 == e); }
        __syncthreads();
        if (lane < 8) { unsigned c = 0;
#pragma unroll
            for (int e = 0; e < 8; ++e) c = (lane == e) ? (unsigned)(__popcll(m0[e]) + __popcll(m1[e])) : c;
            wcnt[F.wave * 8 + lane] = c; }
        __syncthreads();
        if (F.tid < 8) { unsigned run = 0, pre[8];
#pragma unroll
            for (int w = 0; w < 8; ++w) { pre[w] = run; run += wcnt[w * 8 + F.tid]; }
            const unsigned gb = run ? __hip_atomic_fetch_add(F.ctl + CW_CUR + 64 * li + F.tid, run, RLX_AGENT) : 0u;
#pragma unroll
            for (int w = 0; w < 8; ++w) wcnt[64 + w * 8 + F.tid] = gb + pre[w]; }
        __syncthreads();
#pragma unroll
        for (int e = 0; e < 8; ++e) { const int base = (int)wcnt[64 + F.wave * 8 + e] + seg[e]; const int c0 = __popcll(m0[e]);
            if (e0 == e) s0 = base + __popcll(m0[e] & lt); if (e1 == e) s1 = base + c0 + __popcll(m1[e] & lt); }
        if (act) { TSLOT[t * 2] = s0; TSLOT[t * 2 + 1] = s1; }
#pragma unroll 1
        for (int i0 = 0; i0 < 16; i0 += 4) { v4u hv[4][2]; int sa[4], sb[4];
#pragma unroll
            for (int q = 0; q < 4; ++q) { const bf16* src = H + (size_t)(blk * 16 + i0 + q) * D; hv[q][0] = *(const v4u*)(src + lane * 8); hv[q][1] = *(const v4u*)(src + 512 + lane * 8); sa[q] = __builtin_amdgcn_readlane(s0, i0 + q); sb[q] = __builtin_amdgcn_readlane(s1, i0 + q); }
#pragma unroll
            for (int q = 0; q < 4; ++q)
#pragma unroll
                for (int k = 0; k < 2; ++k) { const v4u x = hv[q][k]; v2u w; w.x = pg8::pack4_fp8(bflo(x.x) * 8.f, bfhi(x.x) * 8.f, bflo(x.y) * 8.f, bfhi(x.y) * 8.f); w.y = pg8::pack4_fp8(bflo(x.z) * 8.f, bfhi(x.z) * 8.f, bflo(x.w) * 8.f, bfhi(x.w) * 8.f);
                    *(v2u*)((unsigned char*)HS + (size_t)sa[q] * D + k * 512 + lane * 8) = w; *(v2u*)((unsigned char*)HS + (size_t)sb[q] * D + k * 512 + lane * 8) = w; } } }
}
typedef float f32x16 __attribute__((ext_vector_type(16)));
typedef short bf16x8v __attribute__((ext_vector_type(8)));
typedef short s16x4 __attribute__((ext_vector_type(4)));
typedef float f32x2v __attribute__((ext_vector_type(2)));
typedef __bf16 bf16x2v __attribute__((ext_vector_type(2)));
#define MFMA32(a, b, c) __builtin_amdgcn_mfma_f32_32x32x16_bf16((a), (b), (c), 0, 0, 0)
__device__ __forceinline__ int crow(int reg, int hh) { return (reg & 3) + 8 * (reg >> 2) + 4 * hh; }
__device__ __forceinline__ unsigned cvtpk(float lo, float hi) { f32x2v v = {lo, hi}; bf16x2v b = __builtin_convertvector(v, bf16x2v); return __builtin_bit_cast(unsigned, b); }
__device__ __forceinline__ bf16x8v pack8(const f32x16& x, int s) { v4u p; p.x = cvtpk(x[8 * s], x[8 * s + 1]); p.y = cvtpk(x[8 * s + 2], x[8 * s + 3]); p.z = cvtpk(x[8 * s + 4], x[8 * s + 5]); p.w = cvtpk(x[8 * s + 6], x[8 * s + 7]); return __builtin_bit_cast(bf16x8v, p); }
__device__ __forceinline__ s16x4 trread(const LAS unsigned char* p) { return __builtin_bit_cast(s16x4, __builtin_amdgcn_ds_read_tr16_b64_v4i16((LAS s16x4*)p)); }
__device__ __forceinline__ bf16x8v vt_frag(const LAS unsigned char* vtile, int VP, int krow0, int dvb, int lane) {
    const int i = lane & 15, q_ = i >> 2, p_ = i & 3, hh = lane >> 5, blk = (lane >> 4) & 1;
    const LAS unsigned char* a = vtile + (krow0 + 4 * hh + q_) * VP + (32 * dvb + 16 * blk + 4 * p_) * 2;
    const s16x4 lo = trread(a), hi = trread(a + 8 * VP);
    return (bf16x8v){lo[0], lo[1], lo[2], lo[3], hi[0], hi[1], hi[2], hi[3]};
}
__device__ __forceinline__ float xhalf_max(float m) { auto rr = __builtin_amdgcn_permlane32_swap(__float_as_uint(m), __float_as_uint(m), false, false); return fmaxf(__uint_as_float(rr[0]), __uint_as_float(rr[1])); }
__device__ __forceinline__ float xhalf_sum(float m) { auto rr = __builtin_amdgcn_permlane32_swap(__float_as_uint(m), __float_as_uint(m), false, false); return __uint_as_float(rr[0]) + __uint_as_float(rr[1]); }
template <int NS>
__device__ __forceinline__ void softmax_pv(f32x16 (&st)[NS], float& m_run, float& l_run, f32x16 (&ot)[2], const LAS unsigned char* vtile, int VP, int krow0, int lane) {
    float mt = st[0][0];
#pragma unroll
    for (int n = 0; n < NS; ++n)
#pragma unroll
        for (int i = 0; i < 16; ++i) mt = fmaxf(mt, st[n][i]);
    mt = xhalf_max(mt);
    if (__any(mt > m_run)) {
        const float m_new = fmaxf(m_run, mt), corr = __builtin_amdgcn_exp2f(m_run - fmaxf(m_new, -1e30f));
        l_run *= corr; m_run = m_new;
#pragma unroll
        for (int d = 0; d < 2; ++d)
#pragma unroll
            for (int i = 0; i < 16; ++i) ot[d][i] *= corr;
    }
    const float m_use = fmaxf(m_run, -1e30f); float ls = 0.f;
#pragma unroll
    for (int n = 0; n < NS; ++n)
#pragma unroll
        for (int i = 0; i < 16; ++i) { st[n][i] = __builtin_amdgcn_exp2f(st[n][i] - m_use); ls += st[n][i]; }
    l_run += ls;
#pragma unroll
    for (int n = 0; n < NS; ++n) { const bf16x8v p0 = pack8(st[n], 0), p1 = pack8(st[n], 1);
#pragma unroll
        for (int d = 0; d < 2; ++d) { ot[d] = MFMA32(vt_frag(vtile, VP, krow0 + 32 * n, d, lane), p0, ot[d]); ot[d] = MFMA32(vt_frag(vtile, VP, krow0 + 32 * n + 16, d, lane), p1, ot[d]); } }
}
__device__ __forceinline__ int queue_pull(Frame& F, gu32* head) {
    __syncthreads();
    if (F.tid == 0) F.MISC[24] = __hip_atomic_fetch_add(head, 1u, RLX_AGENT);
    __syncthreads();
    return (int)F.MISC[24];
}

constexpr int MLA_KP = 208, MLA_VP = 144, MLA_KBYTES = 64 * MLA_KP, MLA_VBYTES = 64 * MLA_VP, MLA_VOFF = 2 * MLA_KBYTES;
__device__ __forceinline__ void mla_unit(Frame& F, int b, int h, int qb) {
    const int lane = F.lane, w = F.wave, tid = F.tid, r = lane & 31, hh = lane >> 5;
    const bf16* QM = (const bf16*)(F.wsp() + WS_QM); const bf16* KM = (const bf16*)(F.wsp() + WS_KM); const bf16* VM = (const bf16*)(F.wsp() + WS_VM); bf16* YC = (bf16*)(F.wsp() + WS_YCAT);
    LAS unsigned char* lds = F.lds + RING_OFF;
    const size_t row0 = (size_t)b * SEQ;
    const int qpos = qb * 256 + 32 * w + r;
    const int qmax_w = qb * 256 + 32 * w + 31, qmin_w = qb * 256 + 32 * w;
    bf16x8v qf[6];
#pragma unroll
    for (int s = 0; s < 6; ++s) qf[s] = *(const bf16x8v*)(QM + (row0 + qpos) * QLD + h * 96 + 16 * s + 8 * hh);
    const int kc0 = tid, kc1 = 512 + tid; const bool k1 = tid < 256;
    const int kr0 = kc0 / 12, kch0 = kc0 % 12, kr1 = kc1 / 12, kch1 = kc1 % 12, vr = tid >> 3, vch = tid & 7;
    const bf16* ksrc0 = KM + (row0 + kr0) * KLD + h * 96 + kch0 * 8; const bf16* ksrc1 = KM + (row0 + kr1) * KLD + h * 96 + kch1 * 8; const bf16* vsrc = VM + (row0 + vr) * VLD + h * 64 + vch * 8;
    const int kdst0 = kr0 * MLA_KP + kch0 * 16, kdst1 = kr1 * MLA_KP + kch1 * 16, vdst = MLA_VOFF + vr * MLA_VP + vch * 16;
    const int NT = (qb + 1) * 4;
    v4u kreg0, kreg1 = (v4u){0u, 0u, 0u, 0u}, vreg;
    kreg0 = *(const v4u*)ksrc0; if (k1) kreg1 = *(const v4u*)ksrc1; vreg = *(const v4u*)vsrc;
    __syncthreads();
    *(LAS v4u*)(lds + kdst0) = kreg0; if (k1) *(LAS v4u*)(lds + kdst1) = kreg1; *(LAS v4u*)(lds + vdst) = vreg;
    __syncthreads();
    float m_run = -INFINITY, l_run = 0.f; f32x16 ot[2];
#pragma unroll
    for (int i = 0; i < 16; ++i) { ot[0][i] = 0.f; ot[1][i] = 0.f; }
    for (int t = 0; t < NT; ++t) {
        const int buf = t & 1;
        if (t + 1 < NT) { const size_t o = (size_t)(t + 1) * 64; kreg0 = *(const v4u*)(ksrc0 + o * KLD); if (k1) kreg1 = *(const v4u*)(ksrc1 + o * KLD); vreg = *(const v4u*)(vsrc + o * VLD); }
        const LAS unsigned char* kt = lds + buf * MLA_KBYTES; const LAS unsigned char* vt = lds + MLA_VOFF + buf * MLA_VBYTES;
        const int kb = 64 * t;
        if (kb <= qmax_w) {
            if (kb + 32 <= qmax_w) {
                f32x16 st[2];
#pragma unroll
                for (int i = 0; i < 16; ++i) { st[0][i] = 0.f; st[1][i] = 0.f; }
#pragma unroll
                for (int s = 0; s < 6; ++s) { const bf16x8v kf0 = *(const LAS bf16x8v*)(kt + r * MLA_KP + (16 * s + 8 * hh) * 2), kf1 = *(const LAS bf16x8v*)(kt + (32 + r) * MLA_KP + (16 * s + 8 * hh) * 2);
                    st[0] = MFMA32(kf0, qf[s], st[0]); st[1] = MFMA32(kf1, qf[s], st[1]); }
                if (kb + 63 > qmin_w) {
#pragma unroll
                    for (int i = 0; i < 16; ++i) { if (kb + crow(i, hh) > qpos) st[0][i] = -INFINITY; if (kb + 32 + crow(i, hh) > qpos) st[1][i] = -INFINITY; } }
                softmax_pv<2>(st, m_run, l_run, ot, vt, MLA_VP, 0, lane);
            } else {
                f32x16 st[1];
#pragma unroll
                for (int i = 0; i < 16; ++i) st[0][i] = 0.f;
#pragma unroll
                for (int s = 0; s < 6; ++s) { const bf16x8v kf0 = *(const LAS bf16x8v*)(kt + r * MLA_KP + (16 * s + 8 * hh) * 2); st[0] = MFMA32(kf0, qf[s], st[0]); }
#pragma unroll
                for (int i = 0; i < 16; ++i) if (kb + crow(i, hh) > qpos) st[0][i] = -INFINITY;
                softmax_pv<1>(st, m_run, l_run, ot, vt, MLA_VP, 0, lane);
            } }
        if (t + 1 < NT) { const int nb = buf ^ 1; *(LAS v4u*)(lds + nb * MLA_KBYTES + kdst0) = kreg0; if (k1) *(LAS v4u*)(lds + nb * MLA_KBYTES + kdst1) = kreg1; *(LAS v4u*)(lds + nb * MLA_VBYTES + vdst) = vreg; }
        __syncthreads();
    }
    const float inv = 1.0f / xhalf_sum(l_run);
    bf16* yp = YC + (row0 + qpos) * D + YO_MLA + h * 64;
#pragma unroll
    for (int d = 0; d < 2; ++d)
#pragma unroll
        for (int g4 = 0; g4 < 4; ++g4) { v2u wv; wv.x = cvtpk(ot[d][4 * g4] * inv, ot[d][4 * g4 + 1] * inv); wv.y = cvtpk(ot[d][4 * g4 + 2] * inv, ot[d][4 * g4 + 3] * inv);
            *(v2u*)(yp + 32 * d + 8 * g4 + 4 * hh) = wv; }
}
constexpr int M3_KBYTES = 12288, M3_VBYTES = 8192, M3_VOFF = 2 * M3_KBYTES;
__device__ __forceinline__ bf16x8v vt_frag3(const LAS unsigned char* vtile, int krow0, int dvb, int lane) {
    const int i = lane & 15, q_ = i >> 2, p_ = i & 3, hh = lane >> 5, blk = (lane >> 4) & 1;
    const LAS unsigned char* a = vtile + ((dvb * 4 + (krow0 >> 4)) << 10) + (4 * hh + q_) * 64 + (16 * blk + 4 * p_) * 2;
    const s16x4 lo = trread(a), hi = trread(a + 512);
    return (bf16x8v){lo[0], lo[1], lo[2], lo[3], hi[0], hi[1], hi[2], hi[3]};
}
__device__ __forceinline__ void mla_unit2(Frame& F, int b, int h, int qb) {
    const int lane = F.lane, w = F.wave, r = lane & 31, hh = lane >> 5;
    const bf16* QM = (const bf16*)(F.wsp() + WS_QM); const bf16* KM = (const bf16*)(F.wsp() + WS_KM); const bf16* VM = (const bf16*)(F.wsp() + WS_VM); bf16* YC = (bf16*)(F.wsp() + WS_YCAT);
    LAS unsigned char* lds = F.lds + RING_OFF;
    const size_t row0 = (size_t)b * SEQ;
    const int qbase = qb * 512 + 64 * w;
    const int qposA = qbase + r, qposB = qbase + 32 + r;
    bf16x8v qf[2][6];
#pragma unroll
    for (int s = 0; s < 6; ++s) { qf[0][s] = *(const bf16x8v*)(QM + (row0 + qposA) * QLD + h * 96 + 16 * s + 8 * hh); qf[1][s] = *(const bf16x8v*)(QM + (row0 + qposB) * QLD + h * 96 + 16 * s + 8 * hh); }
    const int li = lane >> 2, lc = lane & 3; const bool isK = w < 4; const int p0 = 2 * (w & 3);
    const bf16* dbase = isK ? KM + row0 * KLD + h * 96 : VM + row0 * VLD + h * 64;
    const int doff = isK ? (16 * w + li) * KLD + ((lc ^ ((li >> 2) & 3)) << 3) : (16 * (p0 & 3) + li) * VLD + 32 * (p0 >> 2) + 8 * lc;
    const int dsrc_j = isK ? 32 : 16 * VLD, dstep = isK ? 64 * KLD : 64 * VLD, ddst = isK ? 3 * w * 1024 : M3_VOFF + p0 * 1024, dbuf = isK ? M3_KBYTES : M3_VBYTES;
#define M3_DMA(t_, buf_) do { const bf16* s_ = dbase + (doff + (t_) * dstep); const int d_ = ddst + (buf_) * dbuf; \
        __builtin_amdgcn_global_load_lds((const unsigned*)s_, (LAS unsigned*)(lds + d_), 16, 0, 0); __builtin_amdgcn_global_load_lds((const unsigned*)(s_ + dsrc_j), (LAS unsigned*)(lds + d_ + 1024), 16, 0, 0); \
        if (isK) __builtin_amdgcn_global_load_lds((const unsigned*)(s_ + 2 * dsrc_j), (LAS unsigned*)(lds + d_ + 2048), 16, 0, 0); } while (0)
    const int NT = (qb + 1) * 8;
    __syncthreads();
    M3_DMA(0, 0);
    asm volatile("s_waitcnt vmcnt(0)" ::: "memory"); __syncthreads();
    const int kl = r & 15, kx = (kl >> 2) & 3, kbase = ((r >> 4) * 3) * 1024 + kl * 64;
    float m_run[2] = {-INFINITY, -INFINITY}, l_run[2] = {0.f, 0.f}; f32x16 ot[2][2];
#pragma unroll
    for (int i = 0; i < 16; ++i) { ot[0][0][i] = 0.f; ot[0][1][i] = 0.f; ot[1][0][i] = 0.f; ot[1][1][i] = 0.f; }
    for (int t = 0; t < NT; ++t) {
        const int buf = t & 1;
        if (t + 1 < NT) M3_DMA(t + 1, buf ^ 1);
        const LAS unsigned char* kt = lds + buf * M3_KBYTES; const LAS unsigned char* vt = lds + M3_VOFF + buf * M3_VBYTES;
        const int kb = 64 * t;
#pragma unroll
        for (int n = 0; n < 2; ++n) { const int kbn = kb + 32 * n;
            if (kbn <= qbase + 63) {
                f32x16 sa, sb;
#pragma unroll
                for (int i = 0; i < 16; ++i) { sa[i] = 0.f; sb[i] = 0.f; }
#pragma unroll
                for (int s = 0; s < 6; ++s) { const int c = 2 * s + hh; const bf16x8v kf = *(const LAS bf16x8v*)(kt + n * 6144 + kbase + (c >> 2) * 1024 + (((c & 3) ^ kx) << 4)); sa = MFMA32(kf, qf[0][s], sa); sb = MFMA32(kf, qf[1][s], sb); }
                if (kbn + 31 > qbase) {
#pragma unroll
                    for (int i = 0; i < 16; ++i) { const int k0 = kbn + crow(i, hh); if (k0 > qposA) sa[i] = -INFINITY; if (k0 > qposB) sb[i] = -INFINITY; } }
                float mtA = sa[0], mtB = sb[0];
#pragma unroll
                for (int i = 1; i < 16; ++i) { mtA = fmaxf(mtA, sa[i]); mtB = fmaxf(mtB, sb[i]); }
                mtA = xhalf_max(mtA); mtB = xhalf_max(mtB);
                if (__any(mtA > m_run[0] || mtB > m_run[1])) {
                    const float nA = fmaxf(m_run[0], mtA), nB = fmaxf(m_run[1], mtB), cA = __builtin_amdgcn_exp2f(m_run[0] - fmaxf(nA, -1e30f)), cB = __builtin_amdgcn_exp2f(m_run[1] - fmaxf(nB, -1e30f));
                    l_run[0] *= cA; l_run[1] *= cB; m_run[0] = nA; m_run[1] = nB;
#pragma unroll
                    for (int d = 0; d < 2; ++d)
#pragma unroll
                        for (int i = 0; i < 16; ++i) { ot[0][d][i] *= cA; ot[1][d][i] *= cB; } }
                const float muA = fmaxf(m_run[0], -1e30f), muB = fmaxf(m_run[1], -1e30f); float lsA = 0.f, lsB = 0.f;
#pragma unroll
                for (int i = 0; i < 16; ++i) { sa[i] = __builtin_amdgcn_exp2f(sa[i] - muA); lsA += sa[i]; sb[i] = __builtin_amdgcn_exp2f(sb[i] - muB); lsB += sb[i]; }
                l_run[0] += lsA; l_run[1] += lsB;
                const bf16x8v pa0 = pack8(sa, 0), pa1 = pack8(sa, 1), pb0 = pack8(sb, 0), pb1 = pack8(sb, 1);
#pragma unroll
                for (int d = 0; d < 2; ++d) { const bf16x8v v0 = vt_frag3(vt, 32 * n, d, lane), v1 = vt_frag3(vt, 32 * n + 16, d, lane);
                    ot[0][d] = MFMA32(v0, pa0, ot[0][d]); ot[1][d] = MFMA32(v0, pb0, ot[1][d]); ot[0][d] = MFMA32(v1, pa1, ot[0][d]); ot[1][d] = MFMA32(v1, pb1, ot[1][d]); }
            } }
        asm volatile("s_waitcnt vmcnt(0)" ::: "memory"); __syncthreads();
    }
#undef M3_DMA
#pragma unroll
    for (int qi = 0; qi < 2; ++qi) { const float inv = 1.0f / xhalf_sum(l_run[qi]); bf16* yp = YC + (row0 + qbase + 32 * qi + r) * D + YO_MLA + h * 64;
#pragma unroll
        for (int d = 0; d < 2; ++d)
#pragma unroll
            for (int g4 = 0; g4 < 4; ++g4) { v2u wv; wv.x = cvtpk(ot[qi][d][4 * g4] * inv, ot[qi][d][4 * g4 + 1] * inv); wv.y = cvtpk(ot[qi][d][4 * g4 + 2] * inv, ot[qi][d][4 * g4 + 3] * inv);
                *(v2u*)(yp + 32 * d + 8 * g4 + 4 * hh) = wv; } }
}
__device__ __forceinline__ void phase_mla_mfma(Frame& F, int l, int rep) {
    gu32* head = F.ctl + CW_Q + 64 * (4 * l + rep);
    for (;;) { const int idx = queue_pull(F, head); if (idx >= 48 * 8) break; const int qb = 7 - idx / 48, bh = idx % 48; mla_unit2(F, bh / 6, bh % 6, qb); }
}
constexpr int DIL_P = 144, DIL_VOFF = 384 * DIL_P;
struct DilUnit { int b, h, p, rho, u; };
__device__ __forceinline__ bool dil_decode(int idx, DilUnit& d) { if (idx >= 48 * 48) return false; const int bh = idx / 48, wi = idx % 48; d.b = bh / 6; d.h = bh % 6;
    if (wi < 16) { d.p = 0; d.rho = 0; d.u = wi; } else if (wi < 32) { d.p = 1; d.rho = (wi - 16) >> 2; d.u = (wi - 16) & 3; } else { d.p = 2; d.rho = wi - 32; d.u = 0; } return true; }
__device__ __forceinline__ void dil_fetch(Frame& F, const DilUnit& d, v4u (&kv)[6], v4u (&vv)[6]) {
    const bf16* Z = (const bf16*)(F.wsp() + WS_Z); const int rs = (d.p == 0) ? 1 : (d.p == 1) ? 4 : 16; const size_t row0 = (size_t)d.b * SEQ; const int m0 = 256 * d.u - 128;
#pragma unroll
    for (int i = 0; i < 6; ++i) { const int c = F.tid + 512 * i, kk = c >> 3, ch = c & 7, mm = m0 + kk; kv[i] = (v4u){0u, 0u, 0u, 0u}; vv[i] = (v4u){0u, 0u, 0u, 0u};
        if (mm >= 0) { const bf16* src = Z + (row0 + (size_t)mm * rs + d.rho) * ZLD + d.h * 64 + ch * 8; kv[i] = *(const v4u*)(src + ZO_DK); vv[i] = *(const v4u*)(src + ZO_DV); } }
}
__device__ __forceinline__ void dil_compute(Frame& F, const DilUnit& d) {
    const int lane = F.lane, w = F.wave, r = lane & 31, hh = lane >> 5; const int b = d.b, h = d.h, p = d.p, rho = d.rho, u = d.u;
    const int rs = (p == 0) ? 1 : (p == 1) ? 4 : 16;
    const bf16* Z = (const bf16*)(F.wsp() + WS_Z); bf16* DO = (bf16*)(F.wsp() + WS_DILO) + (size_t)p * T * 384; float* DL = (float*)(F.wsp() + WS_DILL) + (size_t)p * T * 6;
    LAS unsigned char* lds = F.lds + RING_OFF;
    const size_t row0 = (size_t)b * SEQ;
    const int m0 = 256 * u - 128;
    const int mq = 256 * u + 32 * w + r; const size_t rowq = row0 + (size_t)mq * rs + rho;
    bf16x8v qf[4];
#pragma unroll
    for (int s = 0; s < 4; ++s) qf[s] = *(const bf16x8v*)(Z + rowq * ZLD + ZO_DQ + h * 64 + 16 * s + 8 * hh);
    float m_run = -INFINITY, l_run = 0.f; f32x16 ot[2];
#pragma unroll
    for (int i = 0; i < 16; ++i) { ot[0][i] = 0.f; ot[1][i] = 0.f; }
#define DIL_QK(ST, KT) do { _Pragma("unroll") for (int i = 0; i < 16; ++i) ST[i] = 0.f; \
        _Pragma("unroll") for (int s = 0; s < 4; ++s) { const bf16x8v kf = *(const LAS bf16x8v*)(lds + (32 * (KT) + r) * DIL_P + (16 * s + 8 * hh) * 2); ST = MFMA32(kf, qf[s], ST); } \
        _Pragma("unroll") for (int i = 0; i < 16; ++i) { const int mk = m0 + 32 * (KT) + crow(i, hh); if (mk < 0 || mk > mq || mk < mq - 128) ST[i] = -INFINITY; } } while (0)
    if (m0 + 32 * w + 31 >= 0) { f32x16 st[2]; DIL_QK(st[0], w); DIL_QK(st[1], w + 1); softmax_pv<2>(st, m_run, l_run, ot, lds + DIL_VOFF, DIL_P, 32 * w, lane); }
    else if (m0 + 32 * (w + 1) + 31 >= 0) { f32x16 st[1]; DIL_QK(st[0], w + 1); softmax_pv<1>(st, m_run, l_run, ot, lds + DIL_VOFF, DIL_P, 32 * (w + 1), lane); }
    if (m0 + 32 * (w + 2) + 31 >= 0) { f32x16 st[2]; DIL_QK(st[0], w + 2); DIL_QK(st[1], w + 3); softmax_pv<2>(st, m_run, l_run, ot, lds + DIL_VOFF, DIL_P, 32 * (w + 2), lane); }
    else if (m0 + 32 * (w + 3) + 31 >= 0) { f32x16 st[1]; DIL_QK(st[0], w + 3); softmax_pv<1>(st, m_run, l_run, ot, lds + DIL_VOFF, DIL_P, 32 * (w + 3), lane); }
    { f32x16 st[1]; DIL_QK(st[0], w + 4); softmax_pv<1>(st, m_run, l_run, ot, lds + DIL_VOFF, DIL_P, 32 * (w + 4), lane); }
#undef DIL_QK
    const float lt = xhalf_sum(l_run), inv = 1.0f / lt;
    bf16* op = DO + rowq * 384 + h * 64;
#pragma unroll
    for (int d = 0; d < 2; ++d)
#pragma unroll
        for (int g4 = 0; g4 < 4; ++g4) { v2u wv; wv.x = cvtpk(ot[d][4 * g4] * inv, ot[d][4 * g4 + 1] * inv); wv.y = cvtpk(ot[d][4 * g4 + 2] * inv, ot[d][4 * g4 + 3] * inv);
            *(v2u*)(op + 32 * d + 8 * g4 + 4 * hh) = wv; }
    if (hh == 0) DL[rowq * 6 + h] = m_run + __builtin_amdgcn_logf(lt);
}
__device__ __forceinline__ void phase_dil_mfma(Frame& F) {
    LAS unsigned char* lds = F.lds + RING_OFF; DilUnit cur, nxt; v4u kv[6], vv[6];
    int idx = (int)blockIdx.x; bool have = dil_decode(idx, cur);
    if (have) dil_fetch(F, cur, kv, vv);
    while (have) {
        __syncthreads();
#pragma unroll
        for (int i = 0; i < 6; ++i) { const int c = F.tid + 512 * i, kk = c >> 3, ch = c & 7; *(LAS v4u*)(lds + kk * DIL_P + ch * 16) = kv[i]; *(LAS v4u*)(lds + DIL_VOFF + kk * DIL_P + ch * 16) = vv[i]; }
        __syncthreads();
        idx += F.G; const bool hn = dil_decode(idx, nxt);
        if (hn) dil_fetch(F, nxt, kv, vv);
        dil_compute(F, cur);
        cur = nxt; have = hn;
    }
}
__device__ __forceinline__ void dil_merge_range(Frame& F, int gt, int NT, int lo, int hi);
__device__ __forceinline__ void phase_dil_merge(Frame& F) { dil_merge_range(F, F.vcu * NTHREADS + F.tid, F.G * NTHREADS, 0, T * 48); }
__device__ __forceinline__ void dil_merge_range(Frame& F, int gt, int NT, int lo, int hi) {
    const bf16* DO = (const bf16*)(F.wsp() + WS_DILO); const float* DL = (const float*)(F.wsp() + WS_DILL); bf16* YC = (bf16*)(F.wsp() + WS_YCAT);
    for (int ix = lo + gt; ix < hi; ix += NT) { const int t = ix / 48, c = ix % 48, h = c >> 3;
        const float l0 = DL[(size_t)t * 6 + h], l1 = DL[(size_t)T * 6 + (size_t)t * 6 + h], l2 = DL[(size_t)2 * T * 6 + (size_t)t * 6 + h];
        const float mx = fmaxf(l0, fmaxf(l1, l2)); float w0 = __builtin_amdgcn_exp2f(l0 - mx), w1 = __builtin_amdgcn_exp2f(l1 - mx), w2 = __builtin_amdgcn_exp2f(l2 - mx); const float inv = 1.0f / (w0 + w1 + w2); w0 *= inv; w1 *= inv; w2 *= inv;
        float a[8], bb[8], cc[8]; ld8(DO + (size_t)t * 384 + c * 8, a); ld8(DO + (size_t)T * 384 + (size_t)t * 384 + c * 8, bb); ld8(DO + (size_t)2 * T * 384 + (size_t)t * 384 + c * 8, cc);
        v4u o; o.x = pk2(w0 * a[0] + w1 * bb[0] + w2 * cc[0], w0 * a[1] + w1 * bb[1] + w2 * cc[1]); o.y = pk2(w0 * a[2] + w1 * bb[2] + w2 * cc[2], w0 * a[3] + w1 * bb[3] + w2 * cc[3]);
        o.z = pk2(w0 * a[4] + w1 * bb[4] + w2 * cc[4], w0 * a[5] + w1 * bb[5] + w2 * cc[5]); o.w = pk2(w0 * a[6] + w1 * bb[6] + w2 * cc[6], w0 * a[7] + w1 * bb[7] + w2 * cc[7]);
        *(v4u*)(YC + (size_t)t * D + YO_DIL + c * 8) = o; }
}

__device__ __forceinline__ bf16x8v tr_frag_nat(const LAS unsigned char* tile, int P, int krow0, int colblk, int lane) {
    const int i = lane & 15, q_ = i >> 2, p_ = i & 3, hh = lane >> 5, blk = (lane >> 4) & 1;
    const LAS unsigned char* a = tile + (krow0 + 8 * hh + q_) * P + (32 * colblk + 16 * blk + 4 * p_) * 2;
    const s16x4 lo = trread(a), hi = trread(a + 4 * P);
    return (bf16x8v){lo[0], lo[1], lo[2], lo[3], hi[0], hi[1], hi[2], hi[3]};
}
__device__ __forceinline__ float ret_lg2(int h) { return __builtin_amdgcn_logf(1.0f - __builtin_amdgcn_exp2f(-5.0f - (float)h)); }
constexpr int RET_P = 144, RET_VOFF = 256 * RET_P, RET_SOFF = 2 * 256 * RET_P, RET_SBYTES = 64 * RET_P;
__device__ __forceinline__ void ret_state_unit(Frame& F, int b, int h, int cp) {
    const int lane = F.lane, w = F.wave, tid = F.tid, r = lane & 31, hh = lane >> 5;
    const bf16* Z = (const bf16*)(F.wsp() + WS_Z); float* KVS = (float*)(F.wsp() + WS_KVS);
    LAS unsigned char* lds = F.lds + RING_OFF; const size_t row0 = (size_t)b * SEQ + 256 * cp; const float lg2 = ret_lg2(h);
    __syncthreads();
#pragma unroll
    for (int i = 0; i < 4; ++i) { const int c = tid + 512 * i, kk = c >> 3, ch = c & 7; const bf16* src = Z + (row0 + kk) * ZLD + h * 64 + ch * 8;
        float kf[8]; ld8(src + ZO_RK, kf); const float sc = 0.125f * __builtin_amdgcn_exp2f((float)(127 - (kk & 127)) * lg2);
        v4u kv; kv.x = cvtpk(kf[0] * sc, kf[1] * sc); kv.y = cvtpk(kf[2] * sc, kf[3] * sc); kv.z = cvtpk(kf[4] * sc, kf[5] * sc); kv.w = cvtpk(kf[6] * sc, kf[7] * sc);
        *(LAS v4u*)(lds + kk * RET_P + ch * 16) = kv; *(LAS v4u*)(lds + RET_VOFF + kk * RET_P + ch * 16) = *(const v4u*)(src + ZO_RV); }
    __syncthreads();
    const int ci = w >> 2, dvb = (w >> 1) & 1, dkb = w & 1;
    f32x16 acc;
#pragma unroll
    for (int i = 0; i < 16; ++i) acc[i] = 0.f;
#pragma unroll
    for (int ks = 0; ks < 8; ++ks) { const int k0 = 128 * ci + 16 * ks; acc = MFMA32(tr_frag_nat(lds + RET_VOFF, RET_P, k0, dvb, lane), tr_frag_nat(lds, RET_P, k0, dkb, lane), acc); }
    float* dst = KVS + ((size_t)((b * 4 + h) * 32 + 2 * cp + ci)) * 4096;
#pragma unroll
    for (int i = 0; i < 16; ++i) dst[(32 * dvb + crow(i, hh)) * 64 + 32 * dkb + r] = acc[i];
}
__device__ __forceinline__ void phase_ret_state(Frame& F) {
    for (int idx = (int)blockIdx.x; idx < 32 * 16; idx += F.G) { const int bh = idx >> 4, cp = idx & 15; ret_state_unit(F, bh >> 2, bh & 3, cp); }
}
__device__ __forceinline__ void ret_out_unit(Frame& F, int l, int b, int h, int cp) {
    const int lane = F.lane, w = F.wave, tid = F.tid, r = lane & 31, hh = lane >> 5;
    const bf16* Z = (const bf16*)(F.wsp() + WS_Z); const float* KVS = (const float*)(F.wsp() + WS_KVS); bf16* YC = (bf16*)(F.wsp() + WS_YCAT); const float* gn = F.in(4) + l * 256 + h * 64;
    LAS unsigned char* lds = F.lds + RING_OFF; const size_t row0 = (size_t)b * SEQ + 256 * cp; const float lg2 = ret_lg2(h);
    const int ci = w >> 2, wi = w & 3, c = 2 * cp + ci;
    __syncthreads();
#pragma unroll
    for (int i = 0; i < 4; ++i) { const int cc = tid + 512 * i, kk = cc >> 3, ch = cc & 7; const bf16* src = Z + (row0 + kk) * ZLD + h * 64 + ch * 8;
        *(LAS v4u*)(lds + kk * RET_P + ch * 16) = *(const v4u*)(src + ZO_RK); *(LAS v4u*)(lds + RET_VOFF + kk * RET_P + ch * 16) = *(const v4u*)(src + ZO_RV); }
    {
        const int tl = tid & 255; const float dec = __builtin_amdgcn_exp2f(128.0f * lg2); const float* base = KVS + (size_t)((b * 4 + h) * 32) * 4096 + tl * 4;
        f32x4 a[4];
#pragma unroll
        for (int k = 0; k < 4; ++k) a[k] = (f32x4){0.f, 0.f, 0.f, 0.f};
        int m = 0;
        for (; m + 4 <= c; m += 4) { f32x4 ld[4][4];
#pragma unroll
            for (int u4 = 0; u4 < 4; ++u4)
#pragma unroll
                for (int k = 0; k < 4; ++k) ld[u4][k] = *(const f32x4*)(base + (size_t)(m + u4) * 4096 + 1024 * k);
#pragma unroll
            for (int u4 = 0; u4 < 4; ++u4)
#pragma unroll
                for (int k = 0; k < 4; ++k) a[k] = a[k] * dec + ld[u4][k]; }
        for (; m < c; ++m) {
#pragma unroll
            for (int k = 0; k < 4; ++k) a[k] = a[k] * dec + *(const f32x4*)(base + (size_t)m * 4096 + 1024 * k); }
#pragma unroll
        for (int k = 0; k < 4; ++k) { const int e = tl * 4 + 1024 * k, dv = e >> 6, dk = e & 63; v2u wv; wv.x = cvtpk(a[k].x, a[k].y); wv.y = cvtpk(a[k].z, a[k].w);
            *(LAS v2u*)(lds + RET_SOFF + ci * RET_SBYTES + dv * RET_P + dk * 2) = wv; }
    }
    const int iq = 32 * wi + r; const size_t rowq = row0 + 128 * ci + iq;
    bf16x8v qf[4];
#pragma unroll
    for (int s = 0; s < 4; ++s) qf[s] = *(const bf16x8v*)(Z + rowq * ZLD + ZO_RQ + h * 64 + 16 * s + 8 * hh);
    __syncthreads();
    f32x16 ot[2], oc[2];
#pragma unroll
    for (int i = 0; i < 16; ++i) { ot[0][i] = 0.f; ot[1][i] = 0.f; oc[0][i] = 0.f; oc[1][i] = 0.f; }
    for (int kt = 0; kt <= wi; ++kt) { const int krow = 128 * ci + 32 * kt;
        f32x16 st;
#pragma unroll
        for (int i = 0; i < 16; ++i) st[i] = 0.f;
#pragma unroll
        for (int s = 0; s < 4; ++s) { const bf16x8v kf = *(const LAS bf16x8v*)(lds + (krow + r) * RET_P + (16 * s + 8 * hh) * 2); st = MFMA32(kf, qf[s], st); }
#pragma unroll
        for (int i = 0; i < 16; ++i) { const int dj = iq - (32 * kt + crow(i, hh)); st[i] = (dj >= 0) ? st[i] * 0.125f * __builtin_amdgcn_exp2f((float)dj * lg2) : 0.f; }
        const bf16x8v p0 = pack8(st, 0), p1 = pack8(st, 1);
#pragma unroll
        for (int d = 0; d < 2; ++d) { ot[d] = MFMA32(vt_frag(lds + RET_VOFF, RET_P, krow, d, lane), p0, ot[d]); ot[d] = MFMA32(vt_frag(lds + RET_VOFF, RET_P, krow + 16, d, lane), p1, ot[d]); }
    }
    const LAS unsigned char* sT = lds + RET_SOFF + ci * RET_SBYTES;
#pragma unroll
    for (int d = 0; d < 2; ++d)
#pragma unroll
        for (int s = 0; s < 4; ++s) { const bf16x8v sf = *(const LAS bf16x8v*)(sT + (32 * d + r) * RET_P + (16 * s + 8 * hh) * 2); oc[d] = MFMA32(sf, qf[s], oc[d]); }
    const float xi = __builtin_amdgcn_exp2f((float)(iq + 1) * lg2);
    float sum = 0.f;
#pragma unroll
    for (int d = 0; d < 2; ++d)
#pragma unroll
        for (int i = 0; i < 16; ++i) { ot[d][i] += oc[d][i] * xi; sum += ot[d][i]; }
    const float mu = xhalf_sum(sum) * (1.0f / 64.0f); float sq = 0.f;
#pragma unroll
    for (int d = 0; d < 2; ++d)
#pragma unroll
        for (int i = 0; i < 16; ++i) { const float dd = ot[d][i] - mu; sq += dd * dd; }
    const float rstd = 1.0f / sqrtf(xhalf_sum(sq) * (1.0f / 64.0f) + LN_EPS);
    const bf16* gp = Z + rowq * ZLD + ZO_RG + h * 64; bf16* yp = YC + rowq * D + YO_RET + h * 64;
#pragma unroll
    for (int d = 0; d < 2; ++d)
#pragma unroll
        for (int g4 = 0; g4 < 4; ++g4) { const int dv = 32 * d + 8 * g4 + 4 * hh; const v2u gw = *(const v2u*)(gp + dv); const f32x4 gg = *(const f32x4*)(gn + dv);
            const float o0 = fsilu(bflo(gw.x)) * ((ot[d][4 * g4] - mu) * rstd * gg.x), o1 = fsilu(bfhi(gw.x)) * ((ot[d][4 * g4 + 1] - mu) * rstd * gg.y), o2 = fsilu(bflo(gw.y)) * ((ot[d][4 * g4 + 2] - mu) * rstd * gg.z), o3 = fsilu(bfhi(gw.y)) * ((ot[d][4 * g4 + 3] - mu) * rstd * gg.w);
            v2u wv; wv.x = cvtpk(o0, o1); wv.y = cvtpk(o2, o3); *(v2u*)(yp + dv) = wv; }
}
__device__ __forceinline__ void phase_ret_out(Frame& F, int l) {
    for (int idx = (int)blockIdx.x; idx < 32 * 16; idx += F.G) { const int bh = idx >> 4, cp = idx & 15; ret_out_unit(F, l, bh >> 2, bh & 3, cp); }
}

constexpr int P4_NMLA = 48 * 8, P4_NRET = 32 * 16, P4_NMRG = 256;
__device__ __forceinline__ void phase_p4(Frame& F, int l, int rep) {
    gu32* head = F.ctl + CW_Q + 64 * (4 * l + rep);
    for (;;) { const int idx = queue_pull(F, head); F.refresh();
        if (idx < P4_NMLA) { const int qb = 7 - idx / 48, bh = idx % 48; mla_unit2(F, bh / 6, bh % 6, qb); }
        else if (idx < P4_NMLA + P4_NRET) { const int j = idx - P4_NMLA, bh = j >> 4, cp = j & 15; ret_out_unit(F, l, bh >> 2, bh & 3, cp); }
        else if (idx < P4_NMLA + P4_NRET + P4_NMRG) { const int j = idx - P4_NMLA - P4_NRET; dil_merge_range(F, F.tid, NTHREADS, j * (T * 48 / P4_NMRG), (j + 1) * (T * 48 / P4_NMRG)); }
        else break; }
}
#ifndef MK_PER_PHASE
#define MK_PER_PHASE 0
#endif
constexpr int NPHASES = 36;
#ifndef PROBE
#define PROBE 0
#endif
#define REP(k) for (int rep_ = 0; rep_ < ((PROBE == (k)) ? 2 : 1); ++rep_)
struct Args { const float* in[23]; float* out; unsigned char* ws; int ph_lo, ph_hi; };
static_assert(sizeof(Args) == 23 * 8 + 8 + 8 + 8, "no padding");

__global__ void __launch_bounds__(NTHREADS, 2) mk_fwd(Args args) {
    extern __shared__ __attribute__((aligned(16))) unsigned char lds[];
    Frame F;
    F.lds = (LAS unsigned char*)lds; F.MISC = (volatile LAS unsigned*)(F.lds + MISC_OFF);
    F.tid = threadIdx.x; F.lane = F.tid & 63; F.wave = __builtin_amdgcn_readfirstlane(F.tid >> 6); F.wave_s = F.wave;
    F.G = gridDim.x; { const int bx = blockIdx.x; F.vcu = (F.G % 8 == 0) ? (bx % 8) * (F.G / 8) + bx / 8 : bx; }
    F.ctl = (gu32*)(args.ws + WS_CTL);
    for (int u = F.tid; u < (LDS_BYTES - LDSCTL_OFF) / 4; u += NTHREADS) ((LAS unsigned*)(F.lds + LDSCTL_OFF))[u] = 0u;
    __syncthreads();
    if (F.tid == 0) { LAS unsigned long long* pt = (LAS unsigned long long*)(F.lds + PTAB_OFF);
#pragma unroll
        for (int i = 0; i < 23; ++i) pt[i] = (unsigned long long)args.in[i];
        pt[23] = (unsigned long long)args.out; pt[24] = (unsigned long long)args.ws; }
    __syncthreads();
    XcdBarrier bar = xcd_barrier_post((unsigned*)(F.ctl + CW_BAR), F.MISC + 8);
    int pc = 0;
#define PH_ON() (args.ph_lo <= pc && pc < args.ph_hi && (F.refresh(), true))
#define PH_END() do { if (args.ph_lo <= pc && pc + 1 < args.ph_hi) xcd_barrier(bar); ++pc; } while (0)
#define WSB(T_, off) ((T_*)(F.wsp() + (off)))
    if (PH_ON()) { phase_mod_tab(F); phase_convert(F, 0); } PH_END();
    if (PH_ON()) { phase_modulate0(F); } PH_END();
    if (PROBE == 20) { for (int i = 0; i < 40; ++i) xcd_barrier(bar); }
    for (int l = 0; l < NL; ++l) {
        const bool moe = (l & 1) != 0; const int li = l >> 1;
        if (PH_ON()) REP(1) { pg8::Gemm g{WSB(bf16, WS_H), WSB(bf16, WS_WIN), D, D, D, 0, 0}; pg8::StaticOrder S; S.init(T, ZLD, F.G, (int)blockIdx.x); pg8::EpiZ E{WSB(bf16, WS_Z), WSB(bf16, WS_KM), WSB(const float, WS_TAB), WSB(float, WS_RSP), ZLD, 0.125f * LOG2E};
            pg8::gemm_phase<pg8::EpiZ, pg8::StaticOrder, true>(F.lds + RING_OFF, g, S, E, F.tid); } PH_END();
        if (PH_ON()) {
            REP(2) { pg8::Gemm g{WSB(bf16, WS_Z) + ZO_CQ, WSB(bf16, WS_WUQ), ZLD, QRANK, QRANK, 0, 0}; pg8::StaticOrder S; S.init(T, 768, F.G, (int)blockIdx.x); pg8::EpiMlaQ E{WSB(bf16, WS_QM), WSB(const float, WS_RSP), WSB(const float, WS_TAB), MLA_QSCALE, 0};
              pg8::gemm_phase<pg8::EpiMlaQ, pg8::StaticOrder, true>(F.lds + RING_OFF, g, S, E, F.tid); }
            REP(2) { pg8::Gemm g{WSB(bf16, WS_Z) + ZO_CKV, WSB(bf16, WS_WUKV), ZLD, KVRANK, KVRANK, 0, 0}; pg8::StaticOrder S; S.init(T, 768, F.G, F.G - 1 - (int)blockIdx.x); pg8::EpiMlaKV E{WSB(bf16, WS_KM), WSB(bf16, WS_VM), WSB(const float, WS_RSP)};
              pg8::gemm_phase<pg8::EpiMlaKV, pg8::StaticOrder, true>(F.lds + RING_OFF, g, S, E, F.tid); }
            REP(3) phase_dil_mfma(F); REP(4) phase_ret_state(F);
        } PH_END();
        if (PH_ON()) { REP(7) phase_p4(F, l, rep_); } PH_END();
        if (PH_ON()) REP(8) { pg8::Gemm g{WSB(bf16, WS_YCAT), WSB(bf16, WS_WOUT), D, D, D, 0, 0}; pg8::StaticOrder S; S.init(T, D, F.G, (int)blockIdx.x); pg8::EpiBf16 E{WSB(bf16, WS_Y), D, D};
            pg8::gemm_phase<pg8::EpiBf16, pg8::StaticOrder, true>(F.lds + RING_OFF, g, S, E, F.tid); } PH_END();
        if (PH_ON()) { if (PROBE == 21) phase_ln<false>(F, l == 0 ? F.in(0) : (const float*)nullptr, WSB(float, WS_END), WSB(const float, WS_MOD) + (size_t)l * NB * 6 * D + 2 * D, F.in(12) + l * D, F.in(13) + l * D, WSB(const float, WS_MOD) + (size_t)l * NB * 6 * D, 3 * D, 4 * D, nullptr, li);
            phase_ln<false>(F, l == 0 ? F.in(0) : (const float*)nullptr, (float*)nullptr, WSB(const float, WS_MOD) + (size_t)l * NB * 6 * D + 2 * D, F.in(12) + l * D, F.in(13) + l * D, WSB(const float, WS_MOD) + (size_t)l * NB * 6 * D, 3 * D, 4 * D, moe ? F.in(19) + (size_t)li * D * NEXP : nullptr, li); } PH_END();

        if (!moe) {
            if (PH_ON()) REP(9) { pg8::Gemm g{WSB(bf16, WS_H), WSB(bf16, WS_WFF), D, D, D, 0, 0}; pg8::StaticOrder S; S.init(T, 2 * DFF, F.G, (int)blockIdx.x); pg8::EpiSwiglu E{WSB(bf16, WS_FF), DFF};
                pg8::gemm_phase<pg8::EpiSwiglu, pg8::StaticOrder, true>(F.lds + RING_OFF, g, S, E, F.tid); } PH_END();
            if (PH_ON()) REP(10) { pg8::Gemm g{WSB(bf16, WS_FF), WSB(const bf16, WS_WFF + WFF_W2_OFF_DENSE), DFF, DFF, DFF, 0, 0}; pg8::StaticOrder S; S.init(T, D, F.G, (int)blockIdx.x); pg8::EpiBf16 E{WSB(bf16, WS_Y), D, D};
                pg8::gemm_phase<pg8::EpiBf16, pg8::StaticOrder, true>(F.lds + RING_OFF, g, S, E, F.tid); } PH_END();
            if (PH_ON()) { if (PROBE == 22) phase_ln<false>(F, (const float*)nullptr, WSB(float, WS_END), WSB(const float, WS_MOD) + (size_t)l * NB * 6 * D + 5 * D, F.in(14) + l * D, F.in(15) + l * D, (l + 1 < NL) ? WSB(const float, WS_MOD) + (size_t)(l + 1) * NB * 6 * D : nullptr, 0, D, nullptr, 0);
                phase_ln<false>(F, (const float*)nullptr, (float*)nullptr, WSB(const float, WS_MOD) + (size_t)l * NB * 6 * D + 5 * D, F.in(14) + l * D, F.in(15) + l * D, (l + 1 < NL) ? WSB(const float, WS_MOD) + (size_t)(l + 1) * NB * 6 * D : nullptr, 0, D, nullptr, 0);  if (l + 1 < NL) { F.refresh(); phase_convert(F, l + 1); } } PH_END();
        } else {
            if (PH_ON()) { phase_moe_assign(F, li); } PH_END();
            if (PH_ON()) REP(11) { pg8::Gemm g{WSB(bf16, WS_Y), WSB(bf16, WS_WFF), D / 2, D / 2, D / 2, 0, (long)2 * DFFE * D / 2}; pg8::GroupedOrder S; S.init(WSB(const int, WS_SEG), 2 * DFFE / 256, F.G, (int)blockIdx.x); pg8::EpiSwiglu8 E{WSB(unsigned char, WS_FF), DFFE, 1.0f / 512.0f};
                pg8::gemm_phase<pg8::EpiSwiglu8, pg8::GroupedOrder, true, 1>(F.lds + RING_OFF, g, S, E, F.tid); } PH_END();
            if (PH_ON()) REP(12) { pg8::Gemm g{WSB(bf16, WS_FF), WSB(const bf16, WS_WFF + WFF_W2_OFF_MOE8), DFFE / 2, DFFE / 2, DFFE / 2, 0, (long)D * DFFE / 2}; pg8::GroupedOrder S; S.init(WSB(const int, WS_SEG), D / 256, F.G, (int)blockIdx.x); pg8::EpiBf16S E{WSB(bf16, WS_Y), D, 1.0f / 256.0f};
                pg8::gemm_phase<pg8::EpiBf16S, pg8::GroupedOrder, true, 1>(F.lds + RING_OFF, g, S, E, F.tid); } PH_END();
            if (PH_ON()) { phase_ln<true>(F, (const float*)nullptr, (l + 1 < NL) ? (float*)nullptr : F.outp(), WSB(const float, WS_MOD) + (size_t)l * NB * 6 * D + 5 * D, F.in(14) + l * D, F.in(15) + l * D, (l + 1 < NL) ? WSB(const float, WS_MOD) + (size_t)(l + 1) * NB * 6 * D : nullptr, 0, D, nullptr, 0);  if (l + 1 < NL) { F.refresh(); phase_convert(F, l + 1); } } PH_END();
        }
    }
#undef PH_ON
#undef PH_END
}

extern "C" void kernel_launch(void* const* d_in, const int* in_sizes, int n_in, void* d_out, int out_size, void* d_ws, size_t ws_size, hipStream_t stream) {
    static int grid = 0;
    if (grid == 0) {
        if (n_in != 23 || out_size != T * D || ws_size < WS_END) { fprintf(stderr, "kernel_launch: unexpected shapes (n_in %d out %d ws %zu)\n", n_in, out_size, ws_size); grid = -1; return; }
        int dev = 0, cus = 0, per_cu = 0;
        if (hipGetDevice(&dev) != hipSuccess || hipDeviceGetAttribute(&cus, hipDeviceAttributeMultiprocessorCount, dev) != hipSuccess) { grid = -1; return; }
        if (hipFuncSetAttribute((const void*)mk_fwd, hipFuncAttributeMaxDynamicSharedMemorySize, LDS_BYTES) != hipSuccess) { fprintf(stderr, "kernel_launch: hipFuncSetAttribute failed\n"); grid = -1; return; }
        if (hipOccupancyMaxActiveBlocksPerMultiprocessor(&per_cu, (const void*)mk_fwd, NTHREADS, LDS_BYTES) != hipSuccess || per_cu < 1) fprintf(stderr, "kernel_launch: occupancy query reports %d\n", per_cu);
        (void)hipGetLastError();
        grid = cus;
    }
    if (grid < 0) return;
    if (hipMemsetAsync((char*)d_ws + WS_CTL, 0, CTL_ZERO_BYTES, stream) != hipSuccess) return;
    Args a{};
    for (int i = 0; i < 23; ++i) a.in[i] = (const float*)d_in[i];
    a.out = (float*)d_out; a.ws = (unsigned char*)d_ws;
#if MK_PER_PHASE
    for (int p = 0; p < NPHASES; ++p) { a.ph_lo = p; a.ph_hi = p + 1; hipLaunchKernelGGL(mk_fwd, dim3(grid), dim3(NTHREADS), LDS_BYTES, stream, a); }
#else
    a.ph_lo = 0; a.ph_hi = NPHASES; hipLaunchKernelGGL(mk_fwd, dim3(grid), dim3(NTHREADS), LDS_BYTES, stream, a);
#endif
}
```
